# Optimizing an MI355X kernel written in HIP

```python
import math
import jax, jax.numpy as jnp
from jax import lax
import numpy as np

D_MODEL = 1024
BATCH = 4
SEQ = 4096
DEPTH = 2

N_A_LAYERS = DEPTH // 2
N_B_LAYERS = DEPTH - N_A_LAYERS
N_DENSE = (DEPTH + 1) // 2
N_MOE = DEPTH // 2

CHUNK = 128
GMLP_FFN = 6 * D_MODEL
GMLP_HALF = GMLP_FFN // 2
GMLP_GROUPS = 8
GMLP_GROUP_DIM = GMLP_HALF // GMLP_GROUPS

N_HEADS = 16
N_KV_HEADS = 4
HEAD_DIM = 64
KV_REP = N_HEADS // N_KV_HEADS
WINDOW = 128
ROPE_THETA = 10000.0

D_FF_DENSE = 2816
N_EXPERTS = 8
TOP_K = 2
D_FF_EXPERT = 3584

PLE_DIM = 256

EPS = 1e-6
MASK_VALUE = -1e30

kernel_name = "yoco_gmlp_swa_sink_moe_trunk"


def rms_norm(x, g):
    xf = x.astype(jnp.float32)
    y = xf * lax.rsqrt(jnp.mean(xf * xf, axis=-1, keepdims=True) + EPS)
    return (y * g.astype(jnp.float32)).astype(x.dtype)


def layer_norm(x, g, b):
    xf = x.astype(jnp.float32)
    mu = jnp.mean(xf, axis=-1, keepdims=True)
    xc = xf - mu
    var = jnp.mean(xc * xc, axis=-1, keepdims=True)
    y = xc * lax.rsqrt(var + EPS)
    return (y * g.astype(jnp.float32) + b.astype(jnp.float32)).astype(x.dtype)


def rope(t):
    S, Dh = t.shape[1], t.shape[-1]
    freqs = ROPE_THETA ** (-jnp.arange(0, Dh, 2, dtype=jnp.float32) / Dh)
    ang = jnp.arange(S, dtype=jnp.float32)[:, None] * freqs[None, :]
    cos = jnp.cos(ang)[None, :, None, :]
    sin = jnp.sin(ang)[None, :, None, :]
    tf = t.astype(jnp.float32)
    t1, t2 = tf[..., : Dh // 2], tf[..., Dh // 2:]
    out = jnp.concatenate([t1 * cos - t2 * sin, t2 * cos + t1 * sin], axis=-1)
    return out.astype(t.dtype)


def gmlp_mixer(h, w_in, b_in, ln_g, ln_b, w_s, b_s, w_out, b_out):
    B, S, _ = h.shape
    n_chunks = S // CHUNK
    uv = jax.nn.gelu(h @ w_in + b_in)
    u, v = uv[..., :GMLP_HALF], uv[..., GMLP_HALF:]
    v = layer_norm(v, ln_g, ln_b)
    v = v.reshape(B, n_chunks, CHUNK, GMLP_GROUPS, GMLP_GROUP_DIM)
    causal = jnp.tril(jnp.ones((CHUNK, CHUNK), dtype=bool))
    ws = jnp.where(causal[None], w_s, jnp.zeros((), w_s.dtype))
    mixed = jnp.einsum('gts,bcsgd->bctgd', ws, v)
    mixed = mixed + jnp.transpose(b_s)[None, None, :, :, None]
    gated = u * mixed.reshape(B, S, GMLP_HALF)
    return gated @ w_out + b_out


def shared_kv(h, kv_norm_g, w_kv, b_kv):
    B, S, _ = h.shape
    n_blocks = S // WINDOW
    kv = rms_norm(h, kv_norm_g) @ w_kv + b_kv
    k = kv[..., : N_KV_HEADS * HEAD_DIM].reshape(B, S, N_KV_HEADS, HEAD_DIM)
    v = kv[..., N_KV_HEADS * HEAD_DIM:].reshape(B, S, N_KV_HEADS, HEAD_DIM)
    k = rope(k)

    def band(t):
        tp = jnp.pad(t, ((0, 0), (WINDOW, 0), (0, 0), (0, 0)))
        tp = tp.reshape(B, n_blocks + 1, WINDOW, N_KV_HEADS, HEAD_DIM)
        return jnp.concatenate([tp[:, :-1], tp[:, 1:]], axis=2)

    return band(k), band(v)


def swa_sink_attention(h, w_q, b_q, sinks, w_o, b_o, k_band, v_band):
    B, S, _ = h.shape
    n_blocks = S // WINDOW
    q = (h @ w_q + b_q).reshape(B, S, N_HEADS, HEAD_DIM)
    q = rope(q).reshape(B, n_blocks, WINDOW, N_KV_HEADS, KV_REP, HEAD_DIM)
    scores = jnp.einsum('bcqkrd,bcjkd->bckrqj', q, k_band).astype(jnp.float32)
    scores = scores * (1.0 / math.sqrt(HEAD_DIM))
    qi = jnp.arange(WINDOW)[:, None]
    kj = jnp.arange(2 * WINDOW)[None, :]
    in_window = (kj > qi) & (kj <= qi + WINDOW)
    key_pos = jnp.arange(n_blocks)[:, None] * WINDOW + jnp.arange(2 * WINDOW)[None, :] - WINDOW
    mask = in_window[None] & (key_pos >= 0)[:, None, :]
    scores = jnp.where(mask[None, :, None, None], scores, MASK_VALUE)
    sink = sinks.astype(jnp.float32).reshape(N_KV_HEADS, KV_REP)[None, None, :, :, None, None]
    sink = jnp.broadcast_to(sink, scores.shape[:-1] + (1,))
    probs = jax.nn.softmax(jnp.concatenate([scores, sink], axis=-1), axis=-1)[..., :-1]
    out = jnp.einsum('bckrqj,bcjkd->bcqkrd', probs.astype(v_band.dtype), v_band)
    out = out.reshape(B, S, N_HEADS * HEAD_DIM)
    return out @ w_o + b_o


def swiglu(h, w_gate, w_up, w_down):
    return (jax.nn.silu(h @ w_gate) * (h @ w_up)) @ w_down


def moe_swiglu(h, w_router, w_gate, w_up, w_down):
    B, S, D = h.shape
    t = h.reshape(B * S, D)
    logits = (t @ w_router).astype(jnp.float32)
    top_vals, top_idx = lax.top_k(logits, TOP_K)
    top_w = jax.nn.softmax(top_vals, axis=-1)
    combine = jnp.sum(jax.nn.one_hot(top_idx, N_EXPERTS, dtype=jnp.float32) * top_w[..., None], axis=1)
    combine = combine.astype(t.dtype)
    y = jnp.zeros_like(t)
    for e in range(N_EXPERTS):
        y = y + combine[:, e:e + 1] * swiglu(t, w_gate[e], w_up[e], w_down[e])
    return y.reshape(B, S, D)


def per_layer_embedding(h, p_i, w_proj, norm_g, w_gate):
    gate = jax.nn.sigmoid(rms_norm(h, norm_g) @ w_gate)
    return (p_i @ w_proj) * gate


def setup_inputs(seed: int = 0) -> dict:
    key = jax.random.key(seed)
    ks = iter(jax.random.split(key, 40))
    f32 = jnp.float32

    def nrm(shape, scale):
        return jax.random.normal(next(ks), shape, f32) * scale

    def gain(shape):
        return 1.0 + nrm(shape, 0.05)

    D = D_MODEL
    QW = N_HEADS * HEAD_DIM
    KVW = 2 * N_KV_HEADS * HEAD_DIM
    return {
        "x": nrm((BATCH, SEQ, D), 1.0),
        "p": nrm((DEPTH, BATCH, SEQ, PLE_DIM), 1.0),
        "mix_norm_g": gain((DEPTH, D)),
        "ffn_norm_g": gain((DEPTH, D)),
        "gmlp_w_in": nrm((N_A_LAYERS, D, GMLP_FFN), D ** -0.5),
        "gmlp_b_in": nrm((N_A_LAYERS, GMLP_FFN), 0.02),
        "gmlp_ln_g": gain((N_A_LAYERS, GMLP_HALF)),
        "gmlp_ln_b": nrm((N_A_LAYERS, GMLP_HALF), 0.02),
        "gmlp_w_s": nrm((N_A_LAYERS, GMLP_GROUPS, CHUNK, CHUNK), 0.5 * CHUNK ** -0.5),
        "gmlp_b_s": gain((N_A_LAYERS, GMLP_GROUPS, CHUNK)),
        "gmlp_w_out": nrm((N_A_LAYERS, GMLP_HALF, D), GMLP_HALF ** -0.5),
        "gmlp_b_out": nrm((N_A_LAYERS, D), 0.02),
        "kv_norm_g": gain((D,)),
        "w_kv": nrm((D, KVW), D ** -0.5),
        "b_kv": nrm((KVW,), 0.02),
        "attn_w_q": nrm((N_B_LAYERS, D, QW), D ** -0.5),
        "attn_b_q": nrm((N_B_LAYERS, QW), 0.02),
        "attn_sinks": nrm((N_B_LAYERS, N_HEADS), 0.5),
        "attn_w_o": nrm((N_B_LAYERS, QW, D), QW ** -0.5),
        "attn_b_o": nrm((N_B_LAYERS, D), 0.02),
        "ffn_w_gate": nrm((N_DENSE, D, D_FF_DENSE), D ** -0.5),
        "ffn_w_up": nrm((N_DENSE, D, D_FF_DENSE), D ** -0.5),
        "ffn_w_down": nrm((N_DENSE, D_FF_DENSE, D), D_FF_DENSE ** -0.5),
        "moe_w_router": nrm((N_MOE, D, N_EXPERTS), D ** -0.5),
        "moe_w_gate": nrm((N_MOE, N_EXPERTS, D, D_FF_EXPERT), D ** -0.5),
        "moe_w_up": nrm((N_MOE, N_EXPERTS, D, D_FF_EXPERT), D ** -0.5),
        "moe_w_down": nrm((N_MOE, N_EXPERTS, D_FF_EXPERT, D), D_FF_EXPERT ** -0.5),
        "ple_w_proj": nrm((DEPTH, PLE_DIM, D), PLE_DIM ** -0.5),
        "ple_norm_g": gain((DEPTH, D)),
        "ple_w_gate": nrm((DEPTH, D, D), D ** -0.5),
        "final_norm_g": gain((D,)),
    }


def reference(x, p, mix_norm_g, ffn_norm_g,
              gmlp_w_in, gmlp_b_in, gmlp_ln_g, gmlp_ln_b, gmlp_w_s, gmlp_b_s, gmlp_w_out, gmlp_b_out,
              kv_norm_g, w_kv, b_kv,
              attn_w_q, attn_b_q, attn_sinks, attn_w_o, attn_b_o,
              ffn_w_gate, ffn_w_up, ffn_w_down,
              moe_w_router, moe_w_gate, moe_w_up, moe_w_down,
              ple_w_proj, ple_norm_g, ple_w_gate,
              final_norm_g):
    k_band, v_band = None, None
    for i in range(DEPTH):
        h = rms_norm(x, mix_norm_g[i])
        if i < N_A_LAYERS:
            a = i
            x = x + gmlp_mixer(h, gmlp_w_in[a], gmlp_b_in[a], gmlp_ln_g[a], gmlp_ln_b[a],
                               gmlp_w_s[a], gmlp_b_s[a], gmlp_w_out[a], gmlp_b_out[a])
        else:
            b = i - N_A_LAYERS
            if b == 0:
                k_band, v_band = shared_kv(x, kv_norm_g, w_kv, b_kv)
            x = x + swa_sink_attention(h, attn_w_q[b], attn_b_q[b], attn_sinks[b],
                                       attn_w_o[b], attn_b_o[b], k_band, v_band)
        hn = rms_norm(x, ffn_norm_g[i])
        if i % 2 == 0:
            j = i // 2
            x = x + swiglu(hn, ffn_w_gate[j], ffn_w_up[j], ffn_w_down[j])
        else:
            j = i // 2
            x = x + moe_swiglu(hn, moe_w_router[j], moe_w_gate[j], moe_w_up[j], moe_w_down[j])
        x = x + per_layer_embedding(x, p[i], ple_w_proj[i], ple_norm_g[i], ple_w_gate[i])
    return rms_norm(x, final_norm_g)
```

```cpp
#include <hip/hip_runtime.h>
#include <cstdio>
#include <cstdint>

#ifndef MK_N_LAUNCHES
#define MK_N_LAUNCHES 16
#endif

#define GAS __attribute__((address_space(1)))
#define LAS __attribute__((address_space(3)))
typedef unsigned short bf16;
typedef unsigned v4u __attribute__((ext_vector_type(4)));
typedef unsigned v2u __attribute__((ext_vector_type(2)));
typedef float f32x4 __attribute__((ext_vector_type(4)));
typedef float f32x2 __attribute__((ext_vector_type(2)));
typedef short bf16x8 __attribute__((ext_vector_type(8)));
typedef short s16x4 __attribute__((ext_vector_type(4)));

constexpr int M = 16384, D = 1024, SEQ = 4096;
constexpr int GF = 6144, GH = 3072, GD = 384;
constexpr int FFD = 2816, NE = 8, FFE = 3584, PLE = 256;
constexpr int NQKV = 1536;
constexpr float EPS = 1e-6f;
constexpr float LOG2E = 1.4426950408889634f;
constexpr float QSCALE = 0.125f * LOG2E;

constexpr size_t MiB = 1u << 20;
constexpr size_t WS_CTL = 0, CTL_ZERO_BYTES = 1 * MiB;
constexpr size_t WS_SS = 1 * MiB;
constexpr size_t WS_R4 = 6 * MiB;
constexpr size_t WS_TOKSLOT = WS_R4 + 64 * 1024;
constexpr size_t WS_TOKLIST = WS_TOKSLOT + 128 * 1024;
constexpr size_t WS_SLOTW = WS_TOKLIST + 512 * 1024;
constexpr size_t WS_WR = WS_SLOTW + 512 * 1024;
constexpr size_t WS_VSTAT = 8 * MiB;
constexpr size_t WS_ROPE = 14 * MiB;
constexpr size_t WS_PB = 15 * MiB;
constexpr size_t WS_XB1 = 31 * MiB;
constexpr size_t WS_WPG1 = 63 * MiB;
constexpr size_t WS_WPP1 = 65 * MiB;
constexpr size_t WS_MWGU = 66 * MiB;
constexpr size_t WS_MWD = 178 * MiB;
constexpr size_t WS_B = 234 * MiB;
constexpr size_t WS_WIN = WS_B;
constexpr size_t WS_WOUT = WS_B + 12 * MiB;
constexpr size_t WS_WGU = WS_B + 18 * MiB;
constexpr size_t WS_WD = WS_B + 29 * MiB;
constexpr size_t WS_WPG0 = WS_B + 35 * MiB;
constexpr size_t WS_WPP0 = WS_B + 37 * MiB;
constexpr size_t WS_WQKV = WS_B + 38 * MiB;
constexpr size_t WS_WO = WS_B + 41 * MiB;
constexpr size_t WS_XB0 = WS_B + 43 * MiB;
constexpr size_t WS_UV = WS_B + 75 * MiB;
constexpr size_t WS_HID = WS_UV;
constexpr size_t WS_PROJ = WS_UV + 96 * MiB;
constexpr size_t WS_Q = WS_UV;
constexpr size_t WS_K = WS_UV + 32 * MiB;
constexpr size_t WS_V = WS_UV + 40 * MiB;
constexpr size_t WS_HIDM = WS_B;
constexpr size_t WS_YS = WS_MWGU;
constexpr size_t WS_END = WS_B + 267 * MiB;
static_assert(WS_HIDM + (size_t)(32768 + 256) * FFE * 2 <= WS_END, "hidm");
static_assert(WS_WR + 32768 <= WS_VSTAT, "misc");

constexpr int CW_TMO = 0, CW_BAR = 4096, CW_CNT = 8192;

constexpr int RING_BYTES = 131072;
constexpr int TOKTAB_OFF = RING_BYTES;
constexpr int MISC_OFF = RING_BYTES + 16384;
constexpr int LDS_BYTES = MISC_OFF + 512;
constexpr int NWAVES = 8;

#define RLX_AGENT __ATOMIC_RELAXED, __HIP_MEMORY_SCOPE_AGENT
#define LDS_WAIT() asm volatile("s_waitcnt lgkmcnt(0)" ::: "memory")
#define VM_WAIT() asm volatile("s_waitcnt vmcnt(0)" ::: "memory")
__device__ __forceinline__ unsigned cvt_pk_bf16(float lo, float hi) { unsigned r; asm volatile("v_cvt_pk_bf16_f32 %0, %1, %2" : "=v"(r) : "v"(lo), "v"(hi)); return r; }
__device__ __forceinline__ float bf_lo(unsigned w) { return __uint_as_float(w << 16); }
__device__ __forceinline__ float bf_hi(unsigned w) { return __uint_as_float(w & 0xffff0000u); }
__device__ __forceinline__ float fast_rcp(float x) { return __builtin_amdgcn_rcpf(x); }
__device__ __forceinline__ float fast_exp2(float x) { return __builtin_amdgcn_exp2f(x); }
__device__ __forceinline__ float sigmoid_f(float x) { return fast_rcp(1.0f + fast_exp2(-x * LOG2E)); }
__device__ __forceinline__ float gelu_tanh(float x) { const float u = 0.7978845608028654f * (x + 0.044715f * x * x * x); return x * fast_rcp(1.0f + fast_exp2(-2.0f * LOG2E * u)); }
__device__ __forceinline__ float wave_sum(float v) {
#pragma unroll
    for (int o = 1; o < 64; o <<= 1) v += __shfl_xor(v, o);
    return v;
}
__device__ __forceinline__ float row_rscale(const float* ss, int row, int fq) {
    const f32x4 v = *(const f32x4*)(ss + (size_t)row * 16 + 4 * fq);
    float s = (v.x + v.y) + (v.z + v.w);
    s += __shfl_xor(s, 16); s += __shfl_xor(s, 32);
    return __builtin_amdgcn_rsqf(s * (1.0f / D) + EPS);
}

#define XB_TMO      128
#define XB_XCNT(j)  (256  + 64 * (j))
#define XB_XSUB(j)  (1280 + 64 * (j))
#define XB_XGEN(j)  (2304 + 64 * (j))
#define XB_TOP      3328
#define XB_TOPGEN   3392
#define XCD_BAR_WORDS 3456
#define XB_SPIN_CAP (1u << 18)
__device__ __forceinline__ unsigned xb_ld(unsigned* p)              { return __hip_atomic_load(p, __ATOMIC_RELAXED, __HIP_MEMORY_SCOPE_AGENT); }
__device__ __forceinline__ unsigned xb_add(unsigned* p, unsigned v) { return __hip_atomic_fetch_add(p, v, __ATOMIC_RELAXED, __HIP_MEMORY_SCOPE_AGENT); }
__device__ __forceinline__ unsigned xb_xcc_id() { return (unsigned)__builtin_amdgcn_s_getreg((3 << 11) | 20) & 0xFu; }
#define XB_SPIN(cond, bar) do { unsigned _sp = 0; while (cond) { __builtin_amdgcn_s_sleep(1); \
    if ((++_sp & 255u) == 0u) { if (xb_ld(&(bar)[XB_TMO])) break; if (_sp > XB_SPIN_CAP) { atomicAdd(&(bar)[XB_TMO], 1u); break; } } } } while (0)
struct XcdBarrier { unsigned* bar; unsigned x; volatile LAS unsigned* st; };
__device__ __forceinline__ XcdBarrier xcd_barrier_post(unsigned* bar, volatile LAS unsigned* st) {
    XcdBarrier b; b.bar = bar; b.x = xb_xcc_id(); b.st = st;
    if (threadIdx.x == 0) (void)xb_add(&bar[XB_XCNT(b.x)], 1u);
    return b;
}
__device__ __forceinline__ void xcd_barrier_complete(unsigned* bar, unsigned x, unsigned& nloc, unsigned& nx) {
    const unsigned G = gridDim.x * gridDim.y * gridDim.z;
    unsigned sum, cnt, mine, sp = 0u;
    for (;;) {
        sum = 0u; cnt = 0u; mine = 0u;
#pragma unroll
        for (unsigned j = 0; j < 16; ++j) { const unsigned c = xb_ld(&bar[XB_XCNT(j)]); sum += c; cnt += (c > 0u) ? 1u : 0u; mine = (j == x) ? c : mine; }
        if (sum == G) break;
        __builtin_amdgcn_s_sleep(1);
        if ((++sp & 255u) == 0u) { if (xb_ld(&bar[XB_TMO])) break; if (sp > XB_SPIN_CAP) { atomicAdd(&bar[XB_TMO], 1u); break; } }
    }
    nloc = mine > 0u ? mine : 1u; nx = cnt > 0u ? cnt : 1u;
}
__device__ __forceinline__ void xcd_barrier(const XcdBarrier& b) {
    asm volatile("s_waitcnt vmcnt(0)" ::: "memory");
    __syncthreads();
    if (threadIdx.x == 0) {
        unsigned* bar = b.bar;
        __builtin_amdgcn_s_waitcnt(0);
        unsigned nloc = b.st[0], nx = b.st[1];
        if (nloc == 0u) { xcd_barrier_complete(bar, b.x, nloc, nx); b.st[0] = nloc; b.st[1] = nx; }
        const unsigned old = xb_add(&bar[XB_XSUB(b.x)], 1u);
        const unsigned gen = old / nloc;
        if (old + 1u == (gen + 1u) * nloc) {
            __builtin_amdgcn_fence(__ATOMIC_RELEASE, "agent");
            asm volatile("s_waitcnt vmcnt(0)" ::: "memory");
            const unsigned og = xb_add(&bar[XB_TOP], 1u);
            const unsigned tg = og / nx;
            if (og + 1u == (tg + 1u) * nx) xb_add(&bar[XB_TOPGEN], 1u);
            else XB_SPIN(xb_ld(&bar[XB_TOPGEN]) == tg, bar);
            __builtin_amdgcn_fence(__ATOMIC_ACQUIRE, "agent");
            xb_add(&bar[XB_XGEN(b.x)], 1u);
            asm volatile("s_waitcnt vmcnt(0)" ::: "memory");
        } else {
            XB_SPIN(xb_ld(&bar[XB_XGEN(b.x)]) == gen, bar);
            __builtin_amdgcn_fence(__ATOMIC_ACQUIRE, "agent");
            asm volatile("s_waitcnt vmcnt(0)" ::: "memory");
        }
    }
    __syncthreads();
}

namespace pg8 {
constexpr int BM = 256, BK = 64, HALF = 128, HTB = HALF * BK * 2, STAGE_BYTES = 8 * HTB, NXCD = 8, WGM = 8;
__host__ __device__ __forceinline__ int lds_byte(int r, int c) { const int st = (r >> 4) * 2 + (c >> 5), rr = r & 15, cc = c & 31, ob = rr * 64 + cc * 2; return st * 1024 + (ob ^ (((ob >> 9) & 1) << 5)); }
__host__ __device__ __forceinline__ void stage_rc(int b, int& R, int& C) { const int st = b / 1024, sb = b % 1024, swz = sb ^ (((sb >> 9) & 1) << 5); R = (st >> 1) * 16 + swz / 64; C = (st & 1) * 32 + (swz % 64) / 2; }
__host__ __device__ __forceinline__ int perm32(int rho) { const int n = rho >> 4, i = rho & 15; return 8 * (i >> 2) + 4 * n + (i & 3); }

struct Unit { int pm, pn, e, r0, cnt; };

struct StaticOrder {
    int nM, nN, nwg, G, c, lda; const char* A; const char* Bt; size_t tstepA, tstepB;
    __device__ __forceinline__ void init(int M_, int N_, int K_, int lda_, int G_, int c_, const bf16* A_, const bf16* Bt_) { nM = M_ / BM; nN = N_ / BM; nwg = nM * nN; G = G_; c = c_; lda = lda_; A = (const char*)A_; Bt = (const char*)Bt_; tstepA = (size_t)BM * lda_ * 2; tstepB = (size_t)BM * K_ * 2; }
    __device__ __forceinline__ bool next(int i, Unit& u) const {
        const long L = (long)i * G + c; if (L >= nwg) return false;
        int wgid = (int)L; { const int q = nwg / NXCD, r = nwg % NXCD, xcd = wgid % NXCD, off = wgid / NXCD; wgid = (xcd < r ? xcd * (q + 1) : r * (q + 1) + (xcd - r) * q) + off; }
        const int nig = WGM * nN, gid = wgid / nig, fm = gid * WGM, gsz = (nM - fm) < WGM ? (nM - fm) : WGM;
        u.pm = fm + ((wgid % nig) % gsz); u.pn = (wgid % nig) / gsz; u.e = 0; u.r0 = u.pm * BM; u.cnt = BM; return true;
    }
    __device__ __forceinline__ const char* a_base(const Unit& u) const { return A + (size_t)u.pm * tstepA; }
    __device__ __forceinline__ const char* b_base(const Unit& u) const { return Bt + (size_t)u.pn * tstepB; }
    __device__ __forceinline__ unsigned a_off(int, int) const { return 0u; }
};

struct MoeOrder {
    const LAS int* tab; const LAS unsigned* toktab; int NT, G, c, total, lda; const char* A; const char* Bt; size_t a_row_bytes, b_exp_bytes, b_tile_bytes;
    __device__ __forceinline__ bool next(int i, Unit& u) const {
        const long L = (long)i * G + c; if (L >= total) return false;
        const int mtg = (int)(L / NT), pn = (int)(L % NT);
        int e = 0;
#pragma unroll
        for (int j = 1; j < 8; ++j) e += (mtg >= __builtin_amdgcn_readfirstlane(tab[j])) ? 1 : 0;
        const int ts = __builtin_amdgcn_readfirstlane(tab[e]), off = __builtin_amdgcn_readfirstlane(tab[9 + e]), cn = __builtin_amdgcn_readfirstlane(tab[18 + e]);
        u.e = e; u.pm = mtg - ts; u.pn = pn; u.r0 = off + BM * u.pm; const int rem = cn - BM * u.pm; u.cnt = rem < BM ? rem : BM; return true;
    }
    __device__ __forceinline__ const char* a_base(const Unit& u) const { return toktab ? A : A + (size_t)u.r0 * a_row_bytes; }
    __device__ __forceinline__ const char* b_base(const Unit& u) const { return Bt + (size_t)u.e * b_exp_bytes + (size_t)u.pn * b_tile_bytes; }
    __device__ __forceinline__ unsigned a_off(int ui, int R) const { return toktab[(ui & 15) * 256 + R]; }
};

template <class Epi, class Sched, bool ALIGN_EPI, bool GATHER>
__device__ __forceinline__ void gemm_phase(LAS unsigned char* lds, const int K, const Sched& S, const Epi& E) {
    const int tid = threadIdx.x, wid = __builtin_amdgcn_readfirstlane(tid >> 6), lane = tid & 63, wr = wid >> 2, wc = wid & 3, fr = lane & 15, fq = lane >> 4;
    const int nt = K / BK;
    unsigned voffB[2], vAc[2][2], vAn[2][2]; int Rr[2], Cb[2];
    const size_t kstep = (size_t)(BK * 2);
    const size_t hstep = (size_t)HALF * K * 2;
#pragma unroll
    for (int i = 0; i < 2; ++i) { int R, C; stage_rc(tid * 16 + i * 8192, R, C); const int Rb = Epi::PERM ? ((R & ~31) + perm32(R & 31)) : R;
        Rr[i] = R; Cb[i] = C * 2; voffB[i] = (unsigned)(Rb * K + C) * 2u; }
    const unsigned ldsw = (unsigned)wid * 1024u;
    const int aoff = lds_byte(wr * 64 + fr, fq * 8), boff = lds_byte(wc * 32 + fr, fq * 8);
#define PG8_SA(b, h) (((b) * 2 + (h)) * HTB)
#define PG8_SB(b, h) ((4 + (b) * 2 + (h)) * HTB)
#define PG8_STAGE(bufoff, gbase, voff) do { _Pragma("unroll") for (int _i = 0; _i < 2; ++_i) \
        __builtin_amdgcn_global_load_lds((const unsigned*)((const char*)(gbase) + (voff)[_i]), (LAS unsigned*)(lds + (bufoff) + ldsw + _i * 8192), 16, 0, 0); } while (0)
#define PG8_LDA(dst, b, h) do { _Pragma("unroll") for (int m = 0; m < 4; ++m) _Pragma("unroll") for (int k = 0; k < 2; ++k) dst[m][k] = *(const LAS bf16x8*)(lds + PG8_SA(b, h) + aoff + m * 2048 + k * 1024); } while (0)
#define PG8_LDB(dst, b, h) do { _Pragma("unroll") for (int n = 0; n < 2; ++n) _Pragma("unroll") for (int k = 0; k < 2; ++k) dst[n][k] = *(const LAS bf16x8*)(lds + PG8_SB(b, h) + boff + n * 2048 + k * 1024); } while (0)
#define PG8_MMA(ai, bj, At, Bt) do { __builtin_amdgcn_s_setprio(1); _Pragma("unroll") for (int m = 0; m < 4; ++m) _Pragma("unroll") for (int n = 0; n < 2; ++n) _Pragma("unroll") for (int k = 0; k < 2; ++k) \
        acc[ai][bj][m][n] = __builtin_amdgcn_mfma_f32_16x16x32_bf16(Bt[n][k], At[m][k], acc[ai][bj][m][n], 0, 0, 0); __builtin_amdgcn_s_setprio(0); } while (0)
#define PG8_WAIT_V(n) asm volatile("s_waitcnt vmcnt(" #n ")" ::: "memory")
#define PG8_WAIT_L(n) asm volatile("s_waitcnt lgkmcnt(" #n ")" ::: "memory")
#define PG8_BAR __builtin_amdgcn_s_barrier()
#define PG8_SCHED __builtin_amdgcn_sched_barrier(0)
#define PG8_VOFF(dst, ui_) do { _Pragma("unroll") for (int _h = 0; _h < 2; ++_h) _Pragma("unroll") for (int _i = 0; _i < 2; ++_i) \
        dst[_h][_i] = GATHER ? (S.a_off((ui_), Rr[_i] + _h * HALF) + (unsigned)Cb[_i]) : (unsigned)((Rr[_i] + _h * HALF) * S.lda * 2 + Cb[_i]); } while (0)
    Unit cur, nxt; int ui = 0;
    if (!S.next(0, cur)) return;
    f32x4 acc[2][2][4][2];
#pragma unroll
    for (int a = 0; a < 2; ++a)
#pragma unroll
        for (int b = 0; b < 2; ++b)
#pragma unroll
            for (int m = 0; m < 4; ++m)
#pragma unroll
                for (int n = 0; n < 2; ++n) acc[a][b][m][n] = (f32x4){0.f, 0.f, 0.f, 0.f};
    bf16x8 At[4][2], B0[2][2], B1[2][2];
    const char* cA = S.a_base(cur); const char* cB = S.b_base(cur);
    PG8_VOFF(vAc, 0);
    PG8_STAGE(PG8_SB(0, 0), cB, voffB); PG8_STAGE(PG8_SB(0, 1), cB + hstep, voffB); PG8_STAGE(PG8_SA(0, 0), cA, vAc[0]); PG8_STAGE(PG8_SA(0, 1), cA, vAc[1]);
    if (wr == 1) PG8_BAR;
    PG8_WAIT_V(2); PG8_BAR;
    PG8_STAGE(PG8_SB(1, 0), cB + kstep, voffB); PG8_STAGE(PG8_SA(1, 0), cA + kstep, vAc[0]); PG8_STAGE(PG8_SB(1, 1), cB + hstep + kstep, voffB);
    PG8_WAIT_V(6); PG8_BAR;
    for (;;) {
        const bool has_next = S.next(ui + 1, nxt);
        const char* nA = has_next ? S.a_base(nxt) : cA; const char* nB = has_next ? S.b_base(nxt) : cB;
        if (GATHER) { if (has_next) { PG8_VOFF(vAn, ui + 1); } else {
#pragma unroll
            for (int h = 0; h < 2; ++h)
#pragma unroll
                for (int i = 0; i < 2; ++i) vAn[h][i] = vAc[h][i]; } }
        for (int t = 0; t < nt; t += 2) {
            const bool last = (t == nt - 2);
            const char* a1 = cA + (size_t)(t + 1) * kstep;
            const char* a2 = last ? nA : cA + (size_t)(t + 2) * kstep; const char* b2 = last ? nB : cB + (size_t)(t + 2) * kstep;
            const char* a3 = a2 + kstep; const char* b3 = b2 + kstep;
            unsigned vA2[2][2];
#pragma unroll
            for (int h = 0; h < 2; ++h)
#pragma unroll
                for (int i = 0; i < 2; ++i) vA2[h][i] = (GATHER && last) ? vAn[h][i] : vAc[h][i];
            PG8_LDB(B0, 0, 0); PG8_LDB(B1, 0, 1); PG8_SCHED; PG8_LDA(At, 0, 0); PG8_STAGE(PG8_SA(1, 1), a1, vAc[1]);
            PG8_WAIT_V(8); PG8_WAIT_L(0); PG8_BAR; PG8_MMA(0, 0, At, B0); PG8_MMA(0, 1, At, B1); PG8_BAR; PG8_SCHED;
            PG8_LDA(At, 0, 1); PG8_STAGE(PG8_SB(0, 0), b2, voffB); PG8_STAGE(PG8_SB(0, 1), b2 + hstep, voffB); PG8_STAGE(PG8_SA(0, 0), a2, vA2[0]);
            PG8_WAIT_V(8); PG8_WAIT_L(0); PG8_BAR; PG8_MMA(1, 0, At, B0); PG8_MMA(1, 1, At, B1); PG8_BAR; PG8_SCHED;
            PG8_LDB(B0, 1, 0); PG8_LDB(B1, 1, 1); PG8_SCHED; PG8_LDA(At, 1, 0); PG8_STAGE(PG8_SA(0, 1), a2, vA2[1]);
            PG8_WAIT_V(8); PG8_WAIT_L(0); PG8_BAR; PG8_MMA(0, 0, At, B0); PG8_MMA(0, 1, At, B1); PG8_BAR; PG8_SCHED;
            PG8_LDA(At, 1, 1); PG8_STAGE(PG8_SB(1, 0), b3, voffB); PG8_STAGE(PG8_SB(1, 1), b3 + hstep, voffB); PG8_STAGE(PG8_SA(1, 0), a3, vA2[0]);
            PG8_WAIT_V(8); PG8_WAIT_L(0); PG8_BAR; PG8_MMA(1, 0, At, B0); PG8_MMA(1, 1, At, B1); PG8_BAR; PG8_SCHED;
        }
        if constexpr (ALIGN_EPI) { if (wr == 0) PG8_BAR; }
        E(acc, cur, wr, wc, fr, fq);
        if (!has_next) break;
#pragma unroll
        for (int a = 0; a < 2; ++a)
#pragma unroll
            for (int b = 0; b < 2; ++b)
#pragma unroll
                for (int m = 0; m < 4; ++m)
#pragma unroll
                    for (int n = 0; n < 2; ++n) acc[a][b][m][n] = (f32x4){0.f, 0.f, 0.f, 0.f};
        cur = nxt; cA = nA; cB = nB; ++ui;
        if (GATHER) {
#pragma unroll
            for (int h = 0; h < 2; ++h)
#pragma unroll
                for (int i = 0; i < 2; ++i) vAc[h][i] = vAn[h][i]; }
        if constexpr (ALIGN_EPI) { if (wr == 1) PG8_BAR; }
    }
    PG8_WAIT_V(0);
    if constexpr (!ALIGN_EPI) { if (wr == 0) PG8_BAR; }
    PG8_BAR;
#undef PG8_SA
#undef PG8_SB
#undef PG8_STAGE
#undef PG8_LDA
#undef PG8_LDB
#undef PG8_MMA
#undef PG8_WAIT_V
#undef PG8_WAIT_L
#undef PG8_BAR
#undef PG8_SCHED
#undef PG8_VOFF
}

typedef const f32x4 (&AccT)[2][2][4][2];

struct EpiUV {
    static constexpr bool PERM = true;
    bf16* O; const float* bias; const float* ss; float* vstat;
    __device__ __forceinline__ void operator()(AccT acc, const Unit& u, int wr, int wc, int fr, int fq) const {
        const int col0 = u.pn * BM + wc * 32 + 8 * fq; const bool isv = u.pn >= 12;
        f32x4 bv[2][2];
#pragma unroll
        for (int bj = 0; bj < 2; ++bj)
#pragma unroll
            for (int n = 0; n < 2; ++n) bv[bj][n] = *(const f32x4*)(bias + col0 + bj * HALF + 4 * n);
#pragma unroll
        for (int ai = 0; ai < 2; ++ai)
#pragma unroll
            for (int m = 0; m < 4; ++m) {
                const int row = u.r0 + ai * HALF + wr * 64 + m * 16 + fr;
                const float r = row_rscale(ss, row, fq);
                bf16* rowp = O + (size_t)row * GF + col0; float s1 = 0.f, s2 = 0.f;
#pragma unroll
                for (int bj = 0; bj < 2; ++bj) {
                    f32x4 v0 = acc[ai][bj][m][0] * r + bv[bj][0], v1 = acc[ai][bj][m][1] * r + bv[bj][1];
#pragma unroll
                    for (int j = 0; j < 4; ++j) { v0[j] = gelu_tanh(v0[j]); v1[j] = gelu_tanh(v1[j]); s1 += v0[j] + v1[j]; s2 += v0[j] * v0[j] + v1[j] * v1[j]; }
                    v4u w; w.x = cvt_pk_bf16(v0[0], v0[1]); w.y = cvt_pk_bf16(v0[2], v0[3]); w.z = cvt_pk_bf16(v1[0], v1[1]); w.w = cvt_pk_bf16(v1[2], v1[3]);
                    *(v4u*)(rowp + bj * HALF) = w; }
                if (isv) { s1 += __shfl_xor(s1, 16); s1 += __shfl_xor(s1, 32); s2 += __shfl_xor(s2, 16); s2 += __shfl_xor(s2, 32);
                    if (fq == 0) *(f32x2*)(vstat + ((size_t)row * 48 + (u.pn - 12) * 4 + wc) * 2) = (f32x2){s1, s2}; }
            }
    }
};

struct EpiRes {
    static constexpr bool PERM = false;
    const float* base; float* out; const float* bias; bf16* xb; float* ssout;
    __device__ __forceinline__ void operator()(AccT acc, const Unit& u, int wr, int wc, int fr, int fq) const {
        const int col0 = u.pn * BM + wc * 32 + 4 * fq;
        f32x4 bv[2][2];
#pragma unroll
        for (int bj = 0; bj < 2; ++bj)
#pragma unroll
            for (int n = 0; n < 2; ++n) bv[bj][n] = bias ? *(const f32x4*)(bias + col0 + bj * HALF + n * 16) : (f32x4){0.f, 0.f, 0.f, 0.f};
#pragma unroll
        for (int ai = 0; ai < 2; ++ai)
#pragma unroll
            for (int m = 0; m < 4; ++m) {
                const int row = u.r0 + ai * HALF + wr * 64 + m * 16 + fr; const size_t off = (size_t)row * D + col0; float s2 = 0.f;
#pragma unroll
                for (int bj = 0; bj < 2; ++bj)
#pragma unroll
                    for (int n = 0; n < 2; ++n) {
                        const f32x4 v = *(const f32x4*)(base + off + bj * HALF + n * 16) + acc[ai][bj][m][n] + bv[bj][n];
                        *(f32x4*)(out + off + bj * HALF + n * 16) = v;
                        s2 += (v[0] * v[0] + v[1] * v[1]) + (v[2] * v[2] + v[3] * v[3]);
                        if (xb) { v2u w; w.x = cvt_pk_bf16(v[0], v[1]); w.y = cvt_pk_bf16(v[2], v[3]); *(v2u*)(xb + off + bj * HALF + n * 16) = w; } }
                if (ssout) { s2 += __shfl_xor(s2, 16); s2 += __shfl_xor(s2, 32); if (fq == 0) ssout[(size_t)row * 16 + u.pn * 4 + wc] = s2; }
            }
    }
};

template <bool MOE> struct EpiHid {
    static constexpr bool PERM = true;
    bf16* O; int ldh; const float* ss; const float* r4; const int* toklist;
    __device__ __forceinline__ void operator()(AccT acc, const Unit& u, int wr, int wc, int fr, int fq) const {
        const int col0 = u.pn * HALF + wc * 32 + 8 * fq;
#pragma unroll
        for (int ai = 0; ai < 2; ++ai)
#pragma unroll
            for (int m = 0; m < 4; ++m) {
                const int tr = ai * HALF + wr * 64 + m * 16 + fr; const int row = u.r0 + tr; float r; bool valid = true;
                if (MOE) { valid = tr < u.cnt; const int pos = u.pm * BM + tr; const int tok = valid ? toklist[u.e * M + pos] : 0; r = r4[tok]; }
                else r = row_rscale(ss, row, fq);
                f32x4 g0 = acc[ai][0][m][0] * r, g1 = acc[ai][0][m][1] * r, u0 = acc[ai][1][m][0] * r, u1 = acc[ai][1][m][1] * r;
#pragma unroll
                for (int j = 0; j < 4; ++j) { g0[j] = g0[j] * sigmoid_f(g0[j]) * u0[j]; g1[j] = g1[j] * sigmoid_f(g1[j]) * u1[j]; }
                v4u w; w.x = cvt_pk_bf16(g0[0], g0[1]); w.y = cvt_pk_bf16(g0[2], g0[3]); w.z = cvt_pk_bf16(g1[0], g1[1]); w.w = cvt_pk_bf16(g1[2], g1[3]);
                if (valid) *(v4u*)(O + (size_t)row * ldh + col0) = w;
            }
    }
};

template <bool MOE> struct EpiBf {
    static constexpr bool PERM = true;
    bf16* O; int ldc; const float* slotw;
    __device__ __forceinline__ void operator()(AccT acc, const Unit& u, int wr, int wc, int fr, int fq) const {
        const int col0 = u.pn * BM + wc * 32 + 8 * fq;
#pragma unroll
        for (int ai = 0; ai < 2; ++ai)
#pragma unroll
            for (int m = 0; m < 4; ++m) {
                const int tr = ai * HALF + wr * 64 + m * 16 + fr; const int row = u.r0 + tr; float sc = 1.f; bool valid = true;
                if (MOE) { valid = tr < u.cnt; sc = valid ? slotw[u.e * M + u.pm * BM + tr] : 0.f; }
                bf16* rowp = O + (size_t)row * ldc + col0;
#pragma unroll
                for (int bj = 0; bj < 2; ++bj) { const f32x4 v0 = acc[ai][bj][m][0] * sc, v1 = acc[ai][bj][m][1] * sc;
                    v4u w; w.x = cvt_pk_bf16(v0[0], v0[1]); w.y = cvt_pk_bf16(v0[2], v0[3]); w.z = cvt_pk_bf16(v1[0], v1[1]); w.w = cvt_pk_bf16(v1[2], v1[3]);
                    if (valid) *(v4u*)(rowp + bj * HALF) = w; }
            }
    }
};

struct EpiPle {
    static constexpr bool PERM = false;
    float* x; const bf16* proj; const float* ss; bf16* xb; float* ssout;
    __device__ __forceinline__ void operator()(AccT acc, const Unit& u, int wr, int wc, int fr, int fq) const {
        const int col0 = u.pn * BM + wc * 32 + 4 * fq;
#pragma unroll
        for (int ai = 0; ai < 2; ++ai)
#pragma unroll
            for (int m = 0; m < 4; ++m) {
                const int row = u.r0 + ai * HALF + wr * 64 + m * 16 + fr; const size_t off = (size_t)row * D + col0; float s2 = 0.f;
                const float r = row_rscale(ss, row, fq);
#pragma unroll
                for (int bj = 0; bj < 2; ++bj)
#pragma unroll
                    for (int n = 0; n < 2; ++n) {
                        const size_t o = off + bj * HALF + n * 16;
                        const v2u pw = *(const v2u*)(proj + o); const f32x4 a = acc[ai][bj][m][n] * r; f32x4 v = *(const f32x4*)(x + o);
                        v[0] += bf_lo(pw.x) * sigmoid_f(a[0]); v[1] += bf_hi(pw.x) * sigmoid_f(a[1]); v[2] += bf_lo(pw.y) * sigmoid_f(a[2]); v[3] += bf_hi(pw.y) * sigmoid_f(a[3]);
                        *(f32x4*)(x + o) = v;
                        s2 += (v[0] * v[0] + v[1] * v[1]) + (v[2] * v[2] + v[3] * v[3]);
                        if (xb) { v2u w; w.x = cvt_pk_bf16(v[0], v[1]); w.y = cvt_pk_bf16(v[2], v[3]); *(v2u*)(xb + o) = w; } }
                if (ssout) { s2 += __shfl_xor(s2, 16); s2 += __shfl_xor(s2, 32); if (fq == 0) ssout[(size_t)row * 16 + u.pn * 4 + wc] = s2; }
            }
    }
};

struct EpiQKV {
    static constexpr bool PERM = false;
    bf16* Q; bf16* Kb; bf16* Vb; const float* bq; const float* bkv; const float* ss; const f32x2* rope;
    __device__ __forceinline__ void operator()(AccT acc, const Unit& u, int wr, int wc, int fr, int fq) const {
        const int dlo = 16 * (wc & 1) + 4 * fq;
        const int kind = u.pn < 4 ? 0 : (u.pn == 4 ? 1 : 2);
        f32x4 bv[2][2];
#pragma unroll
        for (int bj = 0; bj < 2; ++bj) {
            const int hcol = 64 * (2 * bj + (wc >> 1)) + dlo;
            const float* bp = kind == 0 ? bq + u.pn * BM + hcol : bkv + (kind - 1) * BM + hcol;
            bv[bj][0] = *(const f32x4*)bp; bv[bj][1] = *(const f32x4*)(bp + 32); }
#pragma unroll
        for (int ai = 0; ai < 2; ++ai)
#pragma unroll
            for (int m = 0; m < 4; ++m) {
                const int row = u.r0 + ai * HALF + wr * 64 + m * 16 + fr; const float r = row_rscale(ss, row, fq);
                const f32x2* rp = rope + (size_t)(row & (SEQ - 1)) * 32 + dlo;
                const f32x4 cs01 = *(const f32x4*)rp, cs23 = *(const f32x4*)(rp + 2);
                const float cc[4] = {cs01[0], cs01[2], cs23[0], cs23[2]}, sn[4] = {cs01[1], cs01[3], cs23[1], cs23[3]};
#pragma unroll
                for (int bj = 0; bj < 2; ++bj) {
                    const int hcol = 64 * (2 * bj + (wc >> 1)) + dlo;
                    f32x4 lo = acc[ai][bj][m][0] * r + bv[bj][0], hi = acc[ai][bj][m][1] * r + bv[bj][1];
                    if (kind < 2) {
#pragma unroll
                        for (int j = 0; j < 4; ++j) { const float a = lo[j], b = hi[j]; lo[j] = a * cc[j] - b * sn[j]; hi[j] = b * cc[j] + a * sn[j]; }
                    }
                    if (kind == 0) { lo = lo * QSCALE; hi = hi * QSCALE; }
                    v2u wl, wh; wl.x = cvt_pk_bf16(lo[0], lo[1]); wl.y = cvt_pk_bf16(lo[2], lo[3]); wh.x = cvt_pk_bf16(hi[0], hi[1]); wh.y = cvt_pk_bf16(hi[2], hi[3]);
                    bf16* dst = kind == 0 ? Q + (size_t)row * D + u.pn * BM + hcol : (kind == 1 ? Kb : Vb) + (size_t)row * 256 + hcol;
                    *(v2u*)dst = wl; *(v2u*)(dst + 32) = wh; }
            }
    }
};
}

struct Args { const float* in[31]; float* out; unsigned char* ws; int ph_lo, ph_hi, li, pad; };

struct Frame {
    LAS unsigned char* lds; volatile LAS unsigned* MISC; unsigned* ctl; unsigned char* ws;
    int tid, lane, wave, G, bid;
};

__device__ __forceinline__ int dest_row(int mode, int off, int n) {
    if (mode == 1) return ((n >> 7) << 8) + (n & 127) + off;
    if (mode == 2) return ((n & ~48) | ((n & 16) << 1) | ((n & 32) >> 1)) + off;
    return n + off;
}
__device__ __forceinline__ void p0_transpose_item(const float* W, int K, int N, const float* gain, bf16* WT, int mode, int off, LAS float* scr, int item, int lane) {
    const int nblk = N / 32, kb = item / nblk, nb = item % nblk, k0 = 64 * kb, n0 = 32 * nb;
#pragma unroll 8
    for (int i = 0; i < 32; ++i) { const int kk = 2 * i + (lane >> 5); const float g = gain ? gain[k0 + kk] : 1.0f; scr[kk * 33 + (lane & 31)] = W[(size_t)(k0 + kk) * N + n0 + (lane & 31)] * g; }
    LDS_WAIT(); asm volatile("" ::: "memory");
    const int c = lane & 7;
#pragma unroll
    for (int j = 0; j < 4; ++j) { const int n = (lane >> 3) + 8 * j; const LAS float* s = scr + (8 * c) * 33 + n;
        v4u o; o.x = cvt_pk_bf16(s[0 * 33], s[1 * 33]); o.y = cvt_pk_bf16(s[2 * 33], s[3 * 33]); o.z = cvt_pk_bf16(s[4 * 33], s[5 * 33]); o.w = cvt_pk_bf16(s[6 * 33], s[7 * 33]);
        *(v4u*)(WT + (size_t)dest_row(mode, off, n0 + n) * K + k0 + 8 * c) = o; }
    LDS_WAIT(); asm volatile("" ::: "memory");
}

#define IN_(k) ((const float*)args.in[k])

__global__ void __launch_bounds__(NWAVES * 64, 2) fwd_kernel(Args args) {
    extern __shared__ __attribute__((aligned(16))) unsigned char lds_raw[];
    Frame F;
    F.lds = (LAS unsigned char*)lds_raw;
    F.MISC = (volatile LAS unsigned*)(F.lds + MISC_OFF);
    F.tid = threadIdx.x; F.lane = F.tid & 63; F.wave = __builtin_amdgcn_readfirstlane(F.tid >> 6);
    F.G = gridDim.x; F.bid = blockIdx.x;
    F.ws = args.ws; F.ctl = (unsigned*)(args.ws + WS_CTL);
    unsigned char* ws = args.ws;
    const int tid = F.tid, lane = F.lane, wave = F.wave, G = F.G, bid = F.bid;
    const int gw = bid * NWAVES + wave, NGW = G * NWAVES;

    for (int u = tid; u < 128; u += NWAVES * 64) ((LAS unsigned*)(F.lds + MISC_OFF))[u] = 0u;
    __syncthreads();
    constexpr bool ONE = (MK_N_LAUNCHES == 1);
    XcdBarrier bar; bar.bar = F.ctl + CW_BAR; bar.x = 0; bar.st = nullptr;
    if (ONE) bar = xcd_barrier_post(F.ctl + CW_BAR, F.MISC + 8);
#define GRID_BAR() do { if (ONE) xcd_barrier(bar); } while (0)
    const int lo = args.ph_lo, hi = args.ph_hi;
#define IN(k) (lo <= (k) && (k) < hi)

    bf16* const Win_t = (bf16*)(ws + WS_WIN); bf16* const Wout_t = (bf16*)(ws + WS_WOUT); bf16* const Wgu_t = (bf16*)(ws + WS_WGU); bf16* const Wd_t = (bf16*)(ws + WS_WD);
    bf16* const Wpg0_t = (bf16*)(ws + WS_WPG0); bf16* const Wpp0_t = (bf16*)(ws + WS_WPP0); bf16* const Wpg1_t = (bf16*)(ws + WS_WPG1); bf16* const Wpp1_t = (bf16*)(ws + WS_WPP1);
    bf16* const Wqkv_t = (bf16*)(ws + WS_WQKV); bf16* const Wo_t = (bf16*)(ws + WS_WO); bf16* const MWgu_t = (bf16*)(ws + WS_MWGU); bf16* const MWd_t = (bf16*)(ws + WS_MWD);
    bf16* const XB0 = (bf16*)(ws + WS_XB0); bf16* const XB1 = (bf16*)(ws + WS_XB1); bf16* const PB = (bf16*)(ws + WS_PB);
    bf16* const UV = (bf16*)(ws + WS_UV); bf16* const HID = (bf16*)(ws + WS_HID); bf16* const PROJ = (bf16*)(ws + WS_PROJ);
    bf16* const Qb = (bf16*)(ws + WS_Q); bf16* const Kb = (bf16*)(ws + WS_K); bf16* const Vb = (bf16*)(ws + WS_V);
    bf16* const HIDM = (bf16*)(ws + WS_HIDM); bf16* const YS = (bf16*)(ws + WS_YS);
    float* const SS0 = (float*)(ws + WS_SS); float* const SS1 = SS0 + M * 16; float* const SS2 = SS1 + M * 16; float* const SS3 = SS2 + M * 16; float* const SS5 = SS3 + M * 16;
    float* const R4 = (float*)(ws + WS_R4); unsigned* const TOKSLOT = (unsigned*)(ws + WS_TOKSLOT); int* const TOKLIST = (int*)(ws + WS_TOKLIST); float* const SLOTW = (float*)(ws + WS_SLOTW);
    float* const WR = (float*)(ws + WS_WR); float* const VSTAT = (float*)(ws + WS_VSTAT); f32x2* const ROPE = (f32x2*)(ws + WS_ROPE);
    float* const X = args.out;
    unsigned* const GCNT = F.ctl + CW_CNT;

    if (IN(0)) {
        LAS float* scr = (LAS float*)(F.lds + wave * 16384);
        constexpr int I_WIN = (D / 64) * (GF / 32), I_WOUT = (GH / 64) * (D / 32), I_FG = (D / 64) * (FFD / 32), I_FD = (FFD / 64) * (D / 32), I_PG = (D / 64) * (D / 32), I_PP = (PLE / 64) * (D / 32),
                      I_WQ = (D / 64) * (D / 32), I_WKV = (D / 64) * (512 / 32), I_WO = I_WQ, I_MG = (D / 64) * (FFE / 32), I_MD = (FFE / 64) * (D / 32);
        constexpr int NITEMS = I_WIN + I_WOUT + 2 * I_FG + I_FD + 2 * I_PG + 2 * I_PP + I_WQ + I_WKV + I_WO + NE * (2 * I_MG + I_MD);
        for (int it = gw; it < NITEMS; it += NGW) {
            int r = it;
            if (r < I_WIN) { p0_transpose_item(IN_(4), D, GF, IN_(2), Win_t, 0, 0, scr, r, lane); continue; } r -= I_WIN;
            if (r < I_WOUT) { p0_transpose_item(IN_(10), GH, D, nullptr, Wout_t, 0, 0, scr, r, lane); continue; } r -= I_WOUT;
            if (r < I_FG) { p0_transpose_item(IN_(20), D, FFD, IN_(3), Wgu_t, 1, 0, scr, r, lane); continue; } r -= I_FG;
            if (r < I_FG) { p0_transpose_item(IN_(21), D, FFD, IN_(3), Wgu_t, 1, 128, scr, r, lane); continue; } r -= I_FG;
            if (r < I_FD) { p0_transpose_item(IN_(22), FFD, D, nullptr, Wd_t, 0, 0, scr, r, lane); continue; } r -= I_FD;
            if (r < I_PG) { p0_transpose_item(IN_(29), D, D, IN_(28), Wpg0_t, 0, 0, scr, r, lane); continue; } r -= I_PG;
            if (r < I_PG) { p0_transpose_item(IN_(29) + D * D, D, D, IN_(28) + D, Wpg1_t, 0, 0, scr, r, lane); continue; } r -= I_PG;
            if (r < I_PP) { p0_transpose_item(IN_(27), PLE, D, nullptr, Wpp0_t, 0, 0, scr, r, lane); continue; } r -= I_PP;
            if (r < I_PP) { p0_transpose_item(IN_(27) + PLE * D, PLE, D, nullptr, Wpp1_t, 0, 0, scr, r, lane); continue; } r -= I_PP;
            if (r < I_WQ) { p0_transpose_item(IN_(15), D, D, IN_(2) + D, Wqkv_t, 2, 0, scr, r, lane); continue; } r -= I_WQ;
            if (r < I_WKV) { p0_transpose_item(IN_(13), D, 512, IN_(12), Wqkv_t, 2, 1024, scr, r, lane); continue; } r -= I_WKV;
            if (r < I_WO) { p0_transpose_item(IN_(18), D, D, nullptr, Wo_t, 0, 0, scr, r, lane); continue; } r -= I_WO;
            { constexpr int PER_E = 2 * I_MG + I_MD; const int e = r / PER_E; int q = r % PER_E;
              if (q < I_MG) { p0_transpose_item(IN_(24) + (size_t)e * D * FFE, D, FFE, IN_(3) + D, MWgu_t + (size_t)e * 7168 * D, 1, 0, scr, q, lane); continue; } q -= I_MG;
              if (q < I_MG) { p0_transpose_item(IN_(25) + (size_t)e * D * FFE, D, FFE, IN_(3) + D, MWgu_t + (size_t)e * 7168 * D, 1, 128, scr, q, lane); continue; } q -= I_MG;
              p0_transpose_item(IN_(26) + (size_t)e * FFE * D, FFE, D, nullptr, MWd_t + (size_t)e * D * FFE, 0, 0, scr, q, lane); }
        }
        for (int m = gw; m < M; m += NGW) {
            const f32x4* xr = (const f32x4*)(IN_(0) + (size_t)m * D) + lane; f32x4 v[4]; float s = 0.f;
#pragma unroll
            for (int j = 0; j < 4; ++j) { v[j] = xr[64 * j]; s += (v[j].x * v[j].x + v[j].y * v[j].y) + (v[j].z * v[j].z + v[j].w * v[j].w); }
            s = wave_sum(s);
            v2u* o8 = (v2u*)(XB0 + (size_t)m * D) + lane;
#pragma unroll
            for (int j = 0; j < 4; ++j) { v2u w; w.x = cvt_pk_bf16(v[j].x, v[j].y); w.y = cvt_pk_bf16(v[j].z, v[j].w); o8[64 * j] = w; }
            if (lane < 16) SS0[(size_t)m * 16 + lane] = lane == 0 ? s : 0.f;
        }
        for (int i = bid * (NWAVES * 64) + tid; i < 2 * M * PLE / 8; i += G * NWAVES * 64) {
            const f32x4 a = ((const f32x4*)IN_(1))[2 * i], b = ((const f32x4*)IN_(1))[2 * i + 1];
            v4u w; w.x = cvt_pk_bf16(a.x, a.y); w.y = cvt_pk_bf16(a.z, a.w); w.z = cvt_pk_bf16(b.x, b.y); w.w = cvt_pk_bf16(b.z, b.w);
            ((v4u*)PB)[i] = w;
        }
        for (int i = bid * (NWAVES * 64) + tid; i < SEQ * 32; i += G * NWAVES * 64) {
            const int pos = i >> 5, fi = i & 31;
            const float freq = exp2f(-(float)fi * (13.287712379549449f / 32.0f));
            const float ang = (float)pos * freq;
            const double rev = (double)ang * 0.15915494309189535; const double fr_ = rev - __builtin_rint(rev);
            const float xr = (float)fr_;
            ROPE[i] = (f32x2){__builtin_amdgcn_cosf(xr), __builtin_amdgcn_sinf(xr)};
        }
        for (int i = bid * (NWAVES * 64) + tid; i < NE * D; i += G * NWAVES * 64) { const int e = i >> 10, k = i & 1023; WR[i] = IN_(3)[D + k] * IN_(23)[k * NE + e]; }
        GRID_BAR();
    }

    if (IN(1)) {
        pg8::StaticOrder S; S.init(M, GF, D, D, G, bid, XB0, Win_t);
        pg8::EpiUV E{UV, IN_(5), SS0, VSTAT};
        pg8::gemm_phase<pg8::EpiUV, pg8::StaticOrder, true, false>(F.lds, D, S, E);
        GRID_BAR();
    }

    if (IN(2)) {
        constexpr int WSTR = 136;
        LAS bf16* WSL = (LAS bf16*)(F.lds);
        LAS bf16* VT = (LAS bf16*)(F.lds + 128 * WSTR * 2);
        LAS f32x2* STAT = (LAS f32x2*)(F.lds + 128 * WSTR * 2 + 192 * WSTR * 2);
        const float* lng = IN_(6); const float* lnb = IN_(7); const float* wsrc = IN_(8); const float* bsrc = IN_(9);
        for (int id = bid; id < 2048; id += G) {
            const int hf = id & 1, g = (id >> 1) & 7, c = id >> 4; const int row0 = 128 * c, ch0 = GD * g + 192 * hf;
            if (tid < 128) {
                const f32x4* vp = (const f32x4*)(VSTAT + (size_t)(row0 + tid) * 96); float s1 = 0.f, s2 = 0.f;
#pragma unroll 4
                for (int j = 0; j < 24; ++j) { const f32x4 q = vp[j]; s1 += q.x + q.z; s2 += q.y + q.w; }
                const float mean = s1 * (1.0f / GH); float var = s2 * (1.0f / GH) - mean * mean; var = var < 0.f ? 0.f : var;
                STAT[tid] = (f32x2){mean, __builtin_amdgcn_rsqf(var + EPS)};
            }
            for (int idx = tid; idx < 2048; idx += NWAVES * 64) {
                const int t = idx >> 4, s0 = (idx & 15) * 8; const f32x4* wp = (const f32x4*)(wsrc + ((size_t)g * 128 + t) * 128 + s0);
                const f32x4 a = wp[0], b = wp[1]; float w8[8] = {a.x, a.y, a.z, a.w, b.x, b.y, b.z, b.w};
#pragma unroll
                for (int j = 0; j < 8; ++j) w8[j] = (s0 + j <= t) ? w8[j] : 0.f;
                v4u o; o.x = cvt_pk_bf16(w8[0], w8[1]); o.y = cvt_pk_bf16(w8[2], w8[3]); o.z = cvt_pk_bf16(w8[4], w8[5]); o.w = cvt_pk_bf16(w8[6], w8[7]);
                *(LAS v4u*)(WSL + t * WSTR + s0) = o;
            }
            __syncthreads();
            for (int idx = tid; idx < 128 * 24; idx += NWAVES * 64) {
                const int s = idx & 127, cg = idx >> 7; const int ch = ch0 + 8 * cg;
                const v4u raw = *(const v4u*)(UV + (size_t)(row0 + s) * GF + GH + ch);
                const f32x2 st = STAT[s];
                const f32x4 g0 = *(const f32x4*)(lng + ch), g1 = *(const f32x4*)(lng + ch + 4), b0 = *(const f32x4*)(lnb + ch), b1 = *(const f32x4*)(lnb + ch + 4);
                float v8[8] = {bf_lo(raw.x), bf_hi(raw.x), bf_lo(raw.y), bf_hi(raw.y), bf_lo(raw.z), bf_hi(raw.z), bf_lo(raw.w), bf_hi(raw.w)};
                const float gg[8] = {g0.x, g0.y, g0.z, g0.w, g1.x, g1.y, g1.z, g1.w}, bb[8] = {b0.x, b0.y, b0.z, b0.w, b1.x, b1.y, b1.z, b1.w};
#pragma unroll
                for (int j = 0; j < 8; j += 2) {
                    const float y0 = (v8[j] - st.x) * st.y * gg[j] + bb[j], y1 = (v8[j + 1] - st.x) * st.y * gg[j + 1] + bb[j + 1];
                    const unsigned w = cvt_pk_bf16(y0, y1);
                    VT[(8 * cg + j) * WSTR + s] = (bf16)(w & 0xffffu); VT[(8 * cg + j + 1) * WSTR + s] = (bf16)(w >> 16); }
            }
            __syncthreads();
            {
                const int tl = lane & 15, kg = lane >> 4; const int t = 16 * wave + tl; const int nks = (wave + 2) >> 1;
                f32x4 acc[12];
#pragma unroll
                for (int cb = 0; cb < 12; ++cb) acc[cb] = (f32x4){0.f, 0.f, 0.f, 0.f};
                for (int ks = 0; ks < nks; ++ks) {
                    const bf16x8 wf = *(const LAS bf16x8*)(WSL + t * WSTR + 32 * ks + 8 * kg);
#pragma unroll
                    for (int cb = 0; cb < 12; ++cb) { const bf16x8 vf = *(const LAS bf16x8*)(VT + (16 * cb + tl) * WSTR + 32 * ks + 8 * kg);
                        acc[cb] = __builtin_amdgcn_mfma_f32_16x16x32_bf16(vf, wf, acc[cb], 0, 0, 0); }
                }
                const float bsv = bsrc[g * 128 + t];
                bf16* up = UV + (size_t)(row0 + t) * GF + ch0 + 4 * kg;
#pragma unroll
                for (int cb = 0; cb < 12; ++cb) { const v2u uw = *(const v2u*)(up + 16 * cb);
                    const float o0 = bf_lo(uw.x) * (acc[cb][0] + bsv), o1 = bf_hi(uw.x) * (acc[cb][1] + bsv), o2 = bf_lo(uw.y) * (acc[cb][2] + bsv), o3 = bf_hi(uw.y) * (acc[cb][3] + bsv);
                    v2u w; w.x = cvt_pk_bf16(o0, o1); w.y = cvt_pk_bf16(o2, o3); *(v2u*)(up + 16 * cb) = w; }
            }
            __syncthreads();
        }
        GRID_BAR();
    }

    if (IN(3)) {
        pg8::StaticOrder S; S.init(M, D, GH, GF, G, bid, UV, Wout_t);
        pg8::EpiRes E{IN_(0), X, IN_(11), XB0, SS1};
        pg8::gemm_phase<pg8::EpiRes, pg8::StaticOrder, false, false>(F.lds, GH, S, E);
        GRID_BAR();
    }

    if (IN(4)) {
        pg8::StaticOrder S; S.init(M, 2 * FFD, D, D, G, bid, XB0, Wgu_t);
        pg8::EpiHid<false> E{HID, FFD, SS1, nullptr, nullptr};
        pg8::gemm_phase<pg8::EpiHid<false>, pg8::StaticOrder, true, false>(F.lds, D, S, E);
        GRID_BAR();
    }

    if (IN(5)) {
        { pg8::StaticOrder S; S.init(M, D, FFD, FFD, G, bid, HID, Wd_t);
          pg8::EpiRes E{X, X, nullptr, XB0, SS2};
          pg8::gemm_phase<pg8::EpiRes, pg8::StaticOrder, false, false>(F.lds, FFD, S, E); }
        { pg8::StaticOrder S; S.init(M, D, PLE, PLE, G, bid, PB, Wpp0_t);
          pg8::EpiBf<false> E{PROJ, D, nullptr};
          pg8::gemm_phase<pg8::EpiBf<false>, pg8::StaticOrder, false, false>(F.lds, PLE, S, E); }
        GRID_BAR();
    }

    if (IN(6)) {
        pg8::StaticOrder S; S.init(M, D, D, D, G, bid, XB0, Wpg0_t);
        pg8::EpiPle E{X, PROJ, SS2, XB1, SS3};
        pg8::gemm_phase<pg8::EpiPle, pg8::StaticOrder, false, false>(F.lds, D, S, E);
        GRID_BAR();
    }

    if (IN(7)) {
        pg8::StaticOrder S; S.init(M, NQKV, D, D, G, bid, XB1, Wqkv_t);
        pg8::EpiQKV E{Qb, Kb, Vb, IN_(16), IN_(14), SS3, ROPE};
        pg8::gemm_phase<pg8::EpiQKV, pg8::StaticOrder, true, false>(F.lds, D, S, E);
        GRID_BAR();
    }

    if (IN(8)) {
        constexpr int KSTR = 72, VSTR = 264;
        LAS bf16* KL = (LAS bf16*)(F.lds);
        LAS bf16* VT = (LAS bf16*)(F.lds + 256 * KSTR * 2);
        const float* sinks = IN_(17);
        for (int id = bid; id < 512; id += G) {
            const int qb = id & 31, g = (id >> 5) & 3, b = id >> 7;
            const long tok0 = (long)b * SEQ + 128 * qb - 128;
            for (int idx = tid; idx < 2048; idx += NWAVES * 64) {
                const int kj = idx >> 3, c = idx & 7; const bool valid = (qb > 0) || (kj >= 128);
                v4u val = (v4u){0u, 0u, 0u, 0u};
                if (valid) val = *(const v4u*)(Kb + (size_t)(tok0 + kj) * 256 + 64 * g + 8 * c);
                *(LAS v4u*)(KL + kj * KSTR + 8 * c) = val;
            }
            for (int idx = tid; idx < 2048; idx += NWAVES * 64) {
                const int kj = idx & 255, c = idx >> 8; const bool valid = (qb > 0) || (kj >= 128);
                v4u raw = (v4u){0u, 0u, 0u, 0u};
                if (valid) raw = *(const v4u*)(Vb + (size_t)(tok0 + kj) * 256 + 64 * g + 8 * c);
                LAS bf16* vp = VT + (8 * c) * VSTR + kj;
                vp[0 * VSTR] = (bf16)(raw.x & 0xffffu); vp[1 * VSTR] = (bf16)(raw.x >> 16); vp[2 * VSTR] = (bf16)(raw.y & 0xffffu); vp[3 * VSTR] = (bf16)(raw.y >> 16);
                vp[4 * VSTR] = (bf16)(raw.z & 0xffffu); vp[5 * VSTR] = (bf16)(raw.z >> 16); vp[6 * VSTR] = (bf16)(raw.w & 0xffffu); vp[7 * VSTR] = (bf16)(raw.w >> 16);
            }
            __syncthreads();
            const int ql = lane & 15, kg = lane >> 4, i = wave;
            for (int it = 0; it < 4; ++it) {
                const int head = 4 * g + it; const size_t qrow = (size_t)b * SEQ + 128 * qb + 16 * i + ql;
                bf16* qp = Qb + qrow * D + 64 * head;
                const bf16x8 qf0 = *(const bf16x8*)(qp + 8 * kg), qf1 = *(const bf16x8*)(qp + 32 + 8 * kg);
                f32x4 sc[9];
#pragma unroll
                for (int jb = 0; jb < 9; ++jb) {
                    const LAS bf16* kp = KL + (16 * (i + jb) + ql) * KSTR + 8 * kg;
                    const bf16x8 a0 = *(const LAS bf16x8*)kp, a1 = *(const LAS bf16x8*)(kp + 32);
                    sc[jb] = __builtin_amdgcn_mfma_f32_16x16x32_bf16(a0, qf0, (f32x4){0.f, 0.f, 0.f, 0.f}, 0, 0, 0);
                    sc[jb] = __builtin_amdgcn_mfma_f32_16x16x32_bf16(a1, qf1, sc[jb], 0, 0, 0);
                }
                const int qi = 16 * i + ql; const float sink = sinks[head] * LOG2E; float mx = sink;
#pragma unroll
                for (int jb = 0; jb < 9; ++jb)
#pragma unroll
                    for (int r = 0; r < 4; ++r) { const int kj = 16 * (i + jb) + 4 * kg + r; const bool valid = (kj > qi) && (kj <= qi + 128) && ((qb > 0) || (kj >= 128));
                        sc[jb][r] = valid ? sc[jb][r] : -INFINITY; mx = fmaxf(mx, sc[jb][r]); }
                mx = fmaxf(mx, __shfl_xor(mx, 16)); mx = fmaxf(mx, __shfl_xor(mx, 32));
                float sum = 0.f;
#pragma unroll
                for (int jb = 0; jb < 9; ++jb)
#pragma unroll
                    for (int r = 0; r < 4; ++r) { const float p = fast_exp2(sc[jb][r] - mx); sc[jb][r] = p; sum += p; }
                sum += __shfl_xor(sum, 16); sum += __shfl_xor(sum, 32);
                const float inv = fast_rcp(sum + fast_exp2(sink - mx));
                f32x4 o[4];
#pragma unroll
                for (int db = 0; db < 4; ++db) o[db] = (f32x4){0.f, 0.f, 0.f, 0.f};
#pragma unroll
                for (int pp = 0; pp < 5; ++pp) {
                    v4u pw; pw.x = cvt_pk_bf16(sc[2 * pp][0], sc[2 * pp][1]); pw.y = cvt_pk_bf16(sc[2 * pp][2], sc[2 * pp][3]);
                    if (pp < 4) { pw.z = cvt_pk_bf16(sc[2 * pp + 1 < 9 ? 2 * pp + 1 : 8][0], sc[2 * pp + 1 < 9 ? 2 * pp + 1 : 8][1]); pw.w = cvt_pk_bf16(sc[2 * pp + 1 < 9 ? 2 * pp + 1 : 8][2], sc[2 * pp + 1 < 9 ? 2 * pp + 1 : 8][3]); }
                    else { pw.z = 0u; pw.w = 0u; }
                    const bf16x8 pf = __builtin_bit_cast(bf16x8, pw);
#pragma unroll
                    for (int db = 0; db < 4; ++db) {
                        const LAS bf16* vp = VT + (16 * db + ql) * VSTR + 16 * (i + 2 * pp) + 4 * kg;
                        v4u vw; const v2u l2 = *(const LAS v2u*)vp; vw.x = l2.x; vw.y = l2.y;
                        if (pp < 4) { const v2u h2 = *(const LAS v2u*)(vp + 16); vw.z = h2.x; vw.w = h2.y; } else { vw.z = 0u; vw.w = 0u; }
                        o[db] = __builtin_amdgcn_mfma_f32_16x16x32_bf16(__builtin_bit_cast(bf16x8, vw), pf, o[db], 0, 0, 0);
                    }
                }
#pragma unroll
                for (int db = 0; db < 4; ++db) { v2u w; w.x = cvt_pk_bf16(o[db][0] * inv, o[db][1] * inv); w.y = cvt_pk_bf16(o[db][2] * inv, o[db][3] * inv);
                    *(v2u*)(qp + 16 * db + 4 * kg) = w; }
            }
            __syncthreads();
        }
        GRID_BAR();
    }

    if (IN(9)) {
        pg8::StaticOrder S; S.init(M, D, D, D, G, bid, Qb, Wo_t);
        pg8::EpiRes E{X, X, IN_(19), XB1, nullptr};
        pg8::gemm_phase<pg8::EpiRes, pg8::StaticOrder, false, false>(F.lds, D, S, E);
        GRID_BAR();
    }

    if (IN(10)) {
        LAS float* WRL = (LAS float*)(F.lds);
        LAS int* lcnt = (LAS int*)(F.lds + 32768);
        LAS unsigned* rec = (LAS unsigned*)(F.lds + 32768 + 64);
        for (int i = tid; i < NE * D / 4; i += NWAVES * 64) ((LAS f32x4*)WRL)[i] = ((const f32x4*)WR)[i];
        for (int chunk = bid; chunk < M / 64; chunk += G) {
            if (tid < 8) lcnt[tid] = 0;
            __syncthreads();
            for (int k = 0; k < 8; ++k) {
                const int tl = wave * 8 + k, tok = chunk * 64 + tl;
                const f32x4* xr = (const f32x4*)(X + (size_t)tok * D) + lane; f32x4 v[4]; float s = 0.f;
#pragma unroll
                for (int j = 0; j < 4; ++j) { v[j] = xr[64 * j]; s += (v[j].x * v[j].x + v[j].y * v[j].y) + (v[j].z * v[j].z + v[j].w * v[j].w); }
                float dot[8];
#pragma unroll
                for (int e = 0; e < 8; ++e) { float d = 0.f;
#pragma unroll
                    for (int j = 0; j < 4; ++j) { const f32x4 w = ((const LAS f32x4*)(WRL + e * D))[lane + 64 * j]; d += (v[j].x * w.x + v[j].y * w.y) + (v[j].z * w.z + v[j].w * w.w); }
                    dot[e] = d; }
                s = wave_sum(s);
#pragma unroll
                for (int e = 0; e < 8; ++e) dot[e] = wave_sum(dot[e]);
                const float r = __builtin_amdgcn_rsqf(s * (1.0f / D) + EPS);
                int e0 = 0; float v0 = dot[0] * r;
#pragma unroll
                for (int e = 1; e < 8; ++e) { const float l = dot[e] * r; if (l > v0) { v0 = l; e0 = e; } }
                int e1 = -1; float v1 = -INFINITY;
#pragma unroll
                for (int e = 0; e < 8; ++e) { const float l = dot[e] * r; if (e != e0 && l > v1) { v1 = l; e1 = e; } }
                const float w1 = fast_rcp(1.0f + fast_exp2((v0 - v1) * LOG2E)), w0 = 1.0f - w1;
                if (lane == 0) {
                    const int p0 = __hip_atomic_fetch_add(&lcnt[e0], 1, __ATOMIC_RELAXED, __HIP_MEMORY_SCOPE_WORKGROUP);
                    const int p1 = __hip_atomic_fetch_add(&lcnt[e1], 1, __ATOMIC_RELAXED, __HIP_MEMORY_SCOPE_WORKGROUP);
                    LAS unsigned* rp = rec + tl * 6; rp[0] = (unsigned)e0; rp[1] = (unsigned)e1; rp[2] = (unsigned)p0; rp[3] = (unsigned)p1; rp[4] = __float_as_uint(w0); rp[5] = __float_as_uint(w1);
                    R4[tok] = r;
                }
            }
            __syncthreads();
            if (tid < 8) lcnt[8 + tid] = (int)__hip_atomic_fetch_add(GCNT + 64 * tid, (unsigned)lcnt[tid], __ATOMIC_RELAXED, __HIP_MEMORY_SCOPE_AGENT);
            __syncthreads();
            if (tid < 64) {
                const int tok = chunk * 64 + tid; const LAS unsigned* rp = rec + tid * 6;
                const int e0 = (int)rp[0], e1 = (int)rp[1]; const int q0 = lcnt[8 + e0] + (int)rp[2], q1 = lcnt[8 + e1] + (int)rp[3];
                TOKLIST[e0 * M + q0] = tok; TOKLIST[e1 * M + q1] = tok; SLOTW[e0 * M + q0] = __uint_as_float(rp[4]); SLOTW[e1 * M + q1] = __uint_as_float(rp[5]);
                TOKSLOT[2 * tok] = ((unsigned)e0 << 16) | (unsigned)q0; TOKSLOT[2 * tok + 1] = ((unsigned)e1 << 16) | (unsigned)q1;
            }
            __syncthreads();
        }
        GRID_BAR();
    }

    LAS int* const etab = (LAS int*)(F.lds + MISC_OFF) + 32;
    if (IN(11) || IN(12) || IN(13)) {
        if (tid == 0) { int ts = 0, off = 0;
            for (int e = 0; e < 8; ++e) { const int cn = (int)__hip_atomic_load(GCNT + 64 * e, __ATOMIC_RELAXED, __HIP_MEMORY_SCOPE_AGENT); etab[e] = ts; etab[9 + e] = off; etab[18 + e] = cn; ts += (cn + 255) >> 8; off += cn; }
            etab[8] = ts; etab[17] = off; }
        __syncthreads();
    }

    if (IN(11)) {
        LAS unsigned* toktab = (LAS unsigned*)(F.lds + TOKTAB_OFF);
        pg8::MoeOrder S{etab, toktab, FFE / 128, G, bid, etab[8] * (FFE / 128), D, (const char*)XB1, (const char*)MWgu_t, (size_t)D * 2, (size_t)2 * FFE * D * 2, (size_t)256 * D * 2};
        { pg8::Unit u; for (int ui = 0; ui < 16 && S.next(ui, u); ++ui) { if (tid < 256) { const int tok = TOKLIST[u.e * M + (tid < u.cnt ? u.pm * 256 + tid : 0)]; toktab[ui * 256 + tid] = (unsigned)tok * (unsigned)(D * 2); } } }
        __syncthreads();
        pg8::EpiHid<true> E{HIDM, FFE, nullptr, R4, TOKLIST};
        pg8::gemm_phase<pg8::EpiHid<true>, pg8::MoeOrder, true, true>(F.lds, D, S, E);
        GRID_BAR();
    }

    if (IN(12)) {
        pg8::MoeOrder S{etab, nullptr, D / 256, G, bid, etab[8] * (D / 256), FFE, (const char*)HIDM, (const char*)MWd_t, (size_t)FFE * 2, (size_t)D * FFE * 2, (size_t)256 * FFE * 2};
        pg8::EpiBf<true> E{YS, D, SLOTW};
        pg8::gemm_phase<pg8::EpiBf<true>, pg8::MoeOrder, true, false>(F.lds, FFE, S, E);
        GRID_BAR();
    }

    if (IN(13)) {
        for (int m = gw; m < M; m += NGW) {
            const unsigned s0 = TOKSLOT[2 * m], s1 = TOKSLOT[2 * m + 1];
            const size_t r0 = (size_t)(etab[9 + (s0 >> 16)] + (int)(s0 & 0xffffu)), r1 = (size_t)(etab[9 + (s1 >> 16)] + (int)(s1 & 0xffffu));
            f32x4* xr = (f32x4*)(X + (size_t)m * D) + lane; const v2u* y0 = (const v2u*)(YS + r0 * D) + lane; const v2u* y1 = (const v2u*)(YS + r1 * D) + lane;
            v2u* o8 = (v2u*)(XB0 + (size_t)m * D) + lane; float s = 0.f;
#pragma unroll
            for (int j = 0; j < 4; ++j) { f32x4 v = xr[64 * j]; const v2u a = y0[64 * j], b = y1[64 * j];
                v.x += bf_lo(a.x) + bf_lo(b.x); v.y += bf_hi(a.x) + bf_hi(b.x); v.z += bf_lo(a.y) + bf_lo(b.y); v.w += bf_hi(a.y) + bf_hi(b.y);
                xr[64 * j] = v; s += (v.x * v.x + v.y * v.y) + (v.z * v.z + v.w * v.w);
                v2u w; w.x = cvt_pk_bf16(v.x, v.y); w.y = cvt_pk_bf16(v.z, v.w); o8[64 * j] = w; }
            s = wave_sum(s);
            if (lane < 16) SS5[(size_t)m * 16 + lane] = lane == 0 ? s : 0.f;
        }
        VM_WAIT(); __syncthreads();
        { pg8::StaticOrder S; S.init(M, D, PLE, PLE, G, bid, PB + (size_t)M * PLE, Wpp1_t);
          pg8::EpiBf<false> E{PROJ, D, nullptr};
          pg8::gemm_phase<pg8::EpiBf<false>, pg8::StaticOrder, false, false>(F.lds, PLE, S, E); }
        GRID_BAR();
    }

    if (IN(14)) {
        pg8::StaticOrder S; S.init(M, D, D, D, G, bid, XB0, Wpg1_t);
        pg8::EpiPle E{X, PROJ, SS5, nullptr, nullptr};
        pg8::gemm_phase<pg8::EpiPle, pg8::StaticOrder, false, false>(F.lds, D, S, E);
        GRID_BAR();
    }

    if (IN(15)) {
        const f32x4* gp = (const f32x4*)IN_(30) + lane;
        const f32x4 g0 = gp[0], g1 = gp[64], g2 = gp[128], g3 = gp[192];
        for (int m = gw; m < M; m += NGW) {
            f32x4* xr = (f32x4*)(X + (size_t)m * D) + lane; f32x4 v[4]; float s = 0.f;
#pragma unroll
            for (int j = 0; j < 4; ++j) { v[j] = xr[64 * j]; s += (v[j].x * v[j].x + v[j].y * v[j].y) + (v[j].z * v[j].z + v[j].w * v[j].w); }
            s = wave_sum(s); const float r = __builtin_amdgcn_rsqf(s * (1.0f / D) + EPS);
            xr[0] = v[0] * r * g0; xr[64] = v[1] * r * g1; xr[128] = v[2] * r * g2; xr[192] = v[3] * r * g3;
        }
    }
#undef IN
#undef GRID_BAR
}

constexpr int N_PHASES = 16;
extern "C" void kernel_launch(void* const* d_in, const int* in_sizes, int n_in, void* d_out, int out_size, void* d_ws, size_t ws_size, hipStream_t stream) {
    static int grid = 0;
    if (grid == 0) {
        if (n_in != 31 || out_size != M * D || ws_size < WS_END) { fprintf(stderr, "kernel_launch: unexpected shapes (n_in %d, out %d, ws %zu < %zu)\n", n_in, out_size, ws_size, (size_t)WS_END); grid = -1; return; }
        int dev = 0, cus = 0;
        if (hipGetDevice(&dev) != hipSuccess || hipDeviceGetAttribute(&cus, hipDeviceAttributeMultiprocessorCount, dev) != hipSuccess) { grid = -1; return; }
        if (hipFuncSetAttribute((const void*)fwd_kernel, hipFuncAttributeMaxDynamicSharedMemorySize, LDS_BYTES) != hipSuccess) { fprintf(stderr, "kernel_launch: hipFuncSetAttribute failed\n"); grid = -1; return; }
        int per_cu = 0;
        if (hipOccupancyMaxActiveBlocksPerMultiprocessor(&per_cu, (const void*)fwd_kernel, NWAVES * 64, LDS_BYTES) != hipSuccess || per_cu < 1) fprintf(stderr, "kernel_launch: occupancy query reports %d\n", per_cu);
        (void)hipGetLastError();
        grid = cus;
    }
    if (grid < 0) return;
    (void)in_sizes;
    if (hipMemsetAsync((char*)d_ws + WS_CTL, 0, CTL_ZERO_BYTES, stream) != hipSuccess) return;
    Args a{};
    for (int i = 0; i < 31; ++i) a.in[i] = (const float*)d_in[i];
    a.out = (float*)d_out; a.ws = (unsigned char*)d_ws;
    if (MK_N_LAUNCHES == 1) {
        a.ph_lo = 0; a.ph_hi = N_PHASES; a.li = 0;
        hipLaunchKernelGGL(fwd_kernel, dim3(grid), dim3(NWAVES * 64), LDS_BYTES, stream, a);
    } else {
        for (int li = 0; li < N_PHASES; ++li) { a.ph_lo = li; a.ph_hi = li + 1; a.li = li;
            hipLaunchKernelGGL(fwd_kernel, dim3(grid), dim3(NWAVES * 64), LDS_BYTES, stream, a); }
    }
}
```

```cpp
#include <hip/hip_runtime.h>
#include <cstdio>
#include <cstdint>

#ifndef MK_N_LAUNCHES
#define MK_N_LAUNCHES 1
#endif

#define GAS __attribute__((address_space(1)))
#define LAS __attribute__((address_space(3)))
typedef unsigned short bf16;
typedef unsigned v4u __attribute__((ext_vector_type(4)));
typedef unsigned v2u __attribute__((ext_vector_type(2)));
typedef float f32x4 __attribute__((ext_vector_type(4)));
typedef float f32x2 __attribute__((ext_vector_type(2)));
typedef short bf16x8 __attribute__((ext_vector_type(8)));
typedef short s16x4 __attribute__((ext_vector_type(4)));

constexpr int M = 16384, D = 1024, SEQ = 4096;
constexpr int GF = 6144, GH = 3072, GD = 384;
constexpr int FFD = 2816, NE = 8, FFE = 3584, PLE = 256;
constexpr int NQKV = 1536;
constexpr float EPS = 1e-6f;
constexpr float LOG2E = 1.4426950408889634f;
constexpr float QSCALE = 0.125f * LOG2E;

constexpr size_t MiB = 1u << 20;
constexpr size_t WS_CTL = 0, CTL_ZERO_BYTES = 1 * MiB;
constexpr size_t WS_SS = 1 * MiB;
constexpr size_t WS_R4 = 6 * MiB;
constexpr size_t WS_TOKSLOT = WS_R4 + 64 * 1024;
constexpr size_t WS_TOKLIST = WS_TOKSLOT + 128 * 1024;
constexpr size_t WS_SLOTW = WS_TOKLIST + 512 * 1024;
constexpr size_t WS_WR = WS_SLOTW + 512 * 1024;
constexpr size_t WS_VSTAT = 8 * MiB;
constexpr size_t WS_ROPE = 14 * MiB;
constexpr size_t WS_PB = 15 * MiB;
constexpr size_t WS_XB1 = 31 * MiB;
constexpr size_t WS_WPG1 = 63 * MiB;
constexpr size_t WS_WPP1 = 65 * MiB;
constexpr size_t WS_MWGU = 66 * MiB;
constexpr size_t WS_MWD = 178 * MiB;
constexpr size_t WS_B = 234 * MiB;
constexpr size_t WS_WIN = WS_B;
constexpr size_t WS_WOUT = WS_B + 12 * MiB;
constexpr size_t WS_WGU = WS_B + 18 * MiB;
constexpr size_t WS_WD = WS_B + 29 * MiB;
constexpr size_t WS_WPG0 = WS_B + 35 * MiB;
constexpr size_t WS_WPP0 = WS_B + 37 * MiB;
constexpr size_t WS_WQKV = WS_B + 38 * MiB;
constexpr size_t WS_WO = WS_B + 41 * MiB;
constexpr size_t WS_XB0 = WS_B + 43 * MiB;
constexpr size_t WS_UV = WS_B + 75 * MiB;
constexpr size_t WS_HID = WS_UV;
constexpr size_t WS_PROJ = WS_UV + 96 * MiB;
constexpr size_t WS_Q = WS_UV;
constexpr size_t WS_K = WS_UV + 32 * MiB;
constexpr size_t WS_V = WS_UV + 40 * MiB;
constexpr size_t WS_HIDM = WS_B;
constexpr size_t WS_YS = WS_MWGU;
constexpr size_t WS_END = WS_B + 267 * MiB;
static_assert(WS_HIDM + (size_t)(32768 + 256) * FFE * 2 <= WS_END, "hidm");
static_assert(WS_WR + 32768 <= WS_VSTAT, "misc");

constexpr int CW_TMO = 0, CW_BAR = 4096, CW_CNT = 8192;

constexpr int RING_BYTES = 131072;
constexpr int TOKTAB_OFF = RING_BYTES;
constexpr int MISC_OFF = RING_BYTES + 16384;
constexpr int LDS_BYTES = MISC_OFF + 512;
constexpr int NWAVES = 8;

#define RLX_AGENT __ATOMIC_RELAXED, __HIP_MEMORY_SCOPE_AGENT
#define LDS_WAIT() asm volatile("s_waitcnt lgkmcnt(0)" ::: "memory")
#define VM_WAIT() asm volatile("s_waitcnt vmcnt(0)" ::: "memory")
__device__ __forceinline__ unsigned cvt_pk_bf16(float lo, float hi) { unsigned r; asm volatile("v_cvt_pk_bf16_f32 %0, %1, %2" : "=v"(r) : "v"(lo), "v"(hi)); return r; }
__device__ __forceinline__ float bf_lo(unsigned w) { return __uint_as_float(w << 16); }
__device__ __forceinline__ float bf_hi(unsigned w) { return __uint_as_float(w & 0xffff0000u); }
__device__ __forceinline__ float fast_rcp(float x) { return __builtin_amdgcn_rcpf(x); }
__device__ __forceinline__ float fast_exp2(float x) { return __builtin_amdgcn_exp2f(x); }
__device__ __forceinline__ float sigmoid_f(float x) { return fast_rcp(1.0f + fast_exp2(-x * LOG2E)); }
__device__ __forceinline__ float gelu_tanh(float x) { const float u = 0.7978845608028654f * (x + 0.044715f * x * x * x); return x * fast_rcp(1.0f + fast_exp2(-2.0f * LOG2E * u)); }
__device__ __forceinline__ float wave_sum(float v) {
#pragma unroll
    for (int o = 1; o < 64; o <<= 1) v += __shfl_xor(v, o);
    return v;
}
__device__ __forceinline__ float row_rscale(const float* ss, int row, int fq) {
    const f32x4 v = *(const f32x4*)(ss + (size_t)row * 16 + 4 * fq);
    float s = (v.x + v.y) + (v.z + v.w);
    s += __shfl_xor(s, 16); s += __shfl_xor(s, 32);
    return __builtin_amdgcn_rsqf(s * (1.0f / D) + EPS);
}

#define XB_TMO      128
#define XB_XCNT(j)  (256  + 64 * (j))
#define XB_XSUB(j)  (1280 + 64 * (j))
#define XB_XGEN(j)  (2304 + 64 * (j))
#define XB_TOP      3328
#define XB_TOPGEN   3392
#define XCD_BAR_WORDS 3456
#define XB_SPIN_CAP (1u << 18)
__device__ __forceinline__ unsigned xb_ld(unsigned* p)              { return __hip_atomic_load(p, __ATOMIC_RELAXED, __HIP_MEMORY_SCOPE_AGENT); }
__device__ __forceinline__ unsigned xb_add(unsigned* p, unsigned v) { return __hip_atomic_fetch_add(p, v, __ATOMIC_RELAXED, __HIP_MEMORY_SCOPE_AGENT); }
__device__ __forceinline__ unsigned xb_xcc_id() { return (unsigned)__builtin_amdgcn_s_getreg((3 << 11) | 20) & 0xFu; }
#define XB_SPIN(cond, bar) do { unsigned _sp = 0; while (cond) { __builtin_amdgcn_s_sleep(1); \
    if ((++_sp & 255u) == 0u) { if (xb_ld(&(bar)[XB_TMO])) break; if (_sp > XB_SPIN_CAP) { atomicAdd(&(bar)[XB_TMO], 1u); break; } } } } while (0)
struct XcdBarrier { unsigned* bar; unsigned x; volatile LAS unsigned* st; };
__device__ __forceinline__ XcdBarrier xcd_barrier_post(unsigned* bar, volatile LAS unsigned* st) {
    XcdBarrier b; b.bar = bar; b.x = xb_xcc_id(); b.st = st;
    if (threadIdx.x == 0) (void)xb_add(&bar[XB_XCNT(b.x)], 1u);
    return b;
}
__device__ __forceinline__ void xcd_barrier_complete(unsigned* bar, unsigned x, unsigned& nloc, unsigned& nx) {
    const unsigned G = gridDim.x * gridDim.y * gridDim.z;
    unsigned sum, cnt, mine, sp = 0u;
    for (;;) {
        sum = 0u; cnt = 0u; mine = 0u;
#pragma unroll
        for (unsigned j = 0; j < 16; ++j) { const unsigned c = xb_ld(&bar[XB_XCNT(j)]); sum += c; cnt += (c > 0u) ? 1u : 0u; mine = (j == x) ? c : mine; }
        if (sum == G) break;
        __builtin_amdgcn_s_sleep(1);
        if ((++sp & 255u) == 0u) { if (xb_ld(&bar[XB_TMO])) break; if (sp > XB_SPIN_CAP) { atomicAdd(&bar[XB_TMO], 1u); break; } }
    }
    nloc = mine > 0u ? mine : 1u; nx = cnt > 0u ? cnt : 1u;
}
__device__ __forceinline__ void xcd_barrier(const XcdBarrier& b) {
    asm volatile("s_waitcnt vmcnt(0)" ::: "memory");
    __syncthreads();
    if (threadIdx.x == 0) {
        unsigned* bar = b.bar;
        __builtin_amdgcn_s_waitcnt(0);
        unsigned nloc = b.st[0], nx = b.st[1];
        if (nloc == 0u) { xcd_barrier_complete(bar, b.x, nloc, nx); b.st[0] = nloc; b.st[1] = nx; }
        const unsigned old = xb_add(&bar[XB_XSUB(b.x)], 1u);
        const unsigned gen = old / nloc;
        if (old + 1u == (gen + 1u) * nloc) {
            __builtin_amdgcn_fence(__ATOMIC_RELEASE, "agent");
            asm volatile("s_waitcnt vmcnt(0)" ::: "memory");
            const unsigned og = xb_add(&bar[XB_TOP], 1u);
            const unsigned tg = og / nx;
            if (og + 1u == (tg + 1u) * nx) xb_add(&bar[XB_TOPGEN], 1u);
            else XB_SPIN(xb_ld(&bar[XB_TOPGEN]) == tg, bar);
            __builtin_amdgcn_fence(__ATOMIC_ACQUIRE, "agent");
            xb_add(&bar[XB_XGEN(b.x)], 1u);
            asm volatile("s_waitcnt vmcnt(0)" ::: "memory");
        } else {
            XB_SPIN(xb_ld(&bar[XB_XGEN(b.x)]) == gen, bar);
            __builtin_amdgcn_fence(__ATOMIC_ACQUIRE, "agent");
            asm volatile("s_waitcnt vmcnt(0)" ::: "memory");
        }
    }
    __syncthreads();
}

namespace pg8 {
constexpr int BM = 256, BK = 64, HALF = 128, HTB = HALF * BK * 2, STAGE_BYTES = 8 * HTB, NXCD = 8, WGM = 8;
__host__ __device__ __forceinline__ int lds_byte(int r, int c) { const int st = (r >> 4) * 2 + (c >> 5), rr = r & 15, cc = c & 31, ob = rr * 64 + cc * 2; return st * 1024 + (ob ^ (((ob >> 9) & 1) << 5)); }
__host__ __device__ __forceinline__ void stage_rc(int b, int& R, int& C) { const int st = b / 1024, sb = b % 1024, swz = sb ^ (((sb >> 9) & 1) << 5); R = (st >> 1) * 16 + swz / 64; C = (st & 1) * 32 + (swz % 64) / 2; }
__host__ __device__ __forceinline__ int perm32(int rho) { const int n = rho >> 4, i = rho & 15; return 8 * (i >> 2) + 4 * n + (i & 3); }

struct Unit { int pm, pn, e, r0, cnt; };

struct StaticOrder {
    int nM, nN, nwg, G, c, lda; const char* A; const char* Bt; size_t tstepA, tstepB;
    __device__ __forceinline__ void init(int M_, int N_, int K_, int lda_, int G_, int c_, const bf16* A_, const bf16* Bt_) { nM = M_ / BM; nN = N_ / BM; nwg = nM * nN; G = G_; c = c_; lda = lda_; A = (const char*)A_; Bt = (const char*)Bt_; tstepA = (size_t)BM * lda_ * 2; tstepB = (size_t)BM * K_ * 2; }
    __device__ __forceinline__ bool next(int i, Unit& u) const {
        const long L = (long)i * G + c; if (L >= nwg) return false;
        int wgid = (int)L; { const int q = nwg / NXCD, r = nwg % NXCD, xcd = wgid % NXCD, off = wgid / NXCD; wgid = (xcd < r ? xcd * (q + 1) : r * (q + 1) + (xcd - r) * q) + off; }
        const int nig = WGM * nN, gid = wgid / nig, fm = gid * WGM, gsz = (nM - fm) < WGM ? (nM - fm) : WGM;
        u.pm = fm + ((wgid % nig) % gsz); u.pn = (wgid % nig) / gsz; u.e = 0; u.r0 = u.pm * BM; u.cnt = BM; return true;
    }
    __device__ __forceinline__ const char* a_base(const Unit& u) const { return A + (size_t)u.pm * tstepA; }
    __device__ __forceinline__ const char* b_base(const Unit& u) const { return Bt + (size_t)u.pn * tstepB; }
    __device__ __forceinline__ unsigned a_off(int, int) const { return 0u; }
};

struct MoeOrder {
    const LAS int* tab; const LAS unsigned* toktab; int NT, G, c, total, lda; const char* A; const char* Bt; size_t a_row_bytes, b_exp_bytes, b_tile_bytes;
    __device__ __forceinline__ bool next(int i, Unit& u) const {
        const long L = (long)i * G + c; if (L >= total) return false;
        const int mtg = (int)(L / NT), pn = (int)(L % NT);
        int e = 0;
#pragma unroll
        for (int j = 1; j < 8; ++j) e += (mtg >= __builtin_amdgcn_readfirstlane(tab[j])) ? 1 : 0;
        const int ts = __builtin_amdgcn_readfirstlane(tab[e]), off = __builtin_amdgcn_readfirstlane(tab[9 + e]), cn = __builtin_amdgcn_readfirstlane(tab[18 + e]);
        u.e = e; u.pm = mtg - ts; u.pn = pn; u.r0 = off + BM * u.pm; const int rem = cn - BM * u.pm; u.cnt = rem < BM ? rem : BM; return true;
    }
    __device__ __forceinline__ const char* a_base(const Unit& u) const { return toktab ? A : A + (size_t)u.r0 * a_row_bytes; }
    __device__ __forceinline__ const char* b_base(const Unit& u) const { return Bt + (size_t)u.e * b_exp_bytes + (size_t)u.pn * b_tile_bytes; }
    __device__ __forceinline__ unsigned a_off(int ui, int R) const { return toktab[(ui & 15) * 256 + R]; }
};

template <class Epi, class Sched, bool ALIGN_EPI, bool GATHER>
__device__ __forceinline__ void gemm_phase(LAS unsigned char* lds, const int K, const Sched& S, const Epi& E) {
    const int tid = threadIdx.x, wid = __builtin_amdgcn_readfirstlane(tid >> 6), lane = tid & 63, wr = wid >> 2, wc = wid & 3, fr = lane & 15, fq = lane >> 4;
    const int nt = K / BK;
    unsigned voffB[2], vAc[2][2], vAn[2][2]; int Rr[2], Cb[2];
    const size_t kstep = (size_t)(BK * 2);
    const size_t hstep = (size_t)HALF * K * 2;
#pragma unroll
    for (int i = 0; i < 2; ++i) { int R, C; stage_rc(tid * 16 + i * 8192, R, C); const int Rb = Epi::PERM ? ((R & ~31) + perm32(R & 31)) : R;
        Rr[i] = R; Cb[i] = C * 2; voffB[i] = (unsigned)(Rb * K + C) * 2u; }
    const unsigned ldsw = (unsigned)wid * 1024u;
    const int aoff = lds_byte(wr * 64 + fr, fq * 8), boff = lds_byte(wc * 32 + fr, fq * 8);
#define PG8_SA(b, h) (((b) * 2 + (h)) * HTB)
#define PG8_SB(b, h) ((4 + (b) * 2 + (h)) * HTB)
#define PG8_STAGE(bufoff, gbase, voff) do { _Pragma("unroll") for (int _i = 0; _i < 2; ++_i) \
        __builtin_amdgcn_global_load_lds((const unsigned*)((const char*)(gbase) + (voff)[_i]), (LAS unsigned*)(lds + (bufoff) + ldsw + _i * 8192), 16, 0, 0); } while (0)
#define PG8_LDA(dst, b, h) do { _Pragma("unroll") for (int m = 0; m < 4; ++m) _Pragma("unroll") for (int k = 0; k < 2; ++k) dst[m][k] = *(const LAS bf16x8*)(lds + PG8_SA(b, h) + aoff + m * 2048 + k * 1024); } while (0)
#define PG8_LDB(dst, b, h) do { _Pragma("unroll") for (int n = 0; n < 2; ++n) _Pragma("unroll") for (int k = 0; k < 2; ++k) dst[n][k] = *(const LAS bf16x8*)(lds + PG8_SB(b, h) + boff + n * 2048 + k * 1024); } while (0)
#define PG8_MMA(ai, bj, At, Bt) do { __builtin_amdgcn_s_setprio(1); _Pragma("unroll") for (int m = 0; m < 4; ++m) _Pragma("unroll") for (int n = 0; n < 2; ++n) _Pragma("unroll") for (int k = 0; k < 2; ++k) \
        acc[ai][bj][m][n] = __builtin_amdgcn_mfma_f32_16x16x32_bf16(Bt[n][k], At[m][k], acc[ai][bj][m][n], 0, 0, 0); __builtin_amdgcn_s_setprio(0); } while (0)
#define PG8_WAIT_V(n) asm volatile("s_waitcnt vmcnt(" #n ")" ::: "memory")
#define PG8_WAIT_L(n) asm volatile("s_waitcnt lgkmcnt(" #n ")" ::: "memory")
#define PG8_BAR __builtin_amdgcn_s_barrier()
#define PG8_SCHED __builtin_amdgcn_sched_barrier(0)
#define PG8_VOFF(dst, ui_) do { _Pragma("unroll") for (int _h = 0; _h < 2; ++_h) _Pragma("unroll") for (int _i = 0; _i < 2; ++_i) \
        dst[_h][_i] = GATHER ? (S.a_off((ui_), Rr[_i] + _h * HALF) + (unsigned)Cb[_i]) : (unsigned)((Rr[_i] + _h * HALF) * S.lda * 2 + Cb[_i]); } while (0)
    Unit cur, nxt; int ui = 0;
    if (!S.next(0, cur)) return;
    f32x4 acc[2][2][4][2];
#pragma unroll
    for (int a = 0; a < 2; ++a)
#pragma unroll
        for (int b = 0; b < 2; ++b)
#pragma unroll
            for (int m = 0; m < 4; ++m)
#pragma unroll
                for (int n = 0; n < 2; ++n) acc[a][b][m][n] = (f32x4){0.f, 0.f, 0.f, 0.f};
    bf16x8 At[4][2], B0[2][2], B1[2][2];
    const char* cA = S.a_base(cur); const char* cB = S.b_base(cur);
    PG8_VOFF(vAc, 0);
    PG8_STAGE(PG8_SB(0, 0), cB, voffB); PG8_STAGE(PG8_SB(0, 1), cB + hstep, voffB); PG8_STAGE(PG8_SA(0, 0), cA, vAc[0]); PG8_STAGE(PG8_SA(0, 1), cA, vAc[1]);
    if (wr == 1) PG8_BAR;
    PG8_WAIT_V(2); PG8_BAR;
    PG8_STAGE(PG8_SB(1, 0), cB + kstep, voffB); PG8_STAGE(PG8_SA(1, 0), cA + kstep, vAc[0]); PG8_STAGE(PG8_SB(1, 1), cB + hstep + kstep, voffB);
    PG8_WAIT_V(6); PG8_BAR;
    for (;;) {
        const bool has_next = S.next(ui + 1, nxt);
        const char* nA = has_next ? S.a_base(nxt) : cA; const char* nB = has_next ? S.b_base(nxt) : cB;
        if (GATHER) { if (has_next) { PG8_VOFF(vAn, ui + 1); } else {
#pragma unroll
            for (int h = 0; h < 2; ++h)
#pragma unroll
                for (int i = 0; i < 2; ++i) vAn[h][i] = vAc[h][i]; } }
        for (int t = 0; t < nt; t += 2) {
            const bool last = (t == nt - 2);
            const char* a1 = cA + (size_t)(t + 1) * kstep;
            const char* a2 = last ? nA : cA + (size_t)(t + 2) * kstep; const char* b2 = last ? nB : cB + (size_t)(t + 2) * kstep;
            const char* a3 = a2 + kstep; const char* b3 = b2 + kstep;
            unsigned vA2[2][2];
#pragma unroll
            for (int h = 0; h < 2; ++h)
#pragma unroll
                for (int i = 0; i < 2; ++i) vA2[h][i] = (GATHER && last) ? vAn[h][i] : vAc[h][i];
            PG8_LDB(B0, 0, 0); PG8_LDB(B1, 0, 1); PG8_SCHED; PG8_LDA(At, 0, 0); PG8_STAGE(PG8_SA(1, 1), a1, vAc[1]);
            PG8_WAIT_V(8); PG8_WAIT_L(0); PG8_BAR; PG8_MMA(0, 0, At, B0); PG8_MMA(0, 1, At, B1); PG8_BAR; PG8_SCHED;
            PG8_LDA(At, 0, 1); PG8_STAGE(PG8_SB(0, 0), b2, voffB); PG8_STAGE(PG8_SB(0, 1), b2 + hstep, voffB); PG8_STAGE(PG8_SA(0, 0), a2, vA2[0]);
            PG8_WAIT_V(8); PG8_WAIT_L(0); PG8_BAR; PG8_MMA(1, 0, At, B0); PG8_MMA(1, 1, At, B1); PG8_BAR; PG8_SCHED;
            PG8_LDB(B0, 1, 0); PG8_LDB(B1, 1, 1); PG8_SCHED; PG8_LDA(At, 1, 0); PG8_STAGE(PG8_SA(0, 1), a2, vA2[1]);
            PG8_WAIT_V(8); PG8_WAIT_L(0); PG8_BAR; PG8_MMA(0, 0, At, B0); PG8_MMA(0, 1, At, B1); PG8_BAR; PG8_SCHED;
            PG8_LDA(At, 1, 1); PG8_STAGE(PG8_SB(1, 0), b3, voffB); PG8_STAGE(PG8_SB(1, 1), b3 + hstep, voffB); PG8_STAGE(PG8_SA(1, 0), a3, vA2[0]);
            PG8_WAIT_V(8); PG8_WAIT_L(0); PG8_BAR; PG8_MMA(1, 0, At, B0); PG8_MMA(1, 1, At, B1); PG8_BAR; PG8_SCHED;
        }
        if constexpr (ALIGN_EPI) { if (wr == 0) PG8_BAR; }
        E(acc, cur, wr, wc, fr, fq);
        if (!has_next) break;
#pragma unroll
        for (int a = 0; a < 2; ++a)
#pragma unroll
            for (int b = 0; b < 2; ++b)
#pragma unroll
                for (int m = 0; m < 4; ++m)
#pragma unroll
                    for (int n = 0; n < 2; ++n) acc[a][b][m][n] = (f32x4){0.f, 0.f, 0.f, 0.f};
        cur = nxt; cA = nA; cB = nB; ++ui;
        if (GATHER) {
#pragma unroll
            for (int h = 0; h < 2; ++h)
#pragma unroll
                for (int i = 0; i < 2; ++i) vAc[h][i] = vAn[h][i]; }
        if constexpr (ALIGN_EPI) { if (wr == 1) PG8_BAR; }
    }
    PG8_WAIT_V(0);
    if constexpr (!ALIGN_EPI) { if (wr == 0) PG8_BAR; }
    PG8_BAR;
#undef PG8_SA
#undef PG8_SB
#undef PG8_STAGE
#undef PG8_LDA
#undef PG8_LDB
#undef PG8_MMA
#undef PG8_WAIT_V
#undef PG8_WAIT_L
#undef PG8_BAR
#undef PG8_SCHED
#undef PG8_VOFF
}

typedef const f32x4 (&AccT)[2][2][4][2];

struct EpiUV {
    static constexpr bool PERM = true;
    bf16* O; const float* bias; const float* ss; float* vstat;
    __device__ __forceinline__ void operator()(AccT acc, const Unit& u, int wr, int wc, int fr, int fq) const {
        const int col0 = u.pn * BM + wc * 32 + 8 * fq; const bool isv = u.pn >= 12;
        f32x4 bv[2][2];
#pragma unroll
        for (int bj = 0; bj < 2; ++bj)
#pragma unroll
            for (int n = 0; n < 2; ++n) bv[bj][n] = *(const f32x4*)(bias + col0 + bj * HALF + 4 * n);
#pragma unroll
        for (int ai = 0; ai < 2; ++ai)
#pragma unroll
            for (int m = 0; m < 4; ++m) {
                const int row = u.r0 + ai * HALF + wr * 64 + m * 16 + fr;
                const float r = row_rscale(ss, row, fq);
                bf16* rowp = O + (size_t)row * GF + col0; float s1 = 0.f, s2 = 0.f;
#pragma unroll
                for (int bj = 0; bj < 2; ++bj) {
                    f32x4 v0 = acc[ai][bj][m][0] * r + bv[bj][0], v1 = acc[ai][bj][m][1] * r + bv[bj][1];
#pragma unroll
                    for (int j = 0; j < 4; ++j) { v0[j] = gelu_tanh(v0[j]); v1[j] = gelu_tanh(v1[j]); s1 += v0[j] + v1[j]; s2 += v0[j] * v0[j] + v1[j] * v1[j]; }
                    v4u w; w.x = cvt_pk_bf16(v0[0], v0[1]); w.y = cvt_pk_bf16(v0[2], v0[3]); w.z = cvt_pk_bf16(v1[0], v1[1]); w.w = cvt_pk_bf16(v1[2], v1[3]);
                    *(v4u*)(rowp + bj * HALF) = w; }
                if (isv) { s1 += __shfl_xor(s1, 16); s1 += __shfl_xor(s1, 32); s2 += __shfl_xor(s2, 16); s2 += __shfl_xor(s2, 32);
                    if (fq == 0) *(f32x2*)(vstat + ((size_t)row * 48 + (u.pn - 12) * 4 + wc) * 2) = (f32x2){s1, s2}; }
            }
    }
};

struct EpiRes {
    static constexpr bool PERM = false;
    const float* base; float* out; const float* bias; bf16* xb; float* ssout;
    __device__ __forceinline__ void operator()(AccT acc, const Unit& u, int wr, int wc, int fr, int fq) const {
        const int col0 = u.pn * BM + wc * 32 + 4 * fq;
        f32x4 bv[2][2];
#pragma unroll
        for (int bj = 0; bj < 2; ++bj)
#pragma unroll
            for (int n = 0; n < 2; ++n) bv[bj][n] = bias ? *(const f32x4*)(bias + col0 + bj * HALF + n * 16) : (f32x4){0.f, 0.f, 0.f, 0.f};
#pragma unroll
        for (int ai = 0; ai < 2; ++ai)
#pragma unroll
            for (int m = 0; m < 4; ++m) {
                const int row = u.r0 + ai * HALF + wr * 64 + m * 16 + fr; const size_t off = (size_t)row * D + col0; float s2 = 0.f;
#pragma unroll
                for (int bj = 0; bj < 2; ++bj)
#pragma unroll
                    for (int n = 0; n < 2; ++n) {
                        const f32x4 v = *(const f32x4*)(base + off + bj * HALF + n * 16) + acc[ai][bj][m][n] + bv[bj][n];
                        *(f32x4*)(out + off + bj * HALF + n * 16) = v;
                        s2 += (v[0] * v[0] + v[1] * v[1]) + (v[2] * v[2] + v[3] * v[3]);
                        if (xb) { v2u w; w.x = cvt_pk_bf16(v[0], v[1]); w.y = cvt_pk_bf16(v[2], v[3]); *(v2u*)(xb + off + bj * HALF + n * 16) = w; } }
                if (ssout) { s2 += __shfl_xor(s2, 16); s2 += __shfl_xor(s2, 32); if (fq == 0) ssout[(size_t)row * 16 + u.pn * 4 + wc] = s2; }
            }
    }
};

template <bool MOE> struct EpiHid {
    static constexpr bool PERM = true;
    bf16* O; int ldh; const float* ss; const float* r4; const int* toklist;
    __device__ __forceinline__ void operator()(AccT acc, const Unit& u, int wr, int wc, int fr, int fq) const {
        const int col0 = u.pn * HALF + wc * 32 + 8 * fq;
#pragma unroll
        for (int ai = 0; ai < 2; ++ai)
#pragma unroll
            for (int m = 0; m < 4; ++m) {
                const int tr = ai * HALF + wr * 64 + m * 16 + fr; const int row = u.r0 + tr; float r; bool valid = true;
                if (MOE) { valid = tr < u.cnt; const int pos = u.pm * BM + tr; const int tok = valid ? toklist[u.e * M + pos] : 0; r = r4[tok]; }
                else r = row_rscale(ss, row, fq);
                f32x4 g0 = acc[ai][0][m][0] * r, g1 = acc[ai][0][m][1] * r, u0 = acc[ai][1][m][0] * r, u1 = acc[ai][1][m][1] * r;
#pragma unroll
                for (int j = 0; j < 4; ++j) { g0[j] = g0[j] * sigmoid_f(g0[j]) * u0[j]; g1[j] = g1[j] * sigmoid_f(g1[j]) * u1[j]; }
                v4u w; w.x = cvt_pk_bf16(g0[0], g0[1]); w.y = cvt_pk_bf16(g0[2], g0[3]); w.z = cvt_pk_bf16(g1[0], g1[1]); w.w = cvt_pk_bf16(g1[2], g1[3]);
                if (valid) *(v4u*)(O + (size_t)row * ldh + col0) = w;
            }
    }
};

template <bool MOE> struct EpiBf {
    static constexpr bool PERM = true;
    bf16* O; int ldc; const float* slotw;
    __device__ __forceinline__ void operator()(AccT acc, const Unit& u, int wr, int wc, int fr, int fq) const {
        const int col0 = u.pn * BM + wc * 32 + 8 * fq;
#pragma unroll
        for (int ai = 0; ai < 2; ++ai)
#pragma unroll
            for (int m = 0; m < 4; ++m) {
                const int tr = ai * HALF + wr * 64 + m * 16 + fr; const int row = u.r0 + tr; float sc = 1.f; bool valid = true;
                if (MOE) { valid = tr < u.cnt; sc = valid ? slotw[u.e * M + u.pm * BM + tr] : 0.f; }
                bf16* rowp = O + (size_t)row * ldc + col0;
#pragma unroll
                for (int bj = 0; bj < 2; ++bj) { const f32x4 v0 = acc[ai][bj][m][0] * sc, v1 = acc[ai][bj][m][1] * sc;
                    v4u w; w.x = cvt_pk_bf16(v0[0], v0[1]); w.y = cvt_pk_bf16(v0[2], v0[3]); w.z = cvt_pk_bf16(v1[0], v1[1]); w.w = cvt_pk_bf16(v1[2], v1[3]);
                    if (valid) *(v4u*)(rowp + bj * HALF) = w; }
            }
    }
};

struct EpiPle {
    static constexpr bool PERM = false;
    float* x; const bf16* proj; const float* ss; bf16* xb; float* ssout;
    __device__ __forceinline__ void operator()(AccT acc, const Unit& u, int wr, int wc, int fr, int fq) const {
        const int col0 = u.pn * BM + wc * 32 + 4 * fq;
#pragma unroll
        for (int ai = 0; ai < 2; ++ai)
#pragma unroll
            for (int m = 0; m < 4; ++m) {
                const int row = u.r0 + ai * HALF + wr * 64 + m * 16 + fr; const size_t off = (size_t)row * D + col0; float s2 = 0.f;
                const float r = row_rscale(ss, row, fq);
#pragma unroll
                for (int bj = 0; bj < 2; ++bj)
#pragma unroll
                    for (int n = 0; n < 2; ++n) {
                        const size_t o = off + bj * HALF + n * 16;
                        const v2u pw = *(const v2u*)(proj + o); const f32x4 a = acc[ai][bj][m][n] * r; f32x4 v = *(const f32x4*)(x + o);
                        v[0] += bf_lo(pw.x) * sigmoid_f(a[0]); v[1] += bf_hi(pw.x) * sigmoid_f(a[1]); v[2] += bf_lo(pw.y) * sigmoid_f(a[2]); v[3] += bf_hi(pw.y) * sigmoid_f(a[3]);
                        *(f32x4*)(x + o) = v;
                        s2 += (v[0] * v[0] + v[1] * v[1]) + (v[2] * v[2] + v[3] * v[3]);
                        if (xb) { v2u w; w.x = cvt_pk_bf16(v[0], v[1]); w.y = cvt_pk_bf16(v[2], v[3]); *(v2u*)(xb + o) = w; } }
                if (ssout) { s2 += __shfl_xor(s2, 16); s2 += __shfl_xor(s2, 32); if (fq == 0) ssout[(size_t)row * 16 + u.pn * 4 + wc] = s2; }
            }
    }
};

struct EpiQKV {
    static constexpr bool PERM = false;
    bf16* Q; bf16* Kb; bf16* Vb; const float* bq; const float* bkv; const float* ss; const f32x2* rope;
    __device__ __forceinline__ void operator()(AccT acc, const Unit& u, int wr, int wc, int fr, int fq) const {
        const int dlo = 16 * (wc & 1) + 4 * fq;
        const int kind = u.pn < 4 ? 0 : (u.pn == 4 ? 1 : 2);
        f32x4 bv[2][2];
#pragma unroll
        for (int bj = 0; bj < 2; ++bj) {
            const int hcol = 64 * (2 * bj + (wc >> 1)) + dlo;
            const float* bp = kind == 0 ? bq + u.pn * BM + hcol : bkv + (kind - 1) * BM + hcol;
            bv[bj][0] = *(const f32x4*)bp; bv[bj][1] = *(const f32x4*)(bp + 32); }
#pragma unroll
        for (int ai = 0; ai < 2; ++ai)
#pragma unroll
            for (int m = 0; m < 4; ++m) {
                const int row = u.r0 + ai * HALF + wr * 64 + m * 16 + fr; const float r = row_rscale(ss, row, fq);
                const f32x2* rp = rope + (size_t)(row & (SEQ - 1)) * 32 + dlo;
                const f32x4 cs01 = *(const f32x4*)rp, cs23 = *(const f32x4*)(rp + 2);
                const float cc[4] = {cs01[0], cs01[2], cs23[0], cs23[2]}, sn[4] = {cs01[1], cs01[3], cs23[1], cs23[3]};
#pragma unroll
                for (int bj = 0; bj < 2; ++bj) {
                    const int hcol = 64 * (2 * bj + (wc >> 1)) + dlo;
                    f32x4 lo = acc[ai][bj][m][0] * r + bv[bj][0], hi = acc[ai][bj][m][1] * r + bv[bj][1];
                    if (kind < 2) {
#pragma unroll
                        for (int j = 0; j < 4; ++j) { const float a = lo[j], b = hi[j]; lo[j] = a * cc[j] - b * sn[j]; hi[j] = b * cc[j] + a * sn[j]; }
                    }
                    if (kind == 0) { lo = lo * QSCALE; hi = hi * QSCALE; }
                    v2u wl, wh; wl.x = cvt_pk_bf16(lo[0], lo[1]); wl.y = cvt_pk_bf16(lo[2], lo[3]); wh.x = cvt_pk_bf16(hi[0], hi[1]); wh.y = cvt_pk_bf16(hi[2], hi[3]);
                    bf16* dst = kind == 0 ? Q + (size_t)row * D + u.pn * BM + hcol : (kind == 1 ? Kb : Vb) + (size_t)row * 256 + hcol;
                    *(v2u*)dst = wl; *(v2u*)(dst + 32) = wh; }
            }
    }
};
}

struct Args { const float* in[31]; float* out; unsigned char* ws; int ph_lo, ph_hi, li, pad; };

struct Frame {
    LAS unsigned char* lds; volatile LAS unsigned* MISC; unsigned* ctl; unsigned char* ws;
    int tid, lane, wave, G, bid;
};

__device__ __forceinline__ int dest_row(int mode, int off, int n) {
    if (mode == 1) return ((n >> 7) << 8) + (n & 127) + off;
    if (mode == 2) return ((n & ~48) | ((n & 16) << 1) | ((n & 32) >> 1)) + off;
    return n + off;
}
__device__ __forceinline__ void p0_transpose_item(const float* W, int K, int N, const float* gain, bf16* WT, int mode, int off, LAS float* scr, int item, int lane) {
    const int nblk = N / 32, kb = item / nblk, nb = item % nblk, k0 = 64 * kb, n0 = 32 * nb;
#pragma unroll 8
    for (int i = 0; i < 32; ++i) { const int kk = 2 * i + (lane >> 5); const float g = gain ? gain[k0 + kk] : 1.0f; scr[kk * 33 + (lane & 31)] = W[(size_t)(k0 + kk) * N + n0 + (lane & 31)] * g; }
    LDS_WAIT(); asm volatile("" ::: "memory");
    const int c = lane & 7;
#pragma unroll
    for (int j = 0; j < 4; ++j) { const int n = (lane >> 3) + 8 * j; const LAS float* s = scr + (8 * c) * 33 + n;
        v4u o; o.x = cvt_pk_bf16(s[0 * 33], s[1 * 33]); o.y = cvt_pk_bf16(s[2 * 33], s[3 * 33]); o.z = cvt_pk_bf16(s[4 * 33], s[5 * 33]); o.w = cvt_pk_bf16(s[6 * 33], s[7 * 33]);
        *(v4u*)(WT + (size_t)dest_row(mode, off, n0 + n) * K + k0 + 8 * c) = o; }
    LDS_WAIT(); asm volatile("" ::: "memory");
}

#define IN_(k) ((const float*)args.in[k])

__global__ void __launch_bounds__(NWAVES * 64, 2) fwd_kernel(Args args) {
    extern __shared__ __attribute__((aligned(16))) unsigned char lds_raw[];
    Frame F;
    F.lds = (LAS unsigned char*)lds_raw;
    F.MISC = (volatile LAS unsigned*)(F.lds + MISC_OFF);
    F.tid = threadIdx.x; F.lane = F.tid & 63; F.wave = __builtin_amdgcn_readfirstlane(F.tid >> 6);
    F.G = gridDim.x; F.bid = blockIdx.x;
    F.ws = args.ws; F.ctl = (unsigned*)(args.ws + WS_CTL);
    unsigned char* ws = args.ws;
    const int tid = F.tid, lane = F.lane, wave = F.wave, G = F.G, bid = F.bid;
    const int gw = bid * NWAVES + wave, NGW = G * NWAVES;

    for (int u = tid; u < 128; u += NWAVES * 64) ((LAS unsigned*)(F.lds + MISC_OFF))[u] = 0u;
    __syncthreads();
    constexpr bool ONE = (MK_N_LAUNCHES == 1);
    XcdBarrier bar; bar.bar = F.ctl + CW_BAR; bar.x = 0; bar.st = nullptr;
    if (ONE) bar = xcd_barrier_post(F.ctl + CW_BAR, F.MISC + 8);
#define GRID_BAR() do { if (ONE) xcd_barrier(bar); } while (0)
    const int lo = args.ph_lo, hi = args.ph_hi;
#define IN(k) (lo <= (k) && (k) < hi)

    bf16* const Win_t = (bf16*)(ws + WS_WIN); bf16* const Wout_t = (bf16*)(ws + WS_WOUT); bf16* const Wgu_t = (bf16*)(ws + WS_WGU); bf16* const Wd_t = (bf16*)(ws + WS_WD);
    bf16* const Wpg0_t = (bf16*)(ws + WS_WPG0); bf16* const Wpp0_t = (bf16*)(ws + WS_WPP0); bf16* const Wpg1_t = (bf16*)(ws + WS_WPG1); bf16* const Wpp1_t = (bf16*)(ws + WS_WPP1);
    bf16* const Wqkv_t = (bf16*)(ws + WS_WQKV); bf16* const Wo_t = (bf16*)(ws + WS_WO); bf16* const MWgu_t = (bf16*)(ws + WS_MWGU); bf16* const MWd_t = (bf16*)(ws + WS_MWD);
    bf16* const XB0 = (bf16*)(ws + WS_XB0); bf16* const XB1 = (bf16*)(ws + WS_XB1); bf16* const PB = (bf16*)(ws + WS_PB);
    bf16* const UV = (bf16*)(ws + WS_UV); bf16* const HID = (bf16*)(ws + WS_HID); bf16* const PROJ = (bf16*)(ws + WS_PROJ);
    bf16* const Qb = (bf16*)(ws + WS_Q); bf16* const Kb = (bf16*)(ws + WS_K); bf16* const Vb = (bf16*)(ws + WS_V);
    bf16* const HIDM = (bf16*)(ws + WS_HIDM); bf16* const YS = (bf16*)(ws + WS_YS);
    float* const SS0 = (float*)(ws + WS_SS); float* const SS1 = SS0 + M * 16; float* const SS2 = SS1 + M * 16; float* const SS3 = SS2 + M * 16; float* const SS5 = SS3 + M * 16;
    float* const R4 = (float*)(ws + WS_R4); unsigned* const TOKSLOT = (unsigned*)(ws + WS_TOKSLOT); int* const TOKLIST = (int*)(ws + WS_TOKLIST); float* const SLOTW = (float*)(ws + WS_SLOTW);
    float* const WR = (float*)(ws + WS_WR); float* const VSTAT = (float*)(ws + WS_VSTAT); f32x2* const ROPE = (f32x2*)(ws + WS_ROPE);
    float* const X = args.out;
    unsigned* const GCNT = F.ctl + CW_CNT;

    if (IN(0)) {
        LAS float* scr = (LAS float*)(F.lds + wave * 16384);
        constexpr int I_WIN = (D / 64) * (GF / 32), I_WOUT = (GH / 64) * (D / 32), I_FG = (D / 64) * (FFD / 32), I_FD = (FFD / 64) * (D / 32), I_PG = (D / 64) * (D / 32), I_PP = (PLE / 64) * (D / 32),
                      I_WQ = (D / 64) * (D / 32), I_WKV = (D / 64) * (512 / 32), I_WO = I_WQ, I_MG = (D / 64) * (FFE / 32), I_MD = (FFE / 64) * (D / 32);
        constexpr int NITEMS = I_WIN + I_WOUT + 2 * I_FG + I_FD + 2 * I_PG + 2 * I_PP + I_WQ + I_WKV + I_WO + NE * (2 * I_MG + I_MD);
        for (int it = gw; it < NITEMS; it += NGW) {
            int r = it;
            if (r < I_WIN) { p0_transpose_item(IN_(4), D, GF, IN_(2), Win_t, 0, 0, scr, r, lane); continue; } r -= I_WIN;
            if (r < I_WOUT) { p0_transpose_item(IN_(10), GH, D, nullptr, Wout_t, 0, 0, scr, r, lane); continue; } r -= I_WOUT;
            if (r < I_FG) { p0_transpose_item(IN_(20), D, FFD, IN_(3), Wgu_t, 1, 0, scr, r, lane); continue; } r -= I_FG;
            if (r < I_FG) { p0_transpose_item(IN_(21), D, FFD, IN_(3), Wgu_t, 1, 128, scr, r, lane); continue; } r -= I_FG;
            if (r < I_FD) { p0_transpose_item(IN_(22), FFD, D, nullptr, Wd_t, 0, 0, scr, r, lane); continue; } r -= I_FD;
            if (r < I_PG) { p0_transpose_item(IN_(29), D, D, IN_(28), Wpg0_t, 0, 0, scr, r, lane); continue; } r -= I_PG;
            if (r < I_PG) { p0_transpose_item(IN_(29) + D * D, D, D, IN_(28) + D, Wpg1_t, 0, 0, scr, r, lane); continue; } r -= I_PG;
            if (r < I_PP) { p0_transpose_item(IN_(27), PLE, D, nullptr, Wpp0_t, 0, 0, scr, r, lane); continue; } r -= I_PP;
            if (r < I_PP) { p0_transpose_item(IN_(27) + PLE * D, PLE, D, nullptr, Wpp1_t, 0, 0, scr, r, lane); continue; } r -= I_PP;
            if (r < I_WQ) { p0_transpose_item(IN_(15), D, D, IN_(2) + D, Wqkv_t, 2, 0, scr, r, lane); continue; } r -= I_WQ;
            if (r < I_WKV) { p0_transpose_item(IN_(13), D, 512, IN_(12), Wqkv_t, 2, 1024, scr, r, lane); continue; } r -= I_WKV;
            if (r < I_WO) { p0_transpose_item(IN_(18), D, D, nullptr, Wo_t, 0, 0, scr, r, lane); continue; } r -= I_WO;
            { constexpr int PER_E = 2 * I_MG + I_MD; const int e = r / PER_E; int q = r % PER_E;
              if (q < I_MG) { p0_transpose_item(IN_(24) + (size_t)e * D * FFE, D, FFE, IN_(3) + D, MWgu_t + (size_t)e * 7168 * D, 1, 0, scr, q, lane); continue; } q -= I_MG;
              if (q < I_MG) { p0_transpose_item(IN_(25) + (size_t)e * D * FFE, D, FFE, IN_(3) + D, MWgu_t + (size_t)e * 7168 * D, 1, 128, scr, q, lane); continue; } q -= I_MG;
              p0_transpose_item(IN_(26) + (size_t)e * FFE * D, FFE, D, nullptr, MWd_t + (size_t)e * D * FFE, 0, 0, scr, q, lane); }
        }
        for (int m = gw; m < M; m += NGW) {
            const f32x4* xr = (const f32x4*)(IN_(0) + (size_t)m * D) + lane; f32x4 v[4]; float s = 0.f;
#pragma unroll
            for (int j = 0; j < 4; ++j) { v[j] = xr[64 * j]; s += (v[j].x * v[j].x + v[j].y * v[j].y) + (v[j].z * v[j].z + v[j].w * v[j].w); }
            s = wave_sum(s);
            v2u* o8 = (v2u*)(XB0 + (size_t)m * D) + lane;
#pragma unroll
            for (int j = 0; j < 4; ++j) { v2u w; w.x = cvt_pk_bf16(v[j].x, v[j].y); w.y = cvt_pk_bf16(v[j].z, v[j].w); o8[64 * j] = w; }
            if (lane < 16) SS0[(size_t)m * 16 + lane] = lane == 0 ? s : 0.f;
        }
        for (int i = bid * (NWAVES * 64) + tid; i < 2 * M * PLE / 8; i += G * NWAVES * 64) {
            const f32x4 a = ((const f32x4*)IN_(1))[2 * i], b = ((const f32x4*)IN_(1))[2 * i + 1];
            v4u w; w.x = cvt_pk_bf16(a.x, a.y); w.y = cvt_pk_bf16(a.z, a.w); w.z = cvt_pk_bf16(b.x, b.y); w.w = cvt_pk_bf16(b.z, b.w);
            ((v4u*)PB)[i] = w;
        }
        for (int i = bid * (NWAVES * 64) + tid; i < SEQ * 32; i += G * NWAVES * 64) {
            const int pos = i >> 5, fi = i & 31;
            const float freq = exp2f(-(float)fi * (13.287712379549449f / 32.0f));
            const float ang = (float)pos * freq;
            const double rev = (double)ang * 0.15915494309189535; const double fr_ = rev - __builtin_rint(rev);
            const float xr = (float)fr_;
            ROPE[i] = (f32x2){__builtin_amdgcn_cosf(xr), __builtin_amdgcn_sinf(xr)};
        }
        for (int i = bid * (NWAVES * 64) + tid; i < NE * D; i += G * NWAVES * 64) { const int e = i >> 10, k = i & 1023; WR[i] = IN_(3)[D + k] * IN_(23)[k * NE + e]; }
        GRID_BAR();
    }

    if (IN(1)) {
        pg8::StaticOrder S; S.init(M, GF, D, D, G, bid, XB0, Win_t);
        pg8::EpiUV E{UV, IN_(5), SS0, VSTAT};
        pg8::gemm_phase<pg8::EpiUV, pg8::StaticOrder, true, false>(F.lds, D, S, E);
        GRID_BAR();
    }

    if (IN(2)) {
        constexpr int WSTR = 136;
        LAS bf16* WSL = (LAS bf16*)(F.lds);
        LAS bf16* VT = (LAS bf16*)(F.lds + 128 * WSTR * 2);
        LAS f32x2* STAT = (LAS f32x2*)(F.lds + 128 * WSTR * 2 + 192 * WSTR * 2);
        const float* lng = IN_(6); const float* lnb = IN_(7); const float* wsrc = IN_(8); const float* bsrc = IN_(9);
        for (int id = bid; id < 2048; id += G) {
            const int hf = id & 1, g = (id >> 1) & 7, c = id >> 4; const int row0 = 128 * c, ch0 = GD * g + 192 * hf;
            if (tid < 128) {
                const f32x4* vp = (const f32x4*)(VSTAT + (size_t)(row0 + tid) * 96); float s1 = 0.f, s2 = 0.f;
#pragma unroll 4
                for (int j = 0; j < 24; ++j) { const f32x4 q = vp[j]; s1 += q.x + q.z; s2 += q.y + q.w; }
                const float mean = s1 * (1.0f / GH); float var = s2 * (1.0f / GH) - mean * mean; var = var < 0.f ? 0.f : var;
                STAT[tid] = (f32x2){mean, __builtin_amdgcn_rsqf(var + EPS)};
            }
            for (int idx = tid; idx < 2048; idx += NWAVES * 64) {
                const int t = idx >> 4, s0 = (idx & 15) * 8; const f32x4* wp = (const f32x4*)(wsrc + ((size_t)g * 128 + t) * 128 + s0);
                const f32x4 a = wp[0], b = wp[1]; float w8[8] = {a.x, a.y, a.z, a.w, b.x, b.y, b.z, b.w};
#pragma unroll
                for (int j = 0; j < 8; ++j) w8[j] = (s0 + j <= t) ? w8[j] : 0.f;
                v4u o; o.x = cvt_pk_bf16(w8[0], w8[1]); o.y = cvt_pk_bf16(w8[2], w8[3]); o.z = cvt_pk_bf16(w8[4], w8[5]); o.w = cvt_pk_bf16(w8[6], w8[7]);
                *(LAS v4u*)(WSL + t * WSTR + s0) = o;
            }
            __syncthreads();
            for (int idx = tid; idx < 128 * 24; idx += NWAVES * 64) {
                const int s = idx & 127, cg = idx >> 7; const int ch = ch0 + 8 * cg;
                const v4u raw = *(const v4u*)(UV + (size_t)(row0 + s) * GF + GH + ch);
                const f32x2 st = STAT[s];
                const f32x4 g0 = *(const f32x4*)(lng + ch), g1 = *(const f32x4*)(lng + ch + 4), b0 = *(const f32x4*)(lnb + ch), b1 = *(const f32x4*)(lnb + ch + 4);
                float v8[8] = {bf_lo(raw.x), bf_hi(raw.x), bf_lo(raw.y), bf_hi(raw.y), bf_lo(raw.z), bf_hi(raw.z), bf_lo(raw.w), bf_hi(raw.w)};
                const float gg[8] = {g0.x, g0.y, g0.z, g0.w, g1.x, g1.y, g1.z, g1.w}, bb[8] = {b0.x, b0.y, b0.z, b0.w, b1.x, b1.y, b1.z, b1.w};
#pragma unroll
                for (int j = 0; j < 8; j += 2) {
                    const float y0 = (v8[j] - st.x) * st.y * gg[j] + bb[j], y1 = (v8[j + 1] - st.x) * st.y * gg[j + 1] + bb[j + 1];
                    const unsigned w = cvt_pk_bf16(y0, y1);
                    VT[(8 * cg + j) * WSTR + s] = (bf16)(w & 0xffffu); VT[(8 * cg + j + 1) * WSTR + s] = (bf16)(w >> 16); }
            }
            __syncthreads();
            {
                const int tl = lane & 15, kg = lane >> 4; const int t = 16 * wave + tl; const int nks = (wave + 2) >> 1;
                f32x4 acc[12];
#pragma unroll
                for (int cb = 0; cb < 12; ++cb) acc[cb] = (f32x4){0.f, 0.f, 0.f, 0.f};
                for (int ks = 0; ks < nks; ++ks) {
                    const bf16x8 wf = *(const LAS bf16x8*)(WSL + t * WSTR + 32 * ks + 8 * kg);
#pragma unroll
                    for (int cb = 0; cb < 12; ++cb) { const bf16x8 vf = *(const LAS bf16x8*)(VT + (16 * cb + tl) * WSTR + 32 * ks + 8 * kg);
                        acc[cb] = __builtin_amdgcn_mfma_f32_16x16x32_bf16(vf, wf, acc[cb], 0, 0, 0); }
                }
                const float bsv = bsrc[g * 128 + t];
                bf16* up = UV + (size_t)(row0 + t) * GF + ch0 + 4 * kg;
#pragma unroll
                for (int cb = 0; cb < 12; ++cb) { const v2u uw = *(const v2u*)(up + 16 * cb);
                    const float o0 = bf_lo(uw.x) * (acc[cb][0] + bsv), o1 = bf_hi(uw.x) * (acc[cb][1] + bsv), o2 = bf_lo(uw.y) * (acc[cb][2] + bsv), o3 = bf_hi(uw.y) * (acc[cb][3] + bsv);
                    v2u w; w.x = cvt_pk_bf16(o0, o1); w.y = cvt_pk_bf16(o2, o3); *(v2u*)(up + 16 * cb) = w; }
            }
            __syncthreads();
        }
        GRID_BAR();
    }

    if (IN(3)) {
        pg8::StaticOrder S; S.init(M, D, GH, GF, G, bid, UV, Wout_t);
        pg8::EpiRes E{IN_(0), X, IN_(11), XB0, SS1};
        pg8::gemm_phase<pg8::EpiRes, pg8::StaticOrder, false, false>(F.lds, GH, S, E);
        GRID_BAR();
    }

    if (IN(4)) {
        pg8::StaticOrder S; S.init(M, 2 * FFD, D, D, G, bid, XB0, Wgu_t);
        pg8::EpiHid<false> E{HID, FFD, SS1, nullptr, nullptr};
        pg8::gemm_phase<pg8::EpiHid<false>, pg8::StaticOrder, true, false>(F.lds, D, S, E);
        GRID_BAR();
    }

    if (IN(5)) {
        { pg8::StaticOrder S; S.init(M, D, FFD, FFD, G, bid, HID, Wd_t);
          pg8::EpiRes E{X, X, nullptr, XB0, SS2};
          pg8::gemm_phase<pg8::EpiRes, pg8::StaticOrder, false, false>(F.lds, FFD, S, E); }
        { pg8::StaticOrder S; S.init(M, D, PLE, PLE, G, bid, PB, Wpp0_t);
          pg8::EpiBf<false> E{PROJ, D, nullptr};
          pg8::gemm_phase<pg8::EpiBf<false>, pg8::StaticOrder, false, false>(F.lds, PLE, S, E); }
        GRID_BAR();
    }

    if (IN(6)) {
        pg8::StaticOrder S; S.init(M, D, D, D, G, bid, XB0, Wpg0_t);
        pg8::EpiPle E{X, PROJ, SS2, XB1, SS3};
        pg8::gemm_phase<pg8::EpiPle, pg8::StaticOrder, false, false>(F.lds, D, S, E);
        GRID_BAR();
    }

    if (IN(7)) {
        pg8::StaticOrder S; S.init(M, NQKV, D, D, G, bid, XB1, Wqkv_t);
        pg8::EpiQKV E{Qb, Kb, Vb, IN_(16), IN_(14), SS3, ROPE};
        pg8::gemm_phase<pg8::EpiQKV, pg8::StaticOrder, true, false>(F.lds, D, S, E);
        GRID_BAR();
    }

    if (IN(8)) {
        constexpr int KSTR = 72, VSTR = 264;
        LAS bf16* KL = (LAS bf16*)(F.lds);
        LAS bf16* VT = (LAS bf16*)(F.lds + 256 * KSTR * 2);
        const float* sinks = IN_(17);
        for (int id = bid; id < 512; id += G) {
            const int qb = id & 31, g = (id >> 5) & 3, b = id >> 7;
            const long tok0 = (long)b * SEQ + 128 * qb - 128;
            for (int idx = tid; idx < 2048; idx += NWAVES * 64) {
                const int kj = idx >> 3, c = idx & 7; const bool valid = (qb > 0) || (kj >= 128);
                v4u val = (v4u){0u, 0u, 0u, 0u};
                if (valid) val = *(const v4u*)(Kb + (size_t)(tok0 + kj) * 256 + 64 * g + 8 * c);
                *(LAS v4u*)(KL + kj * KSTR + 8 * c) = val;
            }
            for (int idx = tid; idx < 2048; idx += NWAVES * 64) {
                const int kj = idx & 255, c = idx >> 8; const bool valid = (qb > 0) || (kj >= 128);
                v4u raw = (v4u){0u, 0u, 0u, 0u};
                if (valid) raw = *(const v4u*)(Vb + (size_t)(tok0 + kj) * 256 + 64 * g + 8 * c);
                LAS bf16* vp = VT + (8 * c) * VSTR + kj;
                vp[0 * VSTR] = (bf16)(raw.x & 0xffffu); vp[1 * VSTR] = (bf16)(raw.x >> 16); vp[2 * VSTR] = (bf16)(raw.y & 0xffffu); vp[3 * VSTR] = (bf16)(raw.y >> 16);
                vp[4 * VSTR] = (bf16)(raw.z & 0xffffu); vp[5 * VSTR] = (bf16)(raw.z >> 16); vp[6 * VSTR] = (bf16)(raw.w & 0xffffu); vp[7 * VSTR] = (bf16)(raw.w >> 16);
            }
            __syncthreads();
            const int ql = lane & 15, kg = lane >> 4, i = wave;
            for (int it = 0; it < 4; ++it) {
                const int head = 4 * g + it; const size_t qrow = (size_t)b * SEQ + 128 * qb + 16 * i + ql;
                bf16* qp = Qb + qrow * D + 64 * head;
                const bf16x8 qf0 = *(const bf16x8*)(qp + 8 * kg), qf1 = *(const bf16x8*)(qp + 32 + 8 * kg);
                f32x4 sc[9];
#pragma unroll
                for (int jb = 0; jb < 9; ++jb) {
                    const LAS bf16* kp = KL + (16 * (i + jb) + ql) * KSTR + 8 * kg;
                    const bf16x8 a0 = *(const LAS bf16x8*)kp, a1 = *(const LAS bf16x8*)(kp + 32);
                    sc[jb] = __builtin_amdgcn_mfma_f32_16x16x32_bf16(a0, qf0, (f32x4){0.f, 0.f, 0.f, 0.f}, 0, 0, 0);
                    sc[jb] = __builtin_amdgcn_mfma_f32_16x16x32_bf16(a1, qf1, sc[jb], 0, 0, 0);
                }
                const int qi = 16 * i + ql; const float sink = sinks[head] * LOG2E; float mx = sink;
#pragma unroll
                for (int jb = 0; jb < 9; ++jb)
#pragma unroll
                    for (int r = 0; r < 4; ++r) { const int kj = 16 * (i + jb) + 4 * kg + r; const bool valid = (kj > qi) && (kj <= qi + 128) && ((qb > 0) || (kj >= 128));
                        sc[jb][r] = valid ? sc[jb][r] : -INFINITY; mx = fmaxf(mx, sc[jb][r]); }
                mx = fmaxf(mx, __shfl_xor(mx, 16)); mx = fmaxf(mx, __shfl_xor(mx, 32));
                float sum = 0.f;
#pragma unroll
                for (int jb = 0; jb < 9; ++jb)
#pragma unroll
                    for (int r = 0; r < 4; ++r) { const float p = fast_exp2(sc[jb][r] - mx); sc[jb][r] = p; sum += p; }
                sum += __shfl_xor(sum, 16); sum += __shfl_xor(sum, 32);
                const float inv = fast_rcp(sum + fast_exp2(sink - mx));
                f32x4 o[4];
#pragma unroll
                for (int db = 0; db < 4; ++db) o[db] = (f32x4){0.f, 0.f, 0.f, 0.f};
#pragma unroll
                for (int pp = 0; pp < 5; ++pp) {
                    v4u pw; pw.x = cvt_pk_bf16(sc[2 * pp][0], sc[2 * pp][1]); pw.y = cvt_pk_bf16(sc[2 * pp][2], sc[2 * pp][3]);
                    if (pp < 4) { pw.z = cvt_pk_bf16(sc[2 * pp + 1 < 9 ? 2 * pp + 1 : 8][0], sc[2 * pp + 1 < 9 ? 2 * pp + 1 : 8][1]); pw.w = cvt_pk_bf16(sc[2 * pp + 1 < 9 ? 2 * pp + 1 : 8][2], sc[2 * pp + 1 < 9 ? 2 * pp + 1 : 8][3]); }
                    else { pw.z = 0u; pw.w = 0u; }
                    const bf16x8 pf = __builtin_bit_cast(bf16x8, pw);
#pragma unroll
                    for (int db = 0; db < 4; ++db) {
                        const LAS bf16* vp = VT + (16 * db + ql) * VSTR + 16 * (i + 2 * pp) + 4 * kg;
                        v4u vw; const v2u l2 = *(const LAS v2u*)vp; vw.x = l2.x; vw.y = l2.y;
                        if (pp < 4) { const v2u h2 = *(const LAS v2u*)(vp + 16); vw.z = h2.x; vw.w = h2.y; } else { vw.z = 0u; vw.w = 0u; }
                        o[db] = __builtin_amdgcn_mfma_f32_16x16x32_bf16(__builtin_bit_cast(bf16x8, vw), pf, o[db], 0, 0, 0);
                    }
                }
#pragma unroll
                for (int db = 0; db < 4; ++db) { v2u w; w.x = cvt_pk_bf16(o[db][0] * inv, o[db][1] * inv); w.y = cvt_pk_bf16(o[db][2] * inv, o[db][3] * inv);
                    *(v2u*)(qp + 16 * db + 4 * kg) = w; }
            }
            __syncthreads();
        }
        GRID_BAR();
    }

    if (IN(9)) {
        pg8::StaticOrder S; S.init(M, D, D, D, G, bid, Qb, Wo_t);
        pg8::EpiRes E{X, X, IN_(19), XB1, nullptr};
        pg8::gemm_phase<pg8::EpiRes, pg8::StaticOrder, false, false>(F.lds, D, S, E);
        GRID_BAR();
    }

    if (IN(10)) {
        LAS float* WRL = (LAS float*)(F.lds);
        LAS int* lcnt = (LAS int*)(F.lds + 32768);
        LAS unsigned* rec = (LAS unsigned*)(F.lds + 32768 + 64);
        for (int i = tid; i < NE * D / 4; i += NWAVES * 64) ((LAS f32x4*)WRL)[i] = ((const f32x4*)WR)[i];
        for (int chunk = bid; chunk < M / 64; chunk += G) {
            if (tid < 8) lcnt[tid] = 0;
            __syncthreads();
            for (int k = 0; k < 8; ++k) {
                const int tl = wave * 8 + k, tok = chunk * 64 + tl;
                const f32x4* xr = (const f32x4*)(X + (size_t)tok * D) + lane; f32x4 v[4]; float s = 0.f;
#pragma unroll
                for (int j = 0; j < 4; ++j) { v[j] = xr[64 * j]; s += (v[j].x * v[j].x + v[j].y * v[j].y) + (v[j].z * v[j].z + v[j].w * v[j].w); }
                float dot[8];
#pragma unroll
                for (int e = 0; e < 8; ++e) { float d = 0.f;
#pragma unroll
                    for (int j = 0; j < 4; ++j) { const f32x4 w = ((const LAS f32x4*)(WRL + e * D))[lane + 64 * j]; d += (v[j].x * w.x + v[j].y * w.y) + (v[j].z * w.z + v[j].w * w.w); }
                    dot[e] = d; }
                s = wave_sum(s);
#pragma unroll
                for (int e = 0; e < 8; ++e) dot[e] = wave_sum(dot[e]);
                const float r = __builtin_amdgcn_rsqf(s * (1.0f / D) + EPS);
                int e0 = 0; float v0 = dot[0] * r;
#pragma unroll
                for (int e = 1; e < 8; ++e) { const float l = dot[e] * r; if (l > v0) { v0 = l; e0 = e; } }
                int e1 = -1; float v1 = -INFINITY;
#pragma unroll
                for (int e = 0; e < 8; ++e) { const float l = dot[e] * r; if (e != e0 && l > v1) { v1 = l; e1 = e; } }
                const float w1 = fast_rcp(1.0f + fast_exp2((v0 - v1) * LOG2E)), w0 = 1.0f - w1;
                if (lane == 0) {
                    const int p0 = __hip_atomic_fetch_add(&lcnt[e0], 1, __ATOMIC_RELAXED, __HIP_MEMORY_SCOPE_WORKGROUP);
                    const int p1 = __hip_atomic_fetch_add(&lcnt[e1], 1, __ATOMIC_RELAXED, __HIP_MEMORY_SCOPE_WORKGROUP);
                    LAS unsigned* rp = rec + tl * 6; rp[0] = (unsigned)e0; rp[1] = (unsigned)e1; rp[2] = (unsigned)p0; rp[3] = (unsigned)p1; rp[4] = __float_as_uint(w0); rp[5] = __float_as_uint(w1);
                    R4[tok] = r;
                }
            }
            __syncthreads();
            if (tid < 8) lcnt[8 + tid] = (int)__hip_atomic_fetch_add(GCNT + 64 * tid, (unsigned)lcnt[tid], __ATOMIC_RELAXED, __HIP_MEMORY_SCOPE_AGENT);
            __syncthreads();
            if (tid < 64) {
                const int tok = chunk * 64 + tid; const LAS unsigned* rp = rec + tid * 6;
                const int e0 = (int)rp[0], e1 = (int)rp[1]; const int q0 = lcnt[8 + e0] + (int)rp[2], q1 = lcnt[8 + e1] + (int)rp[3];
                TOKLIST[e0 * M + q0] = tok; TOKLIST[e1 * M + q1] = tok; SLOTW[e0 * M + q0] = __uint_as_float(rp[4]); SLOTW[e1 * M + q1] = __uint_as_float(rp[5]);
                TOKSLOT[2 * tok] = ((unsigned)e0 << 16) | (unsigned)q0; TOKSLOT[2 * tok + 1] = ((unsigned)e1 << 16) | (unsigned)q1;
            }
            __syncthreads();
        }
        GRID_BAR();
    }

    LAS int* const etab = (LAS int*)(F.lds + MISC_OFF) + 32;
    if (IN(11) || IN(12) || IN(13)) {
        if (tid == 0) { int ts = 0, off = 0;
            for (int e = 0; e < 8; ++e) { const int cn = (int)__hip_atomic_load(GCNT + 64 * e, __ATOMIC_RELAXED, __HIP_MEMORY_SCOPE_AGENT); etab[e] = ts; etab[9 + e] = off; etab[18 + e] = cn; ts += (cn + 255) >> 8; off += cn; }
            etab[8] = ts; etab[17] = off; }
        __syncthreads();
    }

    if (IN(11)) {
        LAS unsigned* toktab = (LAS unsigned*)(F.lds + TOKTAB_OFF);
        pg8::MoeOrder S{etab, toktab, FFE / 128, G, bid, etab[8] * (FFE / 128), D, (const char*)XB1, (const char*)MWgu_t, (size_t)D * 2, (size_t)2 * FFE * D * 2, (size_t)256 * D * 2};
        { pg8::Unit u; for (int ui = 0; ui < 16 && S.next(ui, u); ++ui) { if (tid < 256) { const int tok = TOKLIST[u.e * M + (tid < u.cnt ? u.pm * 256 + tid : 0)]; toktab[ui * 256 + tid] = (unsigned)tok * (unsigned)(D * 2); } } }
        __syncthreads();
        pg8::EpiHid<true> E{HIDM, FFE, nullptr, R4, TOKLIST};
        pg8::gemm_phase<pg8::EpiHid<true>, pg8::MoeOrder, true, true>(F.lds, D, S, E);
        GRID_BAR();
    }

    if (IN(12)) {
        pg8::MoeOrder S{etab, nullptr, D / 256, G, bid, etab[8] * (D / 256), FFE, (const char*)HIDM, (const char*)MWd_t, (size_t)FFE * 2, (size_t)D * FFE * 2, (size_t)256 * FFE * 2};
        pg8::EpiBf<true> E{YS, D, SLOTW};
        pg8::gemm_phase<pg8::EpiBf<true>, pg8::MoeOrder, true, false>(F.lds, FFE, S, E);
        GRID_BAR();
    }

    if (IN(13)) {
        for (int m = gw; m < M; m += NGW) {
            const unsigned s0 = TOKSLOT[2 * m], s1 = TOKSLOT[2 * m + 1];
            const size_t r0 = (size_t)(etab[9 + (s0 >> 16)] + (int)(s0 & 0xffffu)), r1 = (size_t)(etab[9 + (s1 >> 16)] + (int)(s1 & 0xffffu));
            f32x4* xr = (f32x4*)(X + (size_t)m * D) + lane; const v2u* y0 = (const v2u*)(YS + r0 * D) + lane; const v2u* y1 = (const v2u*)(YS + r1 * D) + lane;
            v2u* o8 = (v2u*)(XB0 + (size_t)m * D) + lane; float s = 0.f;
#pragma unroll
            for (int j = 0; j < 4; ++j) { f32x4 v = xr[64 * j]; const v2u a = y0[64 * j], b = y1[64 * j];
                v.x += bf_lo(a.x) + bf_lo(b.x); v.y += bf_hi(a.x) + bf_hi(b.x); v.z += bf_lo(a.y) + bf_lo(b.y); v.w += bf_hi(a.y) + bf_hi(b.y);
                xr[64 * j] = v; s += (v.x * v.x + v.y * v.y) + (v.z * v.z + v.w * v.w);
                v2u w; w.x = cvt_pk_bf16(v.x, v.y); w.y = cvt_pk_bf16(v.z, v.w); o8[64 * j] = w; }
            s = wave_sum(s);
            if (lane < 16) SS5[(size_t)m * 16 + lane] = lane == 0 ? s : 0.f;
        }
        VM_WAIT(); __syncthreads();
        { pg8::StaticOrder S; S.init(M, D, PLE, PLE, G, bid, PB + (size_t)M * PLE, Wpp1_t);
          pg8::EpiBf<false> E{PROJ, D, nullptr};
          pg8::gemm_phase<pg8::EpiBf<false>, pg8::StaticOrder, false, false>(F.lds, PLE, S, E); }
        GRID_BAR();
    }

    if (IN(14)) {
        pg8::StaticOrder S; S.init(M, D, D, D, G, bid, XB0, Wpg1_t);
        pg8::EpiPle E{X, PROJ, SS5, nullptr, nullptr};
        pg8::gemm_phase<pg8::EpiPle, pg8::StaticOrder, false, false>(F.lds, D, S, E);
        GRID_BAR();
    }

    if (IN(15)) {
        const f32x4* gp = (const f32x4*)IN_(30) + lane;
        const f32x4 g0 = gp[0], g1 = gp[64], g2 = gp[128], g3 = gp[192];
        for (int m = gw; m < M; m += NGW) {
            f32x4* xr = (f32x4*)(X + (size_t)m * D) + lane; f32x4 v[4]; float s = 0.f;
#pragma unroll
            for (int j = 0; j < 4; ++j) { v[j] = xr[64 * j]; s += (v[j].x * v[j].x + v[j].y * v[j].y) + (v[j].z * v[j].z + v[j].w * v[j].w); }
            s = wave_sum(s); const float r = __builtin_amdgcn_rsqf(s * (1.0f / D) + EPS);
            xr[0] = v[0] * r * g0; xr[64] = v[1] * r * g1; xr[128] = v[2] * r * g2; xr[192] = v[3] * r * g3;
        }
    }
#undef IN
#undef GRID_BAR
}

constexpr int N_PHASES = 16;
extern "C" void kernel_launch(void* const* d_in, const int* in_sizes, int n_in, void* d_out, int out_size, void* d_ws, size_t ws_size, hipStream_t stream) {
    static int grid = 0;
    if (grid == 0) {
        if (n_in != 31 || out_size != M * D || ws_size < WS_END) { fprintf(stderr, "kernel_launch: unexpected shapes (n_in %d, out %d, ws %zu < %zu)\n", n_in, out_size, ws_size, (size_t)WS_END); grid = -1; return; }
        int dev = 0, cus = 0;
        if (hipGetDevice(&dev) != hipSuccess || hipDeviceGetAttribute(&cus, hipDeviceAttributeMultiprocessorCount, dev) != hipSuccess) { grid = -1; return; }
        if (hipFuncSetAttribute((const void*)fwd_kernel, hipFuncAttributeMaxDynamicSharedMemorySize, LDS_BYTES) != hipSuccess) { fprintf(stderr, "kernel_launch: hipFuncSetAttribute failed\n"); grid = -1; return; }
        int per_cu = 0;
        if (hipOccupancyMaxActiveBlocksPerMultiprocessor(&per_cu, (const void*)fwd_kernel, NWAVES * 64, LDS_BYTES) != hipSuccess || per_cu < 1) fprintf(stderr, "kernel_launch: occupancy query reports %d\n", per_cu);
        (void)hipGetLastError();
        grid = cus;
    }
    if (grid < 0) return;
    (void)in_sizes;
    if (hipMemsetAsync((char*)d_ws + WS_CTL, 0, CTL_ZERO_BYTES, stream) != hipSuccess) return;
    Args a{};
    for (int i = 0; i < 31; ++i) a.in[i] = (const float*)d_in[i];
    a.out = (float*)d_out; a.ws = (unsigned char*)d_ws;
    if (MK_N_LAUNCHES == 1) {
        a.ph_lo = 0; a.ph_hi = N_PHASES; a.li = 0;
        hipLaunchKernelGGL(fwd_kernel, dim3(grid), dim3(NWAVES * 64), LDS_BYTES, stream, a);
    } else {
        for (int li = 0; li < N_PHASES; ++li) { a.ph_lo = li; a.ph_hi = li + 1; a.li = li;
            hipLaunchKernelGGL(fwd_kernel, dim3(grid), dim3(NWAVES * 64), LDS_BYTES, stream, a); }
    }
}
```

```cpp
#include <hip/hip_runtime.h>
#include <cstdio>
#include <cstdint>

#ifndef MK_N_LAUNCHES
#define MK_N_LAUNCHES 1
#endif

#define GAS __attribute__((address_space(1)))
#define LAS __attribute__((address_space(3)))
typedef unsigned short bf16;
typedef unsigned v4u __attribute__((ext_vector_type(4)));
typedef unsigned v2u __attribute__((ext_vector_type(2)));
typedef float f32x4 __attribute__((ext_vector_type(4)));
typedef float f32x2 __attribute__((ext_vector_type(2)));
typedef short bf16x8 __attribute__((ext_vector_type(8)));
typedef short s16x4 __attribute__((ext_vector_type(4)));

constexpr int M = 16384, D = 1024, SEQ = 4096;
constexpr int GF = 6144, GH = 3072, GD = 384;
constexpr int FFD = 2816, NE = 8, FFE = 3584, PLE = 256;
constexpr int NQKV = 1536;
constexpr float EPS = 1e-6f;
constexpr float LOG2E = 1.4426950408889634f;
constexpr float QSCALE = 0.125f * LOG2E;

constexpr size_t MiB = 1u << 20;
constexpr size_t WS_CTL = 0, CTL_ZERO_BYTES = 1 * MiB;
constexpr size_t WS_SS = 1 * MiB;
constexpr size_t WS_R4 = 6 * MiB;
constexpr size_t WS_TOKSLOT = WS_R4 + 64 * 1024;
constexpr size_t WS_TOKLIST = WS_TOKSLOT + 128 * 1024;
constexpr size_t WS_SLOTW = WS_TOKLIST + 512 * 1024;
constexpr size_t WS_WR = WS_SLOTW + 512 * 1024;
constexpr size_t WS_VSTAT = 8 * MiB;
constexpr size_t WS_ROPE = 14 * MiB;
constexpr size_t WS_PB = 15 * MiB;
constexpr size_t WS_XB1 = 31 * MiB;
constexpr size_t WS_WPG1 = 63 * MiB;
constexpr size_t WS_WPP1 = 65 * MiB;
constexpr size_t WS_MWGU = 66 * MiB;
constexpr size_t WS_MWD = 178 * MiB;
constexpr size_t WS_B = 234 * MiB;
constexpr size_t WS_WIN = WS_B;
constexpr size_t WS_WOUT = WS_B + 12 * MiB;
constexpr size_t WS_WGU = WS_B + 18 * MiB;
constexpr size_t WS_WD = WS_B + 29 * MiB;
constexpr size_t WS_WPG0 = WS_B + 35 * MiB;
constexpr size_t WS_WPP0 = WS_B + 37 * MiB;
constexpr size_t WS_WQKV = WS_B + 38 * MiB;
constexpr size_t WS_WO = WS_B + 41 * MiB;
constexpr size_t WS_XB0 = WS_B + 43 * MiB;
constexpr size_t WS_UV = WS_B + 75 * MiB;
constexpr size_t WS_HID = WS_UV;
constexpr size_t WS_PROJ = WS_UV + 96 * MiB;
constexpr size_t WS_Q = WS_UV;
constexpr size_t WS_K = WS_UV + 32 * MiB;
constexpr size_t WS_V = WS_UV + 40 * MiB;
constexpr size_t WS_HIDM = WS_B;
constexpr size_t WS_YS = WS_MWGU;
constexpr size_t WS_END = WS_B + 267 * MiB;
static_assert(WS_HIDM + (size_t)(32768 + 256) * FFE * 2 <= WS_END, "hidm");
static_assert(WS_WR + 32768 <= WS_VSTAT, "misc");

constexpr int CW_TMO = 0, CW_BAR = 4096, CW_CNT = 8192;

constexpr int RING_BYTES = 131072;
constexpr int TOKTAB_OFF = RING_BYTES;
constexpr int MISC_OFF = RING_BYTES + 16384;
constexpr int LDS_BYTES = MISC_OFF + 512;
constexpr int NWAVES = 8;

#define RLX_AGENT __ATOMIC_RELAXED, __HIP_MEMORY_SCOPE_AGENT
#define LDS_WAIT() asm volatile("s_waitcnt lgkmcnt(0)" ::: "memory")
#define VM_WAIT() asm volatile("s_waitcnt vmcnt(0)" ::: "memory")
__device__ __forceinline__ unsigned cvt_pk_bf16(float lo, float hi) { unsigned r; asm volatile("v_cvt_pk_bf16_f32 %0, %1, %2" : "=v"(r) : "v"(lo), "v"(hi)); return r; }
__device__ __forceinline__ float bf_lo(unsigned w) { return __uint_as_float(w << 16); }
__device__ __forceinline__ float bf_hi(unsigned w) { return __uint_as_float(w & 0xffff0000u); }
__device__ __forceinline__ float fast_rcp(float x) { return __builtin_amdgcn_rcpf(x); }
__device__ __forceinline__ float fast_exp2(float x) { return __builtin_amdgcn_exp2f(x); }
__device__ __forceinline__ float sigmoid_f(float x) { return fast_rcp(1.0f + fast_exp2(-x * LOG2E)); }
__device__ __forceinline__ float gelu_tanh(float x) { const float u = 0.7978845608028654f * (x + 0.044715f * x * x * x); return x * fast_rcp(1.0f + fast_exp2(-2.0f * LOG2E * u)); }
__device__ __forceinline__ f32x2 gelu_tanh2(f32x2 x) {
    const f32x2 t = x * x; const f32x2 p = t * (-0.10294324f) + (-2.3022082f); const f32x2 z = x * p;
    f32x2 e; e.x = fast_exp2(z.x); e.y = fast_exp2(z.y); const f32x2 d = e + 1.0f;
    f32x2 r; r.x = fast_rcp(d.x); r.y = fast_rcp(d.y); return x * r;
}
__device__ __forceinline__ f32x2 sigm2(f32x2 y  ) { f32x2 e; e.x = fast_exp2(y.x); e.y = fast_exp2(y.y); const f32x2 d = e + 1.0f; f32x2 r; r.x = fast_rcp(d.x); r.y = fast_rcp(d.y); return r; }
__device__ __forceinline__ float wave_sum(float v) {
#pragma unroll
    for (int o = 1; o < 64; o <<= 1) v += __shfl_xor(v, o);
    return v;
}
__device__ __forceinline__ float row_rscale(const float* ss, int row, int fq) {
    const f32x4 v = *(const f32x4*)(ss + (size_t)row * 16 + 4 * fq);
    float s = (v.x + v.y) + (v.z + v.w);
    s += __shfl_xor(s, 16); s += __shfl_xor(s, 32);
    return __builtin_amdgcn_rsqf(s * (1.0f / D) + EPS);
}

#define XB_TMO      128
#define XB_XCNT(j)  (256  + 64 * (j))
#define XB_XSUB(j)  (1280 + 64 * (j))
#define XB_XGEN(j)  (2304 + 64 * (j))
#define XB_TOP      3328
#define XB_TOPGEN   3392
#define XCD_BAR_WORDS 3456
#define XB_SPIN_CAP (1u << 18)
__device__ __forceinline__ unsigned xb_ld(unsigned* p)              { return __hip_atomic_load(p, __ATOMIC_RELAXED, __HIP_MEMORY_SCOPE_AGENT); }
__device__ __forceinline__ unsigned xb_add(unsigned* p, unsigned v) { return __hip_atomic_fetch_add(p, v, __ATOMIC_RELAXED, __HIP_MEMORY_SCOPE_AGENT); }
__device__ __forceinline__ unsigned xb_xcc_id() { return (unsigned)__builtin_amdgcn_s_getreg((3 << 11) | 20) & 0xFu; }
#define XB_SPIN(cond, bar) do { unsigned _sp = 0; while (cond) { __builtin_amdgcn_s_sleep(1); \
    if ((++_sp & 255u) == 0u) { if (xb_ld(&(bar)[XB_TMO])) break; if (_sp > XB_SPIN_CAP) { atomicAdd(&(bar)[XB_TMO], 1u); break; } } } } while (0)
struct XcdBarrier { unsigned* bar; unsigned x; volatile LAS unsigned* st; };
__device__ __forceinline__ XcdBarrier xcd_barrier_post(unsigned* bar, volatile LAS unsigned* st) {
    XcdBarrier b; b.bar = bar; b.x = xb_xcc_id(); b.st = st;
    if (threadIdx.x == 0) (void)xb_add(&bar[XB_XCNT(b.x)], 1u);
    return b;
}
__device__ __forceinline__ void xcd_barrier_complete(unsigned* bar, unsigned x, unsigned& nloc, unsigned& nx) {
    const unsigned G = gridDim.x * gridDim.y * gridDim.z;
    unsigned sum, cnt, mine, sp = 0u;
    for (;;) {
        sum = 0u; cnt = 0u; mine = 0u;
#pragma unroll
        for (unsigned j = 0; j < 16; ++j) { const unsigned c = xb_ld(&bar[XB_XCNT(j)]); sum += c; cnt += (c > 0u) ? 1u : 0u; mine = (j == x) ? c : mine; }
        if (sum == G) break;
        __builtin_amdgcn_s_sleep(1);
        if ((++sp & 255u) == 0u) { if (xb_ld(&bar[XB_TMO])) break; if (sp > XB_SPIN_CAP) { atomicAdd(&bar[XB_TMO], 1u); break; } }
    }
    nloc = mine > 0u ? mine : 1u; nx = cnt > 0u ? cnt : 1u;
}
__device__ __forceinline__ void xcd_barrier(const XcdBarrier& b) {
    asm volatile("s_waitcnt vmcnt(0)" ::: "memory");
    __syncthreads();
    if (threadIdx.x == 0) {
        unsigned* bar = b.bar;
        __builtin_amdgcn_s_waitcnt(0);
        unsigned nloc = b.st[0], nx = b.st[1];
        if (nloc == 0u) { xcd_barrier_complete(bar, b.x, nloc, nx); b.st[0] = nloc; b.st[1] = nx; }
        const unsigned old = xb_add(&bar[XB_XSUB(b.x)], 1u);
        const unsigned gen = old / nloc;
        if (old + 1u == (gen + 1u) * nloc) {
            __builtin_amdgcn_fence(__ATOMIC_RELEASE, "agent");
            asm volatile("s_waitcnt vmcnt(0)" ::: "memory");
            const unsigned og = xb_add(&bar[XB_TOP], 1u);
            const unsigned tg = og / nx;
            if (og + 1u == (tg + 1u) * nx) xb_add(&bar[XB_TOPGEN], 1u);
            else XB_SPIN(xb_ld(&bar[XB_TOPGEN]) == tg, bar);
            __builtin_amdgcn_fence(__ATOMIC_ACQUIRE, "agent");
            xb_add(&bar[XB_XGEN(b.x)], 1u);
            asm volatile("s_waitcnt vmcnt(0)" ::: "memory");
        } else {
            XB_SPIN(xb_ld(&bar[XB_XGEN(b.x)]) == gen, bar);
            __builtin_amdgcn_fence(__ATOMIC_ACQUIRE, "agent");
            asm volatile("s_waitcnt vmcnt(0)" ::: "memory");
        }
    }
    __syncthreads();
}

namespace pg8 {
constexpr int BM = 256, BK = 64, HALF = 128, HTB = HALF * BK * 2, STAGE_BYTES = 8 * HTB, NXCD = 8, WGM = 8;
__host__ __device__ __forceinline__ int lds_byte(int r, int c) { const int st = (r >> 4) * 2 + (c >> 5), rr = r & 15, cc = c & 31, ob = rr * 64 + cc * 2; return st * 1024 + (ob ^ (((ob >> 9) & 1) << 5)); }
__host__ __device__ __forceinline__ void stage_rc(int b, int& R, int& C) { const int st = b / 1024, sb = b % 1024, swz = sb ^ (((sb >> 9) & 1) << 5); R = (st >> 1) * 16 + swz / 64; C = (st & 1) * 32 + (swz % 64) / 2; }
__host__ __device__ __forceinline__ int perm32(int rho) { const int n = rho >> 4, i = rho & 15; return 8 * (i >> 2) + 4 * n + (i & 3); }

struct Unit { int pm, pn, e, r0, cnt; };

struct StaticOrder {
    int nM, nN, nwg, G, c, lda; const char* A; const char* Bt; size_t tstepA, tstepB;
    __device__ __forceinline__ void init(int M_, int N_, int K_, int lda_, int G_, int c_, const bf16* A_, const bf16* Bt_) { nM = M_ / BM; nN = N_ / BM; nwg = nM * nN; G = G_; c = c_; lda = lda_; A = (const char*)A_; Bt = (const char*)Bt_; tstepA = (size_t)BM * lda_ * 2; tstepB = (size_t)BM * K_ * 2; }
    __device__ __forceinline__ bool next(int i, Unit& u) const {
        const long L = (long)i * G + c; if (L >= nwg) return false;
        int wgid = (int)L; { const int q = nwg / NXCD, r = nwg % NXCD, xcd = wgid % NXCD, off = wgid / NXCD; wgid = (xcd < r ? xcd * (q + 1) : r * (q + 1) + (xcd - r) * q) + off; }
        const int nig = WGM * nN, gid = wgid / nig, fm = gid * WGM, gsz = (nM - fm) < WGM ? (nM - fm) : WGM;
        u.pm = fm + ((wgid % nig) % gsz); u.pn = (wgid % nig) / gsz; u.e = 0; u.r0 = u.pm * BM; u.cnt = BM; return true;
    }
    __device__ __forceinline__ const char* a_base(const Unit& u) const { return A + (size_t)u.pm * tstepA; }
    __device__ __forceinline__ const char* b_base(const Unit& u) const { return Bt + (size_t)u.pn * tstepB; }
    __device__ __forceinline__ unsigned a_off(int, int) const { return 0u; }
};

struct MoeOrder {
    const LAS int* tab; const LAS unsigned* toktab; int NT, G, c, total, lda; const char* A; const char* Bt; size_t a_row_bytes, b_exp_bytes, b_tile_bytes;
    __device__ __forceinline__ bool next(int i, Unit& u) const {
        const long L = (long)i * G + c; if (L >= total) return false;
        const int mtg = (int)(L / NT), pn = (int)(L % NT);
        int e = 0;
#pragma unroll
        for (int j = 1; j < 8; ++j) e += (mtg >= __builtin_amdgcn_readfirstlane(tab[j])) ? 1 : 0;
        const int ts = __builtin_amdgcn_readfirstlane(tab[e]), off = __builtin_amdgcn_readfirstlane(tab[9 + e]), cn = __builtin_amdgcn_readfirstlane(tab[18 + e]);
        u.e = e; u.pm = mtg - ts; u.pn = pn; u.r0 = off + BM * u.pm; const int rem = cn - BM * u.pm; u.cnt = rem < BM ? rem : BM; return true;
    }
    __device__ __forceinline__ const char* a_base(const Unit& u) const { return toktab ? A : A + (size_t)u.r0 * a_row_bytes; }
    __device__ __forceinline__ const char* b_base(const Unit& u) const { return Bt + (size_t)u.e * b_exp_bytes + (size_t)u.pn * b_tile_bytes; }
    __device__ __forceinline__ unsigned a_off(int ui, int R) const { return toktab[(ui & 15) * 256 + R]; }
};

template <class Epi, class Sched, bool ALIGN_EPI, bool GATHER>
__device__ __forceinline__ void gemm_phase(LAS unsigned char* lds, const int K, const Sched& S, const Epi& E) {
    const int tid = threadIdx.x, wid = __builtin_amdgcn_readfirstlane(tid >> 6), lane = tid & 63, wr = wid >> 2, wc = wid & 3, fr = lane & 15, fq = lane >> 4;
    const int nt = K / BK;
    unsigned voffB[2], vAc[2][2], vAn[2][2]; int Rr[2], Cb[2];
    const size_t kstep = (size_t)(BK * 2);
    const size_t hstep = (size_t)HALF * K * 2;
#pragma unroll
    for (int i = 0; i < 2; ++i) { int R, C; stage_rc(tid * 16 + i * 8192, R, C); const int Rb = Epi::PERM ? ((R & ~31) + perm32(R & 31)) : R;
        Rr[i] = R; Cb[i] = C * 2; voffB[i] = (unsigned)(Rb * K + C) * 2u; }
    const unsigned ldsw = (unsigned)wid * 1024u;
    const int aoff = lds_byte(wr * 64 + fr, fq * 8), boff = lds_byte(wc * 32 + fr, fq * 8);
#define PG8_SA(b, h) (((b) * 2 + (h)) * HTB)
#define PG8_SB(b, h) ((4 + (b) * 2 + (h)) * HTB)
#define PG8_STAGE(bufoff, gbase, voff) do { _Pragma("unroll") for (int _i = 0; _i < 2; ++_i) \
        __builtin_amdgcn_global_load_lds((const unsigned*)((const char*)(gbase) + (voff)[_i]), (LAS unsigned*)(lds + (bufoff) + ldsw + _i * 8192), 16, 0, 0); } while (0)
#define PG8_LDA(dst, b, h) do { _Pragma("unroll") for (int m = 0; m < 4; ++m) _Pragma("unroll") for (int k = 0; k < 2; ++k) dst[m][k] = *(const LAS bf16x8*)(lds + PG8_SA(b, h) + aoff + m * 2048 + k * 1024); } while (0)
#define PG8_LDB(dst, b, h) do { _Pragma("unroll") for (int n = 0; n < 2; ++n) _Pragma("unroll") for (int k = 0; k < 2; ++k) dst[n][k] = *(const LAS bf16x8*)(lds + PG8_SB(b, h) + boff + n * 2048 + k * 1024); } while (0)
#define PG8_MMA(ai, bj, At, Bt) do { __builtin_amdgcn_s_setprio(1); _Pragma("unroll") for (int m = 0; m < 4; ++m) _Pragma("unroll") for (int n = 0; n < 2; ++n) _Pragma("unroll") for (int k = 0; k < 2; ++k) \
        acc[ai][bj][m][n] = __builtin_amdgcn_mfma_f32_16x16x32_bf16(Bt[n][k], At[m][k], acc[ai][bj][m][n], 0, 0, 0); __builtin_amdgcn_s_setprio(0); } while (0)
#define PG8_WAIT_V(n) asm volatile("s_waitcnt vmcnt(" #n ")" ::: "memory")
#define PG8_WAIT_L(n) asm volatile("s_waitcnt lgkmcnt(" #n ")" ::: "memory")
#define PG8_BAR __builtin_amdgcn_s_barrier()
#define PG8_SCHED __builtin_amdgcn_sched_barrier(0)
#define PG8_VOFF(dst, ui_) do { _Pragma("unroll") for (int _h = 0; _h < 2; ++_h) _Pragma("unroll") for (int _i = 0; _i < 2; ++_i) \
        dst[_h][_i] = GATHER ? (S.a_off((ui_), Rr[_i] + _h * HALF) + (unsigned)Cb[_i]) : (unsigned)((Rr[_i] + _h * HALF) * S.lda * 2 + Cb[_i]); } while (0)
    Unit cur, nxt; int ui = 0;
    if (!S.next(0, cur)) return;
    f32x4 acc[2][2][4][2];
#pragma unroll
    for (int a = 0; a < 2; ++a)
#pragma unroll
        for (int b = 0; b < 2; ++b)
#pragma unroll
            for (int m = 0; m < 4; ++m)
#pragma unroll
                for (int n = 0; n < 2; ++n) acc[a][b][m][n] = (f32x4){0.f, 0.f, 0.f, 0.f};
    bf16x8 At[4][2], B0[2][2], B1[2][2];
    const char* cA = S.a_base(cur); const char* cB = S.b_base(cur);
    PG8_VOFF(vAc, 0);
    PG8_STAGE(PG8_SB(0, 0), cB, voffB); PG8_STAGE(PG8_SB(0, 1), cB + hstep, voffB); PG8_STAGE(PG8_SA(0, 0), cA, vAc[0]); PG8_STAGE(PG8_SA(0, 1), cA, vAc[1]);
    if (wr == 1) PG8_BAR;
    PG8_WAIT_V(2); PG8_BAR;
    PG8_STAGE(PG8_SB(1, 0), cB + kstep, voffB); PG8_STAGE(PG8_SA(1, 0), cA + kstep, vAc[0]); PG8_STAGE(PG8_SB(1, 1), cB + hstep + kstep, voffB);
    PG8_WAIT_V(6); PG8_BAR;
    for (;;) {
        const bool has_next = S.next(ui + 1, nxt);
        const char* nA = has_next ? S.a_base(nxt) : cA; const char* nB = has_next ? S.b_base(nxt) : cB;
        if (GATHER) { if (has_next) { PG8_VOFF(vAn, ui + 1); } else {
#pragma unroll
            for (int h = 0; h < 2; ++h)
#pragma unroll
                for (int i = 0; i < 2; ++i) vAn[h][i] = vAc[h][i]; } }
        for (int t = 0; t < nt; t += 2) {
            const bool last = (t == nt - 2);
            const char* a1 = cA + (size_t)(t + 1) * kstep;
            const char* a2 = last ? nA : cA + (size_t)(t + 2) * kstep; const char* b2 = last ? nB : cB + (size_t)(t + 2) * kstep;
            const char* a3 = a2 + kstep; const char* b3 = b2 + kstep;
            unsigned vA2[2][2];
#pragma unroll
            for (int h = 0; h < 2; ++h)
#pragma unroll
                for (int i = 0; i < 2; ++i) vA2[h][i] = (GATHER && last) ? vAn[h][i] : vAc[h][i];
            PG8_LDB(B0, 0, 0); PG8_LDB(B1, 0, 1); PG8_SCHED; PG8_LDA(At, 0, 0); PG8_STAGE(PG8_SA(1, 1), a1, vAc[1]);
            PG8_WAIT_V(8); PG8_WAIT_L(0); PG8_BAR; PG8_MMA(0, 0, At, B0); PG8_MMA(0, 1, At, B1); PG8_BAR; PG8_SCHED;
            PG8_LDA(At, 0, 1); PG8_STAGE(PG8_SB(0, 0), b2, voffB); PG8_STAGE(PG8_SB(0, 1), b2 + hstep, voffB); PG8_STAGE(PG8_SA(0, 0), a2, vA2[0]);
            PG8_WAIT_V(8); PG8_WAIT_L(0); PG8_BAR; PG8_MMA(1, 0, At, B0); PG8_MMA(1, 1, At, B1); PG8_BAR; PG8_SCHED;
            PG8_LDB(B0, 1, 0); PG8_LDB(B1, 1, 1); PG8_SCHED; PG8_LDA(At, 1, 0); PG8_STAGE(PG8_SA(0, 1), a2, vA2[1]);
            PG8_WAIT_V(8); PG8_WAIT_L(0); PG8_BAR; PG8_MMA(0, 0, At, B0); PG8_MMA(0, 1, At, B1); PG8_BAR; PG8_SCHED;
            PG8_LDA(At, 1, 1); PG8_STAGE(PG8_SB(1, 0), b3, voffB); PG8_STAGE(PG8_SB(1, 1), b3 + hstep, voffB); PG8_STAGE(PG8_SA(1, 0), a3, vA2[0]);
            PG8_WAIT_V(8); PG8_WAIT_L(0); PG8_BAR; PG8_MMA(1, 0, At, B0); PG8_MMA(1, 1, At, B1); PG8_BAR; PG8_SCHED;
        }
        if constexpr (ALIGN_EPI) { if (wr == 0) PG8_BAR; }
        E(acc, cur, wr, wc, fr, fq);
        if (!has_next) break;
#pragma unroll
        for (int a = 0; a < 2; ++a)
#pragma unroll
            for (int b = 0; b < 2; ++b)
#pragma unroll
                for (int m = 0; m < 4; ++m)
#pragma unroll
                    for (int n = 0; n < 2; ++n) acc[a][b][m][n] = (f32x4){0.f, 0.f, 0.f, 0.f};
        cur = nxt; cA = nA; cB = nB; ++ui;
        if (GATHER) {
#pragma unroll
            for (int h = 0; h < 2; ++h)
#pragma unroll
                for (int i = 0; i < 2; ++i) vAc[h][i] = vAn[h][i]; }
        if constexpr (ALIGN_EPI) { if (wr == 1) PG8_BAR; }
    }
    PG8_WAIT_V(0);
    if constexpr (!ALIGN_EPI) { if (wr == 0) PG8_BAR; }
    PG8_BAR;
#undef PG8_SA
#undef PG8_SB
#undef PG8_STAGE
#undef PG8_LDA
#undef PG8_LDB
#undef PG8_MMA
#undef PG8_WAIT_V
#undef PG8_WAIT_L
#undef PG8_BAR
#undef PG8_SCHED
#undef PG8_VOFF
}

typedef const f32x4 (&AccT)[2][2][4][2];

struct EpiUV {
    static constexpr bool PERM = true;
    bf16* O; const float* bias; const float* ss; float* vstat;
    __device__ __forceinline__ void operator()(AccT acc, const Unit& u, int wr, int wc, int fr, int fq) const {
        const int col0 = u.pn * BM + wc * 32 + 8 * fq; const bool isv = u.pn >= 12;
        f32x4 bv[2][2]; f32x4 sv[2][4]; float rr[2][4];
#pragma unroll
        for (int ai = 0; ai < 2; ++ai)
#pragma unroll
            for (int m = 0; m < 4; ++m) sv[ai][m] = *(const f32x4*)(ss + (size_t)(u.r0 + ai * HALF + wr * 64 + m * 16 + fr) * 16 + 4 * fq);
#pragma unroll
        for (int bj = 0; bj < 2; ++bj)
#pragma unroll
            for (int n = 0; n < 2; ++n) bv[bj][n] = *(const f32x4*)(bias + col0 + bj * HALF + 4 * n);
#pragma unroll
        for (int ai = 0; ai < 2; ++ai)
#pragma unroll
            for (int m = 0; m < 4; ++m) { float q = (sv[ai][m].x + sv[ai][m].y) + (sv[ai][m].z + sv[ai][m].w); q += __shfl_xor(q, 16); q += __shfl_xor(q, 32); rr[ai][m] = __builtin_amdgcn_rsqf(q * (1.0f / D) + EPS); }
        asm volatile("" ::: "memory");
#pragma unroll
        for (int ai = 0; ai < 2; ++ai)
#pragma unroll
            for (int m = 0; m < 4; ++m) {
                const int row = u.r0 + ai * HALF + wr * 64 + m * 16 + fr;
                const float r = rr[ai][m];
                bf16* rowp = O + (size_t)row * GF + col0; f32x2 s1 = (f32x2){0.f, 0.f}, s2 = (f32x2){0.f, 0.f};
#pragma unroll
                for (int bj = 0; bj < 2; ++bj) {
                    const f32x4 v0 = acc[ai][bj][m][0] * r + bv[bj][0], v1 = acc[ai][bj][m][1] * r + bv[bj][1];
                    const f32x2 a = gelu_tanh2((f32x2){v0[0], v0[1]}), b = gelu_tanh2((f32x2){v0[2], v0[3]}), c = gelu_tanh2((f32x2){v1[0], v1[1]}), d = gelu_tanh2((f32x2){v1[2], v1[3]});
                    if (isv) { s1 += (a + b) + (c + d); s2 += (a * a + b * b) + (c * c + d * d); }
                    v4u w; w.x = cvt_pk_bf16(a.x, a.y); w.y = cvt_pk_bf16(b.x, b.y); w.z = cvt_pk_bf16(c.x, c.y); w.w = cvt_pk_bf16(d.x, d.y);
                    *(v4u*)(rowp + bj * HALF) = w; }
                if (isv) { float t1 = s1.x + s1.y, t2 = s2.x + s2.y; t1 += __shfl_xor(t1, 16); t1 += __shfl_xor(t1, 32); t2 += __shfl_xor(t2, 16); t2 += __shfl_xor(t2, 32);
                    if (fq == 0) *(f32x2*)(vstat + ((size_t)row * 48 + (u.pn - 12) * 4 + wc) * 2) = (f32x2){t1, t2}; }
            }
    }
};

struct EpiRes {
    static constexpr bool PERM = false;
    const float* base; float* out; const float* bias; bf16* xb; float* ssout;
    __device__ __forceinline__ void operator()(AccT acc, const Unit& u, int wr, int wc, int fr, int fq) const {
        const int col0 = u.pn * BM + wc * 32 + 4 * fq;
        f32x4 bv[2][2];
#pragma unroll
        for (int bj = 0; bj < 2; ++bj)
#pragma unroll
            for (int n = 0; n < 2; ++n) bv[bj][n] = bias ? *(const f32x4*)(bias + col0 + bj * HALF + n * 16) : (f32x4){0.f, 0.f, 0.f, 0.f};
#pragma unroll
        for (int ai = 0; ai < 2; ++ai) {
            f32x4 xv[4][2][2];
#pragma unroll
            for (int m = 0; m < 4; ++m) { const size_t off = (size_t)(u.r0 + ai * HALF + wr * 64 + m * 16 + fr) * D + col0;
#pragma unroll
                for (int bj = 0; bj < 2; ++bj)
#pragma unroll
                    for (int n = 0; n < 2; ++n) xv[m][bj][n] = *(const f32x4*)(base + off + bj * HALF + n * 16); }
            asm volatile("" ::: "memory");
#pragma unroll
            for (int m = 0; m < 4; ++m) {
                const int row = u.r0 + ai * HALF + wr * 64 + m * 16 + fr; const size_t off = (size_t)row * D + col0; float s2 = 0.f;
#pragma unroll
                for (int bj = 0; bj < 2; ++bj)
#pragma unroll
                    for (int n = 0; n < 2; ++n) {
                        const f32x4 v = xv[m][bj][n] + acc[ai][bj][m][n] + bv[bj][n];
                        *(f32x4*)(out + off + bj * HALF + n * 16) = v;
                        s2 += (v[0] * v[0] + v[1] * v[1]) + (v[2] * v[2] + v[3] * v[3]);
                        if (xb) { v2u w; w.x = cvt_pk_bf16(v[0], v[1]); w.y = cvt_pk_bf16(v[2], v[3]); *(v2u*)(xb + off + bj * HALF + n * 16) = w; } }
                if (ssout) { s2 += __shfl_xor(s2, 16); s2 += __shfl_xor(s2, 32); if (fq == 0) ssout[(size_t)row * 16 + u.pn * 4 + wc] = s2; }
            }
            asm volatile("" ::: "memory");
        }
    }
};

template <bool MOE> struct EpiHid {
    static constexpr bool PERM = true;
    bf16* O; int ldh; const float* ss; const float* r4; const int* toklist;
    __device__ __forceinline__ void operator()(AccT acc, const Unit& u, int wr, int wc, int fr, int fq) const {
        const int col0 = u.pn * HALF + wc * 32 + 8 * fq;
        float rr[2][4];
        if (MOE) {
            int tk[2][4];
#pragma unroll
            for (int ai = 0; ai < 2; ++ai)
#pragma unroll
                for (int m = 0; m < 4; ++m) { const int tr = ai * HALF + wr * 64 + m * 16 + fr; tk[ai][m] = toklist[u.e * M + (tr < u.cnt ? u.pm * BM + tr : 0)]; }
#pragma unroll
            for (int ai = 0; ai < 2; ++ai)
#pragma unroll
                for (int m = 0; m < 4; ++m) rr[ai][m] = r4[tk[ai][m]];
        } else {
            f32x4 sv[2][4];
#pragma unroll
            for (int ai = 0; ai < 2; ++ai)
#pragma unroll
                for (int m = 0; m < 4; ++m) sv[ai][m] = *(const f32x4*)(ss + (size_t)(u.r0 + ai * HALF + wr * 64 + m * 16 + fr) * 16 + 4 * fq);
#pragma unroll
            for (int ai = 0; ai < 2; ++ai)
#pragma unroll
                for (int m = 0; m < 4; ++m) { float q = (sv[ai][m].x + sv[ai][m].y) + (sv[ai][m].z + sv[ai][m].w); q += __shfl_xor(q, 16); q += __shfl_xor(q, 32); rr[ai][m] = __builtin_amdgcn_rsqf(q * (1.0f / D) + EPS); }
        }
        asm volatile("" ::: "memory");
#pragma unroll
        for (int ai = 0; ai < 2; ++ai)
#pragma unroll
            for (int m = 0; m < 4; ++m) {
                const int tr = ai * HALF + wr * 64 + m * 16 + fr; const int row = u.r0 + tr; const float r = rr[ai][m]; const bool valid = MOE ? (tr < u.cnt) : true;
                const float rn = -LOG2E * r, r2 = r * r;
                const f32x4 ga = acc[ai][0][m][0], gb = acc[ai][0][m][1], ua = acc[ai][1][m][0], ub = acc[ai][1][m][1];
                const f32x2 o0 = ((f32x2){ga[0], ga[1]} * (f32x2){ua[0], ua[1]}) * r2 * sigm2((f32x2){ga[0], ga[1]} * rn), o1 = ((f32x2){ga[2], ga[3]} * (f32x2){ua[2], ua[3]}) * r2 * sigm2((f32x2){ga[2], ga[3]} * rn);
                const f32x2 o2 = ((f32x2){gb[0], gb[1]} * (f32x2){ub[0], ub[1]}) * r2 * sigm2((f32x2){gb[0], gb[1]} * rn), o3 = ((f32x2){gb[2], gb[3]} * (f32x2){ub[2], ub[3]}) * r2 * sigm2((f32x2){gb[2], gb[3]} * rn);
                v4u w; w.x = cvt_pk_bf16(o0.x, o0.y); w.y = cvt_pk_bf16(o1.x, o1.y); w.z = cvt_pk_bf16(o2.x, o2.y); w.w = cvt_pk_bf16(o3.x, o3.y);
                if (valid) *(v4u*)(O + (size_t)row * ldh + col0) = w;
            }
    }
};

struct EpiNull {
    static constexpr bool PERM = true;
    __device__ __forceinline__ void operator()(AccT acc, const Unit& u, int wr, int wc, int fr, int fq) const {
#pragma unroll
        for (int ai = 0; ai < 2; ++ai)
#pragma unroll
            for (int bj = 0; bj < 2; ++bj)
#pragma unroll
                for (int m = 0; m < 4; ++m)
#pragma unroll
                    for (int n = 0; n < 2; ++n) asm volatile("" :: "v"(acc[ai][bj][m][n]));
    }
};

template <bool MOE> struct EpiBf {
    static constexpr bool PERM = true;
    bf16* O; int ldc; const float* slotw;
    __device__ __forceinline__ void operator()(AccT acc, const Unit& u, int wr, int wc, int fr, int fq) const {
        const int col0 = u.pn * BM + wc * 32 + 8 * fq;
        float scv[2][4];
#pragma unroll
        for (int ai = 0; ai < 2; ++ai)
#pragma unroll
            for (int m = 0; m < 4; ++m) { const int tr = ai * HALF + wr * 64 + m * 16 + fr; scv[ai][m] = MOE ? slotw[u.e * M + (tr < u.cnt ? u.pm * BM + tr : 0)] : 1.f; }
        asm volatile("" ::: "memory");
#pragma unroll
        for (int ai = 0; ai < 2; ++ai)
#pragma unroll
            for (int m = 0; m < 4; ++m) {
                const int tr = ai * HALF + wr * 64 + m * 16 + fr; const int row = u.r0 + tr; const float sc = scv[ai][m]; const bool valid = MOE ? (tr < u.cnt) : true;
                bf16* rowp = O + (size_t)row * ldc + col0;
#pragma unroll
                for (int bj = 0; bj < 2; ++bj) { const f32x4 v0 = acc[ai][bj][m][0] * sc, v1 = acc[ai][bj][m][1] * sc;
                    v4u w; w.x = cvt_pk_bf16(v0[0], v0[1]); w.y = cvt_pk_bf16(v0[2], v0[3]); w.z = cvt_pk_bf16(v1[0], v1[1]); w.w = cvt_pk_bf16(v1[2], v1[3]);
                    if (valid) *(v4u*)(rowp + bj * HALF) = w; }
            }
    }
};

struct EpiPle {
    static constexpr bool PERM = false;
    float* x; const bf16* proj; const float* ss; bf16* xb; float* ssout;
    __device__ __forceinline__ void operator()(AccT acc, const Unit& u, int wr, int wc, int fr, int fq) const {
        const int col0 = u.pn * BM + wc * 32 + 4 * fq;
#pragma unroll
        for (int ai = 0; ai < 2; ++ai)
#pragma unroll
        for (int mh = 0; mh < 2; ++mh) {
            f32x4 xv[2][2][2]; v2u pv[2][2][2]; f32x4 sv[2];
#pragma unroll
            for (int mm = 0; mm < 2; ++mm) { const int row = u.r0 + ai * HALF + wr * 64 + (2 * mh + mm) * 16 + fr; const size_t off = (size_t)row * D + col0;
                sv[mm] = *(const f32x4*)(ss + (size_t)row * 16 + 4 * fq);
#pragma unroll
                for (int bj = 0; bj < 2; ++bj)
#pragma unroll
                    for (int n = 0; n < 2; ++n) { xv[mm][bj][n] = *(const f32x4*)(x + off + bj * HALF + n * 16); pv[mm][bj][n] = *(const v2u*)(proj + off + bj * HALF + n * 16); } }
            asm volatile("" ::: "memory");
#pragma unroll
            for (int mm = 0; mm < 2; ++mm) {
                const int m = 2 * mh + mm;
                const int row = u.r0 + ai * HALF + wr * 64 + m * 16 + fr; const size_t off = (size_t)row * D + col0; float s2 = 0.f;
                float sq = (sv[mm].x + sv[mm].y) + (sv[mm].z + sv[mm].w); sq += __shfl_xor(sq, 16); sq += __shfl_xor(sq, 32);
                const float r = __builtin_amdgcn_rsqf(sq * (1.0f / D) + EPS);
#pragma unroll
                for (int bj = 0; bj < 2; ++bj)
#pragma unroll
                    for (int n = 0; n < 2; ++n) {
                        const size_t o = off + bj * HALF + n * 16;
                        const v2u pw = pv[mm][bj][n]; const f32x4 a = acc[ai][bj][m][n] * (-LOG2E * r); f32x4 v = xv[mm][bj][n];
                        const f32x2 g01 = sigm2((f32x2){a[0], a[1]}), g23 = sigm2((f32x2){a[2], a[3]});
                        v[0] += bf_lo(pw.x) * g01.x; v[1] += bf_hi(pw.x) * g01.y; v[2] += bf_lo(pw.y) * g23.x; v[3] += bf_hi(pw.y) * g23.y;
                        *(f32x4*)(x + o) = v;
                        s2 += (v[0] * v[0] + v[1] * v[1]) + (v[2] * v[2] + v[3] * v[3]);
                        if (xb) { v2u w; w.x = cvt_pk_bf16(v[0], v[1]); w.y = cvt_pk_bf16(v[2], v[3]); *(v2u*)(xb + o) = w; } }
                if (ssout) { s2 += __shfl_xor(s2, 16); s2 += __shfl_xor(s2, 32); if (fq == 0) ssout[(size_t)row * 16 + u.pn * 4 + wc] = s2; }
            }
            asm volatile("" ::: "memory");
        }
    }
};

struct EpiQKV {
    static constexpr bool PERM = false;
    bf16* Q; bf16* Kb; bf16* Vb; const float* bq; const float* bkv; const float* ss; const f32x2* rope;
    __device__ __forceinline__ void operator()(AccT acc, const Unit& u, int wr, int wc, int fr, int fq) const {
        const int dlo = 16 * (wc & 1) + 4 * fq;
        const int kind = u.pn < 4 ? 0 : (u.pn == 4 ? 1 : 2);
        f32x4 bv[2][2];
#pragma unroll
        for (int bj = 0; bj < 2; ++bj) {
            const int hcol = 64 * (2 * bj + (wc >> 1)) + dlo;
            const float* bp = kind == 0 ? bq + u.pn * BM + hcol : bkv + (kind - 1) * BM + hcol;
            bv[bj][0] = *(const f32x4*)bp; bv[bj][1] = *(const f32x4*)(bp + 32); }
#pragma unroll
        for (int ai = 0; ai < 2; ++ai) {
            f32x4 sv[4], c01[4], c23[4];
#pragma unroll
            for (int m = 0; m < 4; ++m) { const int row = u.r0 + ai * HALF + wr * 64 + m * 16 + fr; sv[m] = *(const f32x4*)(ss + (size_t)row * 16 + 4 * fq);
                const f32x2* rp = rope + (size_t)(row & (SEQ - 1)) * 32 + dlo; c01[m] = *(const f32x4*)rp; c23[m] = *(const f32x4*)(rp + 2); }
            asm volatile("" ::: "memory");
#pragma unroll
            for (int m = 0; m < 4; ++m) {
                const int row = u.r0 + ai * HALF + wr * 64 + m * 16 + fr;
                float q = (sv[m].x + sv[m].y) + (sv[m].z + sv[m].w); q += __shfl_xor(q, 16); q += __shfl_xor(q, 32); const float r = __builtin_amdgcn_rsqf(q * (1.0f / D) + EPS);
                const f32x4 cs01 = c01[m], cs23 = c23[m];
                const float cc[4] = {cs01[0], cs01[2], cs23[0], cs23[2]}, sn[4] = {cs01[1], cs01[3], cs23[1], cs23[3]};
#pragma unroll
                for (int bj = 0; bj < 2; ++bj) {
                    const int hcol = 64 * (2 * bj + (wc >> 1)) + dlo;
                    f32x4 lo = acc[ai][bj][m][0] * r + bv[bj][0], hi = acc[ai][bj][m][1] * r + bv[bj][1];
                    if (kind < 2) {
#pragma unroll
                        for (int j = 0; j < 4; ++j) { const float a = lo[j], b = hi[j]; lo[j] = a * cc[j] - b * sn[j]; hi[j] = b * cc[j] + a * sn[j]; }
                    }
                    if (kind == 0) { lo = lo * QSCALE; hi = hi * QSCALE; }
                    v2u wl, wh; wl.x = cvt_pk_bf16(lo[0], lo[1]); wl.y = cvt_pk_bf16(lo[2], lo[3]); wh.x = cvt_pk_bf16(hi[0], hi[1]); wh.y = cvt_pk_bf16(hi[2], hi[3]);
                    bf16* dst = kind == 0 ? Q + (size_t)row * D + u.pn * BM + hcol : (kind == 1 ? Kb : Vb) + (size_t)row * 256 + hcol;
                    *(v2u*)dst = wl; *(v2u*)(dst + 32) = wh; }
            }
            asm volatile("" ::: "memory");
        }
    }
};
}

struct Args { const float* in[31]; float* out; unsigned char* ws; int ph_lo, ph_hi, li, pad; };

struct Frame {
    LAS unsigned char* lds; volatile LAS unsigned* MISC; unsigned* ctl; unsigned char* ws;
    int tid, lane, wave, G, bid;
};

__device__ __forceinline__ int dest_row(int mode, int off, int n) {
    if (mode == 1) return ((n >> 7) << 8) + (n & 127) + off;
    if (mode == 2) return ((n & ~48) | ((n & 16) << 1) | ((n & 32) >> 1)) + off;
    return n + off;
}
__device__ __forceinline__ void p0_transpose_item(const float* W, int K, int N, const float* gain, bf16* WT, int mode, int off, int item, int lane) {
    const int nblk = N / 64, kb = item / nblk, nb = item % nblk, k0 = 128 * kb, n0 = 64 * nb;
    const float* src = W + (size_t)k0 * N + n0 + lane;
    float v[128];
#pragma unroll
    for (int i = 0; i < 128; ++i) v[i] = src[(size_t)i * N];
    if (gain) {
        const int g0 = __float_as_int(gain[k0 + lane]), g1 = __float_as_int(gain[k0 + 64 + lane]);
#pragma unroll
        for (int i = 0; i < 64; ++i) { v[i] *= __int_as_float(__builtin_amdgcn_readlane(g0, i)); v[64 + i] *= __int_as_float(__builtin_amdgcn_readlane(g1, i)); }
    }
    bf16* dst = WT + (size_t)dest_row(mode, off, n0 + lane) * K + k0;
#pragma unroll
    for (int c = 0; c < 16; ++c) { v4u o; o.x = cvt_pk_bf16(v[8 * c], v[8 * c + 1]); o.y = cvt_pk_bf16(v[8 * c + 2], v[8 * c + 3]); o.z = cvt_pk_bf16(v[8 * c + 4], v[8 * c + 5]); o.w = cvt_pk_bf16(v[8 * c + 6], v[8 * c + 7]);
        *(v4u*)(dst + 8 * c) = o; }
}

#define IN_(k) ((const float*)args.in[k])

__global__ void __launch_bounds__(NWAVES * 64, 2) fwd_kernel(Args args) {
    extern __shared__ __attribute__((aligned(16))) unsigned char lds_raw[];
    Frame F;
    F.lds = (LAS unsigned char*)lds_raw;
    F.MISC = (volatile LAS unsigned*)(F.lds + MISC_OFF);
    F.tid = threadIdx.x; F.lane = F.tid & 63; F.wave = __builtin_amdgcn_readfirstlane(F.tid >> 6);
    F.G = gridDim.x; F.bid = blockIdx.x;
    F.ws = args.ws; F.ctl = (unsigned*)(args.ws + WS_CTL);
    unsigned char* ws = args.ws;
    const int tid = F.tid, lane = F.lane, wave = F.wave, G = F.G, bid = F.bid;
    const int gw = bid * NWAVES + wave, NGW = G * NWAVES;

    for (int u = tid; u < 128; u += NWAVES * 64) ((LAS unsigned*)(F.lds + MISC_OFF))[u] = 0u;
    __syncthreads();
    constexpr bool ONE = (MK_N_LAUNCHES == 1);
    XcdBarrier bar; bar.bar = F.ctl + CW_BAR; bar.x = 0; bar.st = nullptr;
    if (ONE) bar = xcd_barrier_post(F.ctl + CW_BAR, F.MISC + 8);
#define GRID_BAR() do { if (ONE) xcd_barrier(bar); } while (0)
    const int lo = args.ph_lo, hi = args.ph_hi;
#define IN(k) (lo <= (k) && (k) < hi)
#if defined(PROBE_LO)
    unsigned long long probe_t0 = 0ull, probe_dt = 0ull;
#define PROBE_START(k) do { if ((k) == PROBE_LO) probe_t0 = __builtin_amdgcn_s_memrealtime(); } while (0)
#define PROBE_END(k) do { if ((k) == PROBE_HI) probe_dt = __builtin_amdgcn_s_memrealtime() - probe_t0; } while (0)
#else
#define PROBE_START(k) do {} while (0)
#define PROBE_END(k) do {} while (0)
#endif

    bf16* const Win_t = (bf16*)(ws + WS_WIN); bf16* const Wout_t = (bf16*)(ws + WS_WOUT); bf16* const Wgu_t = (bf16*)(ws + WS_WGU); bf16* const Wd_t = (bf16*)(ws + WS_WD);
    bf16* const Wpg0_t = (bf16*)(ws + WS_WPG0); bf16* const Wpp0_t = (bf16*)(ws + WS_WPP0); bf16* const Wpg1_t = (bf16*)(ws + WS_WPG1); bf16* const Wpp1_t = (bf16*)(ws + WS_WPP1);
    bf16* const Wqkv_t = (bf16*)(ws + WS_WQKV); bf16* const Wo_t = (bf16*)(ws + WS_WO); bf16* const MWgu_t = (bf16*)(ws + WS_MWGU); bf16* const MWd_t = (bf16*)(ws + WS_MWD);
    bf16* const XB0 = (bf16*)(ws + WS_XB0); bf16* const XB1 = (bf16*)(ws + WS_XB1); bf16* const PB = (bf16*)(ws + WS_PB);
    bf16* const UV = (bf16*)(ws + WS_UV); bf16* const HID = (bf16*)(ws + WS_HID); bf16* const PROJ = (bf16*)(ws + WS_PROJ);
    bf16* const Qb = (bf16*)(ws + WS_Q); bf16* const Kb = (bf16*)(ws + WS_K); bf16* const Vb = (bf16*)(ws + WS_V);
    bf16* const HIDM = (bf16*)(ws + WS_HIDM); bf16* const YS = (bf16*)(ws + WS_YS);
    float* const SS0 = (float*)(ws + WS_SS); float* const SS1 = SS0 + M * 16; float* const SS2 = SS1 + M * 16; float* const SS3 = SS2 + M * 16; float* const SS5 = SS3 + M * 16;
    float* const R4 = (float*)(ws + WS_R4); unsigned* const TOKSLOT = (unsigned*)(ws + WS_TOKSLOT); int* const TOKLIST = (int*)(ws + WS_TOKLIST); float* const SLOTW = (float*)(ws + WS_SLOTW);
    float* const WR = (float*)(ws + WS_WR); float* const VSTAT = (float*)(ws + WS_VSTAT); f32x2* const ROPE = (f32x2*)(ws + WS_ROPE);
    float* const X = args.out;
    unsigned* const GCNT = F.ctl + CW_CNT;

    if (IN(0)) {
        PROBE_START(0);
        constexpr int I_WIN = (D / 128) * (GF / 64), I_WOUT = (GH / 128) * (D / 64), I_FG = (D / 128) * (FFD / 64), I_FD = (FFD / 128) * (D / 64), I_PG = (D / 128) * (D / 64), I_PP = (PLE / 128) * (D / 64),
                      I_WQ = (D / 128) * (D / 64), I_WKV = (D / 128) * (512 / 64), I_WO = I_WQ, I_MG = (D / 128) * (FFE / 64), I_MD = (FFE / 128) * (D / 64);
        constexpr int NITEMS = I_WIN + I_WOUT + 2 * I_FG + I_FD + 2 * I_PG + 2 * I_PP + I_WQ + I_WKV + I_WO + NE * (2 * I_MG + I_MD);
        for (int it = gw; it < NITEMS; it += NGW) {
            int r = it;
            if (r < I_WIN) { p0_transpose_item(IN_(4), D, GF, IN_(2), Win_t, 0, 0, r, lane); continue; } r -= I_WIN;
            if (r < I_WOUT) { p0_transpose_item(IN_(10), GH, D, nullptr, Wout_t, 0, 0, r, lane); continue; } r -= I_WOUT;
            if (r < I_FG) { p0_transpose_item(IN_(20), D, FFD, IN_(3), Wgu_t, 1, 0, r, lane); continue; } r -= I_FG;
            if (r < I_FG) { p0_transpose_item(IN_(21), D, FFD, IN_(3), Wgu_t, 1, 128, r, lane); continue; } r -= I_FG;
            if (r < I_FD) { p0_transpose_item(IN_(22), FFD, D, nullptr, Wd_t, 0, 0, r, lane); continue; } r -= I_FD;
            if (r < I_PG) { p0_transpose_item(IN_(29), D, D, IN_(28), Wpg0_t, 0, 0, r, lane); continue; } r -= I_PG;
            if (r < I_PG) { p0_transpose_item(IN_(29) + D * D, D, D, IN_(28) + D, Wpg1_t, 0, 0, r, lane); continue; } r -= I_PG;
            if (r < I_PP) { p0_transpose_item(IN_(27), PLE, D, nullptr, Wpp0_t, 0, 0, r, lane); continue; } r -= I_PP;
            if (r < I_PP) { p0_transpose_item(IN_(27) + PLE * D, PLE, D, nullptr, Wpp1_t, 0, 0, r, lane); continue; } r -= I_PP;
            if (r < I_WQ) { p0_transpose_item(IN_(15), D, D, IN_(2) + D, Wqkv_t, 2, 0, r, lane); continue; } r -= I_WQ;
            if (r < I_WKV) { p0_transpose_item(IN_(13), D, 512, IN_(12), Wqkv_t, 2, 1024, r, lane); continue; } r -= I_WKV;
            if (r < I_WO) { p0_transpose_item(IN_(18), D, D, nullptr, Wo_t, 0, 0, r, lane); continue; } r -= I_WO;
            { constexpr int PER_E = 2 * I_MG + I_MD; const int e = r / PER_E; int q = r % PER_E;
              if (q < I_MG) { p0_transpose_item(IN_(24) + (size_t)e * D * FFE, D, FFE, IN_(3) + D, MWgu_t + (size_t)e * 7168 * D, 1, 0, q, lane); continue; } q -= I_MG;
              if (q < I_MG) { p0_transpose_item(IN_(25) + (size_t)e * D * FFE, D, FFE, IN_(3) + D, MWgu_t + (size_t)e * 7168 * D, 1, 128, q, lane); continue; } q -= I_MG;
              p0_transpose_item(IN_(26) + (size_t)e * FFE * D, FFE, D, nullptr, MWd_t + (size_t)e * D * FFE, 0, 0, q, lane); }
        }
        for (int m = 2 * gw; m < M; m += 2 * NGW) {
            const f32x4* xr = (const f32x4*)(IN_(0) + (size_t)m * D) + lane; f32x4 v[8]; float s0 = 0.f, s1 = 0.f;
#pragma unroll
            for (int j = 0; j < 8; ++j) v[j] = xr[64 * j];
#pragma unroll
            for (int j = 0; j < 4; ++j) { s0 += (v[j].x * v[j].x + v[j].y * v[j].y) + (v[j].z * v[j].z + v[j].w * v[j].w); s1 += (v[4 + j].x * v[4 + j].x + v[4 + j].y * v[4 + j].y) + (v[4 + j].z * v[4 + j].z + v[4 + j].w * v[4 + j].w); }
            s0 = wave_sum(s0); s1 = wave_sum(s1);
            v2u* o8 = (v2u*)(XB0 + (size_t)m * D) + lane;
#pragma unroll
            for (int j = 0; j < 8; ++j) { v2u w; w.x = cvt_pk_bf16(v[j].x, v[j].y); w.y = cvt_pk_bf16(v[j].z, v[j].w); o8[64 * j] = w; }
            if (lane < 32) SS0[(size_t)m * 16 + lane] = lane == 0 ? s0 : (lane == 16 ? s1 : 0.f);
        }
        for (int i = bid * (NWAVES * 64) + tid; i < 2 * M * PLE / 8; i += G * NWAVES * 64) {
            const f32x4 a = ((const f32x4*)IN_(1))[2 * i], b = ((const f32x4*)IN_(1))[2 * i + 1];
            v4u w; w.x = cvt_pk_bf16(a.x, a.y); w.y = cvt_pk_bf16(a.z, a.w); w.z = cvt_pk_bf16(b.x, b.y); w.w = cvt_pk_bf16(b.z, b.w);
            ((v4u*)PB)[i] = w;
        }
        for (int i = bid * (NWAVES * 64) + tid; i < SEQ * 32; i += G * NWAVES * 64) {
            const int pos = i >> 5, fi = i & 31;
            const float freq = exp2f(-(float)fi * (13.287712379549449f / 32.0f));
            const float ang = (float)pos * freq;
            const double rev = (double)ang * 0.15915494309189535; const double fr_ = rev - __builtin_rint(rev);
            const float xr = (float)fr_;
            ROPE[i] = (f32x2){__builtin_amdgcn_cosf(xr), __builtin_amdgcn_sinf(xr)};
        }
        for (int i = bid * (NWAVES * 64) + tid; i < NE * D; i += G * NWAVES * 64) { const int e = i >> 10, k = i & 1023; WR[i] = IN_(3)[D + k] * IN_(23)[k * NE + e]; }
        GRID_BAR();
        PROBE_END(0);
    }

    if (IN(1)) {
        PROBE_START(1);
        pg8::StaticOrder S; S.init(M, GF, D, D, G, bid, XB0, Win_t);
        pg8::EpiUV E{UV, IN_(5), SS0, VSTAT};
        pg8::gemm_phase<pg8::EpiUV, pg8::StaticOrder, true, false>(F.lds, D, S, E);
        GRID_BAR();
        PROBE_END(1);
    }

    if (IN(2)) {
        PROBE_START(2);
        constexpr int WSTR = 136;
        LAS bf16* WSL = (LAS bf16*)(F.lds);
        LAS bf16* VT = (LAS bf16*)(F.lds + 128 * WSTR * 2);
        LAS f32x2* STAT = (LAS f32x2*)(F.lds + 128 * WSTR * 2 + 192 * WSTR * 2);
        const float* lng = IN_(6); const float* lnb = IN_(7); const float* wsrc = IN_(8); const float* bsrc = IN_(9);
        for (int id = bid; id < 2048; id += G) {
            const int hf = id & 1, g = (id >> 1) & 7, c = id >> 4; const int row0 = 128 * c, ch0 = GD * g + 192 * hf;
            if (tid < 128) {
                const f32x4* vp = (const f32x4*)(VSTAT + (size_t)(row0 + tid) * 96); float s1 = 0.f, s2 = 0.f;
#pragma unroll 4
                for (int j = 0; j < 24; ++j) { const f32x4 q = vp[j]; s1 += q.x + q.z; s2 += q.y + q.w; }
                const float mean = s1 * (1.0f / GH); float var = s2 * (1.0f / GH) - mean * mean; var = var < 0.f ? 0.f : var;
                STAT[tid] = (f32x2){mean, __builtin_amdgcn_rsqf(var + EPS)};
            }
            for (int idx = tid; idx < 2048; idx += NWAVES * 64) {
                const int t = idx >> 4, s0 = (idx & 15) * 8; const f32x4* wp = (const f32x4*)(wsrc + ((size_t)g * 128 + t) * 128 + s0);
                const f32x4 a = wp[0], b = wp[1]; float w8[8] = {a.x, a.y, a.z, a.w, b.x, b.y, b.z, b.w};
#pragma unroll
                for (int j = 0; j < 8; ++j) w8[j] = (s0 + j <= t) ? w8[j] : 0.f;
                v4u o; o.x = cvt_pk_bf16(w8[0], w8[1]); o.y = cvt_pk_bf16(w8[2], w8[3]); o.z = cvt_pk_bf16(w8[4], w8[5]); o.w = cvt_pk_bf16(w8[6], w8[7]);
                *(LAS v4u*)(WSL + t * WSTR + s0) = o;
            }
            __syncthreads();
            for (int idx = tid; idx < 128 * 24; idx += NWAVES * 64) {
                const int s = idx & 127, cg = idx >> 7; const int ch = ch0 + 8 * cg;
                const v4u raw = *(const v4u*)(UV + (size_t)(row0 + s) * GF + GH + ch);
                const f32x2 st = STAT[s];
                const f32x4 g0 = *(const f32x4*)(lng + ch), g1 = *(const f32x4*)(lng + ch + 4), b0 = *(const f32x4*)(lnb + ch), b1 = *(const f32x4*)(lnb + ch + 4);
                float v8[8] = {bf_lo(raw.x), bf_hi(raw.x), bf_lo(raw.y), bf_hi(raw.y), bf_lo(raw.z), bf_hi(raw.z), bf_lo(raw.w), bf_hi(raw.w)};
                const float gg[8] = {g0.x, g0.y, g0.z, g0.w, g1.x, g1.y, g1.z, g1.w}, bb[8] = {b0.x, b0.y, b0.z, b0.w, b1.x, b1.y, b1.z, b1.w};
#pragma unroll
                for (int j = 0; j < 8; j += 2) {
                    const float y0 = (v8[j] - st.x) * st.y * gg[j] + bb[j], y1 = (v8[j + 1] - st.x) * st.y * gg[j + 1] + bb[j + 1];
                    const unsigned w = cvt_pk_bf16(y0, y1);
                    VT[(8 * cg + j) * WSTR + s] = (bf16)(w & 0xffffu); VT[(8 * cg + j + 1) * WSTR + s] = (bf16)(w >> 16); }
            }
            __syncthreads();
            {
                const int tl = lane & 15, kg = lane >> 4; const int t = 16 * wave + tl; const int nks = (wave + 2) >> 1;
                f32x4 acc[12];
#pragma unroll
                for (int cb = 0; cb < 12; ++cb) acc[cb] = (f32x4){0.f, 0.f, 0.f, 0.f};
                for (int ks = 0; ks < nks; ++ks) {
                    const bf16x8 wf = *(const LAS bf16x8*)(WSL + t * WSTR + 32 * ks + 8 * kg);
#pragma unroll
                    for (int cb = 0; cb < 12; ++cb) { const bf16x8 vf = *(const LAS bf16x8*)(VT + (16 * cb + tl) * WSTR + 32 * ks + 8 * kg);
                        acc[cb] = __builtin_amdgcn_mfma_f32_16x16x32_bf16(vf, wf, acc[cb], 0, 0, 0); }
                }
                const float bsv = bsrc[g * 128 + t];
                bf16* up = UV + (size_t)(row0 + t) * GF + ch0 + 4 * kg;
#pragma unroll
                for (int cb = 0; cb < 12; ++cb) { const v2u uw = *(const v2u*)(up + 16 * cb);
                    const float o0 = bf_lo(uw.x) * (acc[cb][0] + bsv), o1 = bf_hi(uw.x) * (acc[cb][1] + bsv), o2 = bf_lo(uw.y) * (acc[cb][2] + bsv), o3 = bf_hi(uw.y) * (acc[cb][3] + bsv);
                    v2u w; w.x = cvt_pk_bf16(o0, o1); w.y = cvt_pk_bf16(o2, o3); *(v2u*)(up + 16 * cb) = w; }
            }
            __syncthreads();
        }
        GRID_BAR();
        PROBE_END(2);
    }

    if (IN(3)) {
        PROBE_START(3);
        pg8::StaticOrder S; S.init(M, D, GH, GF, G, bid, UV, Wout_t);
        pg8::EpiRes E{IN_(0), X, IN_(11), XB0, SS1};
        pg8::gemm_phase<pg8::EpiRes, pg8::StaticOrder, false, false>(F.lds, GH, S, E);
        GRID_BAR();
        PROBE_END(3);
    }

    if (IN(4)) {
        PROBE_START(4);
        pg8::StaticOrder S; S.init(M, 2 * FFD, D, D, G, bid, XB0, Wgu_t);
        pg8::EpiHid<false> E{HID, FFD, SS1, nullptr, nullptr};
#if defined(PROBE_DUMMY4)
        { pg8::EpiNull EN; pg8::gemm_phase<pg8::EpiNull, pg8::StaticOrder, true, false>(F.lds, D, S, EN); }
#else
        pg8::gemm_phase<pg8::EpiHid<false>, pg8::StaticOrder, true, false>(F.lds, D, S, E);
#endif
        GRID_BAR();
        PROBE_END(4);
#if defined(PROBE_DUMMY4)
        pg8::gemm_phase<pg8::EpiHid<false>, pg8::StaticOrder, true, false>(F.lds, D, S, E);
        GRID_BAR();
#endif
    }

    if (IN(5)) {
        PROBE_START(5);
        { pg8::StaticOrder S; S.init(M, D, FFD, FFD, G, bid, HID, Wd_t);
          pg8::EpiRes E{X, X, nullptr, XB0, SS2};
          pg8::gemm_phase<pg8::EpiRes, pg8::StaticOrder, false, false>(F.lds, FFD, S, E); }
        { pg8::StaticOrder S; S.init(M, D, PLE, PLE, G, bid, PB, Wpp0_t);
          pg8::EpiBf<false> E{PROJ, D, nullptr};
          pg8::gemm_phase<pg8::EpiBf<false>, pg8::StaticOrder, false, false>(F.lds, PLE, S, E); }
        GRID_BAR();
        PROBE_END(5);
    }

    if (IN(6)) {
        PROBE_START(6);
        pg8::StaticOrder S; S.init(M, D, D, D, G, bid, XB0, Wpg0_t);
        pg8::EpiPle E{X, PROJ, SS2, XB1, SS3};
        pg8::gemm_phase<pg8::EpiPle, pg8::StaticOrder, false, false>(F.lds, D, S, E);
        GRID_BAR();
        PROBE_END(6);
    }

    if (IN(7)) {
        PROBE_START(7);
        pg8::StaticOrder S; S.init(M, NQKV, D, D, G, bid, XB1, Wqkv_t);
        pg8::EpiQKV E{Qb, Kb, Vb, IN_(16), IN_(14), SS3, ROPE};
        pg8::gemm_phase<pg8::EpiQKV, pg8::StaticOrder, true, false>(F.lds, D, S, E);
        GRID_BAR();
        PROBE_END(7);
    }

    if (IN(8)) {
        PROBE_START(8);
        constexpr int KSTR = 72, VSTR = 264;
        LAS bf16* KL = (LAS bf16*)(F.lds);
        LAS bf16* VT = (LAS bf16*)(F.lds + 256 * KSTR * 2);
        const float* sinks = IN_(17);
        for (int id = bid; id < 512; id += G) {
            const int qb = id & 31, g = (id >> 5) & 3, b = id >> 7;
            const long tok0 = (long)b * SEQ + 128 * qb - 128;
            for (int idx = tid; idx < 2048; idx += NWAVES * 64) {
                const int kj = idx >> 3, c = idx & 7; const bool valid = (qb > 0) || (kj >= 128);
                v4u val = (v4u){0u, 0u, 0u, 0u};
                if (valid) val = *(const v4u*)(Kb + (size_t)(tok0 + kj) * 256 + 64 * g + 8 * c);
                *(LAS v4u*)(KL + kj * KSTR + 8 * c) = val;
            }
            for (int idx = tid; idx < 2048; idx += NWAVES * 64) {
                const int kj = idx & 255, c = idx >> 8; const bool valid = (qb > 0) || (kj >= 128);
                v4u raw = (v4u){0u, 0u, 0u, 0u};
                if (valid) raw = *(const v4u*)(Vb + (size_t)(tok0 + kj) * 256 + 64 * g + 8 * c);
                LAS bf16* vp = VT + (8 * c) * VSTR + kj;
                vp[0 * VSTR] = (bf16)(raw.x & 0xffffu); vp[1 * VSTR] = (bf16)(raw.x >> 16); vp[2 * VSTR] = (bf16)(raw.y & 0xffffu); vp[3 * VSTR] = (bf16)(raw.y >> 16);
                vp[4 * VSTR] = (bf16)(raw.z & 0xffffu); vp[5 * VSTR] = (bf16)(raw.z >> 16); vp[6 * VSTR] = (bf16)(raw.w & 0xffffu); vp[7 * VSTR] = (bf16)(raw.w >> 16);
            }
            __syncthreads();
            const int ql = lane & 15, kg = lane >> 4, i = wave;
            for (int it = 0; it < 4; ++it) {
                const int head = 4 * g + it; const size_t qrow = (size_t)b * SEQ + 128 * qb + 16 * i + ql;
                bf16* qp = Qb + qrow * D + 64 * head;
                const bf16x8 qf0 = *(const bf16x8*)(qp + 8 * kg), qf1 = *(const bf16x8*)(qp + 32 + 8 * kg);
                f32x4 sc[9];
#pragma unroll
                for (int jb = 0; jb < 9; ++jb) {
                    const LAS bf16* kp = KL + (16 * (i + jb) + ql) * KSTR + 8 * kg;
                    const bf16x8 a0 = *(const LAS bf16x8*)kp, a1 = *(const LAS bf16x8*)(kp + 32);
                    sc[jb] = __builtin_amdgcn_mfma_f32_16x16x32_bf16(a0, qf0, (f32x4){0.f, 0.f, 0.f, 0.f}, 0, 0, 0);
                    sc[jb] = __builtin_amdgcn_mfma_f32_16x16x32_bf16(a1, qf1, sc[jb], 0, 0, 0);
                }
                const int qi = 16 * i + ql; const float sink = sinks[head] * LOG2E; float mx = sink;
#pragma unroll
                for (int jb = 0; jb < 9; ++jb)
#pragma unroll
                    for (int r = 0; r < 4; ++r) { const int kj = 16 * (i + jb) + 4 * kg + r; const bool valid = (kj > qi) && (kj <= qi + 128) && ((qb > 0) || (kj >= 128));
                        sc[jb][r] = valid ? sc[jb][r] : -INFINITY; mx = fmaxf(mx, sc[jb][r]); }
                mx = fmaxf(mx, __shfl_xor(mx, 16)); mx = fmaxf(mx, __shfl_xor(mx, 32));
                float sum = 0.f;
#pragma unroll
                for (int jb = 0; jb < 9; ++jb)
#pragma unroll
                    for (int r = 0; r < 4; ++r) { const float p = fast_exp2(sc[jb][r] - mx); sc[jb][r] = p; sum += p; }
                sum += __shfl_xor(sum, 16); sum += __shfl_xor(sum, 32);
                const float inv = fast_rcp(sum + fast_exp2(sink - mx));
                f32x4 o[4];
#pragma unroll
                for (int db = 0; db < 4; ++db) o[db] = (f32x4){0.f, 0.f, 0.f, 0.f};
#pragma unroll
                for (int pp = 0; pp < 5; ++pp) {
                    v4u pw; pw.x = cvt_pk_bf16(sc[2 * pp][0], sc[2 * pp][1]); pw.y = cvt_pk_bf16(sc[2 * pp][2], sc[2 * pp][3]);
                    if (pp < 4) { pw.z = cvt_pk_bf16(sc[2 * pp + 1 < 9 ? 2 * pp + 1 : 8][0], sc[2 * pp + 1 < 9 ? 2 * pp + 1 : 8][1]); pw.w = cvt_pk_bf16(sc[2 * pp + 1 < 9 ? 2 * pp + 1 : 8][2], sc[2 * pp + 1 < 9 ? 2 * pp + 1 : 8][3]); }
                    else { pw.z = 0u; pw.w = 0u; }
                    const bf16x8 pf = __builtin_bit_cast(bf16x8, pw);
#pragma unroll
                    for (int db = 0; db < 4; ++db) {
                        const LAS bf16* vp = VT + (16 * db + ql) * VSTR + 16 * (i + 2 * pp) + 4 * kg;
                        v4u vw; const v2u l2 = *(const LAS v2u*)vp; vw.x = l2.x; vw.y = l2.y;
                        if (pp < 4) { const v2u h2 = *(const LAS v2u*)(vp + 16); vw.z = h2.x; vw.w = h2.y; } else { vw.z = 0u; vw.w = 0u; }
                        o[db] = __builtin_amdgcn_mfma_f32_16x16x32_bf16(__builtin_bit_cast(bf16x8, vw), pf, o[db], 0, 0, 0);
                    }
                }
#pragma unroll
                for (int db = 0; db < 4; ++db) { v2u w; w.x = cvt_pk_bf16(o[db][0] * inv, o[db][1] * inv); w.y = cvt_pk_bf16(o[db][2] * inv, o[db][3] * inv);
                    *(v2u*)(qp + 16 * db + 4 * kg) = w; }
            }
            __syncthreads();
        }
        GRID_BAR();
        PROBE_END(8);
    }

    if (IN(9)) {
        PROBE_START(9);
        pg8::StaticOrder S; S.init(M, D, D, D, G, bid, Qb, Wo_t);
        pg8::EpiRes E{X, X, IN_(19), XB1, nullptr};
        pg8::gemm_phase<pg8::EpiRes, pg8::StaticOrder, false, false>(F.lds, D, S, E);
        GRID_BAR();
        PROBE_END(9);
    }

    if (IN(10)) {
        PROBE_START(10);
        LAS float* WRL = (LAS float*)(F.lds);
        LAS int* lcnt = (LAS int*)(F.lds + 32768);
        LAS unsigned* rec = (LAS unsigned*)(F.lds + 32768 + 64);
        for (int i = tid; i < NE * D / 4; i += NWAVES * 64) ((LAS f32x4*)WRL)[i] = ((const f32x4*)WR)[i];
        for (int chunk = bid; chunk < M / 64; chunk += G) {
            if (tid < 8) lcnt[tid] = 0;
            __syncthreads();
            for (int k = 0; k < 8; ++k) {
                const int tl = wave * 8 + k, tok = chunk * 64 + tl;
                const f32x4* xr = (const f32x4*)(X + (size_t)tok * D) + lane; f32x4 v[4]; float s = 0.f;
#pragma unroll
                for (int j = 0; j < 4; ++j) { v[j] = xr[64 * j]; s += (v[j].x * v[j].x + v[j].y * v[j].y) + (v[j].z * v[j].z + v[j].w * v[j].w); }
                float dot[8];
#pragma unroll
                for (int e = 0; e < 8; ++e) { float d = 0.f;
#pragma unroll
                    for (int j = 0; j < 4; ++j) { const f32x4 w = ((const LAS f32x4*)(WRL + e * D))[lane + 64 * j]; d += (v[j].x * w.x + v[j].y * w.y) + (v[j].z * w.z + v[j].w * w.w); }
                    dot[e] = d; }
                s = wave_sum(s);
#pragma unroll
                for (int e = 0; e < 8; ++e) dot[e] = wave_sum(dot[e]);
                const float r = __builtin_amdgcn_rsqf(s * (1.0f / D) + EPS);
                int e0 = 0; float v0 = dot[0] * r;
#pragma unroll
                for (int e = 1; e < 8; ++e) { const float l = dot[e] * r; if (l > v0) { v0 = l; e0 = e; } }
                int e1 = -1; float v1 = -INFINITY;
#pragma unroll
                for (int e = 0; e < 8; ++e) { const float l = dot[e] * r; if (e != e0 && l > v1) { v1 = l; e1 = e; } }
                const float w1 = fast_rcp(1.0f + fast_exp2((v0 - v1) * LOG2E)), w0 = 1.0f - w1;
                if (lane == 0) {
                    const int p0 = __hip_atomic_fetch_add(&lcnt[e0], 1, __ATOMIC_RELAXED, __HIP_MEMORY_SCOPE_WORKGROUP);
                    const int p1 = __hip_atomic_fetch_add(&lcnt[e1], 1, __ATOMIC_RELAXED, __HIP_MEMORY_SCOPE_WORKGROUP);
                    LAS unsigned* rp = rec + tl * 6; rp[0] = (unsigned)e0; rp[1] = (unsigned)e1; rp[2] = (unsigned)p0; rp[3] = (unsigned)p1; rp[4] = __float_as_uint(w0); rp[5] = __float_as_uint(w1);
                    R4[tok] = r;
                }
            }
            __syncthreads();
            if (tid < 8) lcnt[8 + tid] = (int)__hip_atomic_fetch_add(GCNT + 64 * tid, (unsigned)lcnt[tid], __ATOMIC_RELAXED, __HIP_MEMORY_SCOPE_AGENT);
            __syncthreads();
            if (tid < 64) {
                const int tok = chunk * 64 + tid; const LAS unsigned* rp = rec + tid * 6;
                const int e0 = (int)rp[0], e1 = (int)rp[1]; const int q0 = lcnt[8 + e0] + (int)rp[2], q1 = lcnt[8 + e1] + (int)rp[3];
                TOKLIST[e0 * M + q0] = tok; TOKLIST[e1 * M + q1] = tok; SLOTW[e0 * M + q0] = __uint_as_float(rp[4]); SLOTW[e1 * M + q1] = __uint_as_float(rp[5]);
                TOKSLOT[2 * tok] = ((unsigned)e0 << 16) | (unsigned)q0; TOKSLOT[2 * tok + 1] = ((unsigned)e1 << 16) | (unsigned)q1;
            }
            __syncthreads();
        }
        GRID_BAR();
        PROBE_END(10);
    }

    LAS int* const etab = (LAS int*)(F.lds + MISC_OFF) + 32;
    if (IN(11) || IN(12) || IN(13)) {
        if (tid == 0) { int ts = 0, off = 0;
            for (int e = 0; e < 8; ++e) { const int cn = (int)__hip_atomic_load(GCNT + 64 * e, __ATOMIC_RELAXED, __HIP_MEMORY_SCOPE_AGENT); etab[e] = ts; etab[9 + e] = off; etab[18 + e] = cn; ts += (cn + 255) >> 8; off += cn; }
            etab[8] = ts; etab[17] = off; }
        __syncthreads();
    }

    if (IN(11)) {
        PROBE_START(11);
        LAS unsigned* toktab = (LAS unsigned*)(F.lds + TOKTAB_OFF);
        pg8::MoeOrder S{etab, toktab, FFE / 128, G, bid, etab[8] * (FFE / 128), D, (const char*)XB1, (const char*)MWgu_t, (size_t)D * 2, (size_t)2 * FFE * D * 2, (size_t)256 * D * 2};
        { pg8::Unit u; for (int ui = 0; ui < 16 && S.next(ui, u); ++ui) { if (tid < 256) { const int tok = TOKLIST[u.e * M + (tid < u.cnt ? u.pm * 256 + tid : 0)]; toktab[ui * 256 + tid] = (unsigned)tok * (unsigned)(D * 2); } } }
        __syncthreads();
        pg8::EpiHid<true> E{HIDM, FFE, nullptr, R4, TOKLIST};
#if defined(PROBE_DUMMY)
        { pg8::EpiNull EN; pg8::gemm_phase<pg8::EpiNull, pg8::MoeOrder, true, true>(F.lds, D, S, EN); }
#else
        pg8::gemm_phase<pg8::EpiHid<true>, pg8::MoeOrder, true, true>(F.lds, D, S, E);
#endif
        GRID_BAR();
        PROBE_END(11);
#if defined(PROBE_DUMMY)
        pg8::gemm_phase<pg8::EpiHid<true>, pg8::MoeOrder, true, true>(F.lds, D, S, E);
        GRID_BAR();
#endif
    }

    if (IN(12)) {
        PROBE_START(12);
        pg8::MoeOrder S{etab, nullptr, D / 256, G, bid, etab[8] * (D / 256), FFE, (const char*)HIDM, (const char*)MWd_t, (size_t)FFE * 2, (size_t)D * FFE * 2, (size_t)256 * FFE * 2};
        pg8::EpiBf<true> E{YS, D, SLOTW};
        pg8::gemm_phase<pg8::EpiBf<true>, pg8::MoeOrder, true, false>(F.lds, FFE, S, E);
        GRID_BAR();
        PROBE_END(12);
    }

    if (IN(13)) {
        PROBE_START(13);
        for (int m = gw; m < M; m += NGW) {
            const unsigned s0 = TOKSLOT[2 * m], s1 = TOKSLOT[2 * m + 1];
            const size_t r0 = (size_t)(etab[9 + (s0 >> 16)] + (int)(s0 & 0xffffu)), r1 = (size_t)(etab[9 + (s1 >> 16)] + (int)(s1 & 0xffffu));
            f32x4* xr = (f32x4*)(X + (size_t)m * D) + lane; const v2u* y0 = (const v2u*)(YS + r0 * D) + lane; const v2u* y1 = (const v2u*)(YS + r1 * D) + lane;
            v2u* o8 = (v2u*)(XB0 + (size_t)m * D) + lane; float s = 0.f;
#pragma unroll
            for (int j = 0; j < 4; ++j) { f32x4 v = xr[64 * j]; const v2u a = y0[64 * j], b = y1[64 * j];
                v.x += bf_lo(a.x) + bf_lo(b.x); v.y += bf_hi(a.x) + bf_hi(b.x); v.z += bf_lo(a.y) + bf_lo(b.y); v.w += bf_hi(a.y) + bf_hi(b.y);
                xr[64 * j] = v; s += (v.x * v.x + v.y * v.y) + (v.z * v.z + v.w * v.w);
                v2u w; w.x = cvt_pk_bf16(v.x, v.y); w.y = cvt_pk_bf16(v.z, v.w); o8[64 * j] = w; }
            s = wave_sum(s);
            if (lane < 16) SS5[(size_t)m * 16 + lane] = lane == 0 ? s : 0.f;
        }
        VM_WAIT(); __syncthreads();
        { pg8::StaticOrder S; S.init(M, D, PLE, PLE, G, bid, PB + (size_t)M * PLE, Wpp1_t);
          pg8::EpiBf<false> E{PROJ, D, nullptr};
          pg8::gemm_phase<pg8::EpiBf<false>, pg8::StaticOrder, false, false>(F.lds, PLE, S, E); }
        GRID_BAR();
        PROBE_END(13);
    }

    if (IN(14)) {
        PROBE_START(14);
        pg8::StaticOrder S; S.init(M, D, D, D, G, bid, XB0, Wpg1_t);
        pg8::EpiPle E{X, PROJ, SS5, nullptr, nullptr};
        pg8::gemm_phase<pg8::EpiPle, pg8::StaticOrder, false, false>(F.lds, D, S, E);
        GRID_BAR();
        PROBE_END(14);
    }

    if (IN(15)) {
        PROBE_START(15);
        const f32x4* gp = (const f32x4*)IN_(30) + lane;
        const f32x4 g0 = gp[0], g1 = gp[64], g2 = gp[128], g3 = gp[192];
        for (int m = gw; m < M; m += NGW) {
            f32x4* xr = (f32x4*)(X + (size_t)m * D) + lane; f32x4 v[4]; float s = 0.f;
#pragma unroll
            for (int j = 0; j < 4; ++j) { v[j] = xr[64 * j]; s += (v[j].x * v[j].x + v[j].y * v[j].y) + (v[j].z * v[j].z + v[j].w * v[j].w); }
            s = wave_sum(s); const float r = __builtin_amdgcn_rsqf(s * (1.0f / D) + EPS);
            xr[0] = v[0] * r * g0; xr[64] = v[1] * r * g1; xr[128] = v[2] * r * g2; xr[192] = v[3] * r * g3;
        }
    }
#if defined(PROBE_LO)
    if (bid == 0) { const unsigned long long te = __builtin_amdgcn_s_memrealtime(); while (__builtin_amdgcn_s_memrealtime() - te < 8ull * probe_dt) __builtin_amdgcn_s_sleep(8); }
#endif
#undef IN
#undef GRID_BAR
}

constexpr int N_PHASES = 16;
extern "C" void kernel_launch(void* const* d_in, const int* in_sizes, int n_in, void* d_out, int out_size, void* d_ws, size_t ws_size, hipStream_t stream) {
    static int grid = 0;
    if (grid == 0) {
        if (n_in != 31 || out_size != M * D || ws_size < WS_END) { fprintf(stderr, "kernel_launch: unexpected shapes (n_in %d, out %d, ws %zu < %zu)\n", n_in, out_size, ws_size, (size_t)WS_END); grid = -1; return; }
        int dev = 0, cus = 0;
        if (hipGetDevice(&dev) != hipSuccess || hipDeviceGetAttribute(&cus, hipDeviceAttributeMultiprocessorCount, dev) != hipSuccess) { grid = -1; return; }
        if (hipFuncSetAttribute((const void*)fwd_kernel, hipFuncAttributeMaxDynamicSharedMemorySize, LDS_BYTES) != hipSuccess) { fprintf(stderr, "kernel_launch: hipFuncSetAttribute failed\n"); grid = -1; return; }
        int per_cu = 0;
        if (hipOccupancyMaxActiveBlocksPerMultiprocessor(&per_cu, (const void*)fwd_kernel, NWAVES * 64, LDS_BYTES) != hipSuccess || per_cu < 1) fprintf(stderr, "kernel_launch: occupancy query reports %d\n", per_cu);
        (void)hipGetLastError();
        grid = cus;
    }
    if (grid < 0) return;
    (void)in_sizes;
    if (hipMemsetAsync((char*)d_ws + WS_CTL, 0, CTL_ZERO_BYTES, stream) != hipSuccess) return;
    Args a{};
    for (int i = 0; i < 31; ++i) a.in[i] = (const float*)d_in[i];
    a.out = (float*)d_out; a.ws = (unsigned char*)d_ws;
    if (MK_N_LAUNCHES == 1) {
        a.ph_lo = 0; a.ph_hi = N_PHASES; a.li = 0;
        hipLaunchKernelGGL(fwd_kernel, dim3(grid), dim3(NWAVES * 64), LDS_BYTES, stream, a);
    } else {
        for (int li = 0; li < N_PHASES; ++li) { a.ph_lo = li; a.ph_hi = li + 1; a.li = li;
            hipLaunchKernelGGL(fwd_kernel, dim3(grid), dim3(NWAVES * 64), LDS_BYTES, stream, a); }
    }
}
```

```cpp
#include <hip/hip_runtime.h>
#include <cstdio>
#include <cstdint>

#ifndef MK_N_LAUNCHES
#define MK_N_LAUNCHES 1
#endif

#define GAS __attribute__((address_space(1)))
#define LAS __attribute__((address_space(3)))
typedef unsigned short bf16;
typedef unsigned v4u __attribute__((ext_vector_type(4)));
typedef unsigned v2u __attribute__((ext_vector_type(2)));
typedef float f32x4 __attribute__((ext_vector_type(4)));
typedef float f32x2 __attribute__((ext_vector_type(2)));
typedef short bf16x8 __attribute__((ext_vector_type(8)));
typedef short s16x4 __attribute__((ext_vector_type(4)));

constexpr int M = 16384, D = 1024, SEQ = 4096;
constexpr int GF = 6144, GH = 3072, GD = 384;
constexpr int FFD = 2816, NE = 8, FFE = 3584, PLE = 256;
constexpr int NQKV = 1536;
constexpr float EPS = 1e-6f;
constexpr float LOG2E = 1.4426950408889634f;
constexpr float QSCALE = 0.125f * LOG2E;

constexpr size_t MiB = 1u << 20;
constexpr size_t WS_CTL = 0, CTL_ZERO_BYTES = 1 * MiB;
constexpr size_t WS_SS = 1 * MiB;
constexpr size_t WS_R4 = 6 * MiB;
constexpr size_t WS_TOKSLOT = WS_R4 + 64 * 1024;
constexpr size_t WS_TOKLIST = WS_TOKSLOT + 128 * 1024;
constexpr size_t WS_SLOTW = WS_TOKLIST + 512 * 1024;
constexpr size_t WS_WR = WS_SLOTW + 512 * 1024;
constexpr size_t WS_VSTAT = 8 * MiB;
constexpr size_t WS_ROPE = 14 * MiB;
constexpr size_t WS_PB = 15 * MiB;
constexpr size_t WS_XB1 = 31 * MiB;
constexpr size_t WS_WPG1 = 63 * MiB;
constexpr size_t WS_WPP1 = 65 * MiB;
constexpr size_t WS_MWGU = 66 * MiB;
constexpr size_t WS_MWD = 178 * MiB;
constexpr size_t WS_B = 234 * MiB;
constexpr size_t WS_WIN = WS_B;
constexpr size_t WS_WOUT = WS_B + 12 * MiB;
constexpr size_t WS_WGU = WS_B + 18 * MiB;
constexpr size_t WS_WD = WS_B + 29 * MiB;
constexpr size_t WS_WPG0 = WS_B + 35 * MiB;
constexpr size_t WS_WPP0 = WS_B + 37 * MiB;
constexpr size_t WS_WQKV = WS_B + 38 * MiB;
constexpr size_t WS_WO = WS_B + 41 * MiB;
constexpr size_t WS_XB0 = WS_B + 43 * MiB;
constexpr size_t WS_UV = WS_B + 75 * MiB;
constexpr size_t WS_HID = WS_UV;
constexpr size_t WS_PROJ = WS_UV + 96 * MiB;
constexpr size_t WS_Q = WS_UV;
constexpr size_t WS_K = WS_UV + 32 * MiB;
constexpr size_t WS_V = WS_UV + 40 * MiB;
constexpr size_t WS_HIDM = WS_B;
constexpr size_t WS_YS = WS_MWGU;
constexpr size_t WS_YSP = WS_B + 226 * MiB;
constexpr size_t WS_END = WS_B + 267 * MiB;
static_assert(WS_HIDM + (size_t)(32768 + 256) * FFE * 2 <= WS_END, "hidm");
static_assert(WS_WR + 32768 <= WS_VSTAT, "misc");

constexpr int CW_TMO = 0, CW_BAR = 4096, CW_CNT = 8192;

constexpr int RING_BYTES = 131072;
constexpr int TOKTAB_OFF = RING_BYTES;
constexpr int MISC_OFF = RING_BYTES + 16384;
constexpr int LDS_BYTES = MISC_OFF + 512;
constexpr int NWAVES = 8;

#define RLX_AGENT __ATOMIC_RELAXED, __HIP_MEMORY_SCOPE_AGENT
#define LDS_WAIT() asm volatile("s_waitcnt lgkmcnt(0)" ::: "memory")
#define VM_WAIT() asm volatile("s_waitcnt vmcnt(0)" ::: "memory")
__device__ __forceinline__ unsigned cvt_pk_bf16(float lo, float hi) { unsigned r; asm volatile("v_cvt_pk_bf16_f32 %0, %1, %2" : "=v"(r) : "v"(lo), "v"(hi)); return r; }
__device__ __forceinline__ float bf_lo(unsigned w) { return __uint_as_float(w << 16); }
__device__ __forceinline__ float bf_hi(unsigned w) { return __uint_as_float(w & 0xffff0000u); }
__device__ __forceinline__ float fast_rcp(float x) { return __builtin_amdgcn_rcpf(x); }
__device__ __forceinline__ float fast_exp2(float x) { return __builtin_amdgcn_exp2f(x); }
__device__ __forceinline__ float sigmoid_f(float x) { return fast_rcp(1.0f + fast_exp2(-x * LOG2E)); }
__device__ __forceinline__ float gelu_tanh(float x) { const float u = 0.7978845608028654f * (x + 0.044715f * x * x * x); return x * fast_rcp(1.0f + fast_exp2(-2.0f * LOG2E * u)); }
__device__ __forceinline__ f32x2 gelu_tanh2(f32x2 x) {
    const f32x2 t = x * x; const f32x2 p = t * (-0.10294324f) + (-2.3022082f); const f32x2 z = x * p;
    f32x2 e; e.x = fast_exp2(z.x); e.y = fast_exp2(z.y); const f32x2 d = e + 1.0f;
    f32x2 r; r.x = fast_rcp(d.x); r.y = fast_rcp(d.y); return x * r;
}
__device__ __forceinline__ f32x2 sigm2(f32x2 y  ) { f32x2 e; e.x = fast_exp2(y.x); e.y = fast_exp2(y.y); const f32x2 d = e + 1.0f; f32x2 r; r.x = fast_rcp(d.x); r.y = fast_rcp(d.y); return r; }
__device__ __forceinline__ int opaque_lane() { int l; asm volatile("v_mbcnt_lo_u32_b32 %0, -1, 0\n\tv_mbcnt_hi_u32_b32 %0, -1, %0" : "=v"(l)); return l; }
__device__ __forceinline__ float wave_sum(float v) {
#pragma unroll
    for (int o = 1; o < 64; o <<= 1) v += __shfl_xor(v, o);
    return v;
}
__device__ __forceinline__ float row_rscale(const float* ss, int row, int fq) {
    const f32x4 v = *(const f32x4*)(ss + (size_t)row * 16 + 4 * fq);
    float s = (v.x + v.y) + (v.z + v.w);
    s += __shfl_xor(s, 16); s += __shfl_xor(s, 32);
    return __builtin_amdgcn_rsqf(s * (1.0f / D) + EPS);
}

#define XB_TMO      128
#define XB_XCNT(j)  (256  + 64 * (j))
#define XB_XSUB(j)  (1280 + 64 * (j))
#define XB_XGEN(j)  (2304 + 64 * (j))
#define XB_TOP      3328
#define XB_TOPGEN   3392
#define XCD_BAR_WORDS 3456
#define XB_SPIN_CAP (1u << 18)
__device__ __forceinline__ unsigned xb_ld(unsigned* p)              { return __hip_atomic_load(p, __ATOMIC_RELAXED, __HIP_MEMORY_SCOPE_AGENT); }
__device__ __forceinline__ unsigned xb_add(unsigned* p, unsigned v) { return __hip_atomic_fetch_add(p, v, __ATOMIC_RELAXED, __HIP_MEMORY_SCOPE_AGENT); }
__device__ __forceinline__ unsigned xb_xcc_id() { return (unsigned)__builtin_amdgcn_s_getreg((3 << 11) | 20) & 0xFu; }
#define XB_SPIN(cond, bar) do { unsigned _sp = 0; while (cond) { __builtin_amdgcn_s_sleep(1); \
    if ((++_sp & 255u) == 0u) { if (xb_ld(&(bar)[XB_TMO])) break; if (_sp > XB_SPIN_CAP) { atomicAdd(&(bar)[XB_TMO], 1u); break; } } } } while (0)
struct XcdBarrier { unsigned* bar; unsigned x; volatile LAS unsigned* st; };
__device__ __forceinline__ XcdBarrier xcd_barrier_post(unsigned* bar, volatile LAS unsigned* st) {
    XcdBarrier b; b.bar = bar; b.x = xb_xcc_id(); b.st = st;
    if (threadIdx.x == 0) (void)xb_add(&bar[XB_XCNT(b.x)], 1u);
    return b;
}
__device__ __forceinline__ void xcd_barrier_complete(unsigned* bar, unsigned x, unsigned& nloc, unsigned& nx) {
    const unsigned G = gridDim.x * gridDim.y * gridDim.z;
    unsigned sum, cnt, mine, sp = 0u;
    for (;;) {
        sum = 0u; cnt = 0u; mine = 0u;
#pragma unroll
        for (unsigned j = 0; j < 16; ++j) { const unsigned c = xb_ld(&bar[XB_XCNT(j)]); sum += c; cnt += (c > 0u) ? 1u : 0u; mine = (j == x) ? c : mine; }
        if (sum == G) break;
        __builtin_amdgcn_s_sleep(1);
        if ((++sp & 255u) == 0u) { if (xb_ld(&bar[XB_TMO])) break; if (sp > XB_SPIN_CAP) { atomicAdd(&bar[XB_TMO], 1u); break; } }
    }
    nloc = mine > 0u ? mine : 1u; nx = cnt > 0u ? cnt : 1u;
}
__device__ __forceinline__ void xcd_barrier(const XcdBarrier& b) {
    asm volatile("s_waitcnt vmcnt(0)" ::: "memory");
    __syncthreads();
    if (threadIdx.x == 0) {
        unsigned* bar = b.bar;
        __builtin_amdgcn_s_waitcnt(0);
        unsigned nloc = b.st[0], nx = b.st[1];
        if (nloc == 0u) { xcd_barrier_complete(bar, b.x, nloc, nx); b.st[0] = nloc; b.st[1] = nx; }
        const unsigned old = xb_add(&bar[XB_XSUB(b.x)], 1u);
        const unsigned gen = old / nloc;
        if (old + 1u == (gen + 1u) * nloc) {
            __builtin_amdgcn_fence(__ATOMIC_RELEASE, "agent");
            asm volatile("s_waitcnt vmcnt(0)" ::: "memory");
            const unsigned og = xb_add(&bar[XB_TOP], 1u);
            const unsigned tg = og / nx;
            if (og + 1u == (tg + 1u) * nx) xb_add(&bar[XB_TOPGEN], 1u);
            else XB_SPIN(xb_ld(&bar[XB_TOPGEN]) == tg, bar);
            __builtin_amdgcn_fence(__ATOMIC_ACQUIRE, "agent");
            xb_add(&bar[XB_XGEN(b.x)], 1u);
            asm volatile("s_waitcnt vmcnt(0)" ::: "memory");
        } else {
            XB_SPIN(xb_ld(&bar[XB_XGEN(b.x)]) == gen, bar);
            __builtin_amdgcn_fence(__ATOMIC_ACQUIRE, "agent");
            asm volatile("s_waitcnt vmcnt(0)" ::: "memory");
        }
    }
    __syncthreads();
}

namespace pg8 {
constexpr int BM = 256, BK = 64, HALF = 128, HTB = HALF * BK * 2, STAGE_BYTES = 8 * HTB, NXCD = 8, WGM = 8;
__host__ __device__ __forceinline__ int lds_byte(int r, int c) { const int st = (r >> 4) * 2 + (c >> 5), rr = r & 15, cc = c & 31, ob = rr * 64 + cc * 2; return st * 1024 + (ob ^ (((ob >> 9) & 1) << 5)); }
__host__ __device__ __forceinline__ void stage_rc(int b, int& R, int& C) { const int st = b / 1024, sb = b % 1024, swz = sb ^ (((sb >> 9) & 1) << 5); R = (st >> 1) * 16 + swz / 64; C = (st & 1) * 32 + (swz % 64) / 2; }
__host__ __device__ __forceinline__ int perm32(int rho) { const int n = rho >> 4, i = rho & 15; return 8 * (i >> 2) + 4 * n + (i & 3); }

struct Unit { int pm, pn, e, r0, cnt, ks; };

struct StaticOrder {
    int nM, nN, nwg, G, c, lda, ldb; const char* A; const char* Bt; size_t tstepA, tstepB;
    __device__ __forceinline__ void init(int M_, int N_, int K_, int lda_, int G_, int c_, const bf16* A_, const bf16* Bt_) { nM = M_ / BM; nN = N_ / BM; nwg = nM * nN; G = G_; c = c_; lda = lda_; ldb = K_; A = (const char*)A_; Bt = (const char*)Bt_; tstepA = (size_t)BM * lda_ * 2; tstepB = (size_t)BM * K_ * 2; }
    __device__ __forceinline__ bool next(int i, Unit& u) const {
        const long L = (long)i * G + c; if (L >= nwg) return false;
        int wgid = (int)L; { const int q = nwg / NXCD, r = nwg % NXCD, xcd = wgid % NXCD, off = wgid / NXCD; wgid = (xcd < r ? xcd * (q + 1) : r * (q + 1) + (xcd - r) * q) + off; }
        const int nig = WGM * nN, gid = wgid / nig, fm = gid * WGM, gsz = (nM - fm) < WGM ? (nM - fm) : WGM;
        u.pm = fm + ((wgid % nig) % gsz); u.pn = (wgid % nig) / gsz; u.e = 0; u.r0 = u.pm * BM; u.cnt = BM; u.ks = 0; return true;
    }
    __device__ __forceinline__ const char* a_base(const Unit& u) const { return A + (size_t)u.pm * tstepA; }
    __device__ __forceinline__ const char* b_base(const Unit& u) const { return Bt + (size_t)u.pn * tstepB; }
    __device__ __forceinline__ unsigned a_off(int, int) const { return 0u; }
};

struct MoeOrder {
    const LAS int* tab; const LAS unsigned* toktab; int NT, G, c, total, lda, ldb; const char* A; const char* Bt; size_t a_row_bytes, b_exp_bytes, b_tile_bytes;
    int mt0, nks;
    __device__ __forceinline__ bool next(int i, Unit& u) const {
        const long L = (long)i * G + c; if (L >= total) return false;
        const int ks = (int)(L % nks); const long L2 = L / nks;
        const int mtg = mt0 + (int)(L2 / NT), pn = (int)(L2 % NT);
        int e = 0;
#pragma unroll
        for (int j = 1; j < 8; ++j) e += (mtg >= __builtin_amdgcn_readfirstlane(tab[j])) ? 1 : 0;
        const int ts = __builtin_amdgcn_readfirstlane(tab[e]), off = __builtin_amdgcn_readfirstlane(tab[9 + e]), cn = __builtin_amdgcn_readfirstlane(tab[18 + e]);
        u.e = e; u.pm = mtg - ts; u.pn = pn; u.r0 = off + BM * u.pm; const int rem = cn - BM * u.pm; u.cnt = rem < BM ? rem : BM; u.ks = ks; return true;
    }
    __device__ __forceinline__ const char* a_base(const Unit& u) const { return toktab ? A : A + (size_t)u.r0 * a_row_bytes + (size_t)u.ks * 1024; }
    __device__ __forceinline__ const char* b_base(const Unit& u) const { return Bt + (size_t)u.e * b_exp_bytes + (size_t)u.pn * b_tile_bytes + (size_t)u.ks * 1024; }
    __device__ __forceinline__ unsigned a_off(int ui, int R) const { return toktab[(ui & 15) * 256 + R]; }
};

template <class Epi, class Sched, bool ALIGN_EPI, bool GATHER>
__device__ __forceinline__ void gemm_phase(LAS unsigned char* lds, const int K, const Sched& S, const Epi& E) {
    const int wid = __builtin_amdgcn_readfirstlane(threadIdx.x >> 6), lane = opaque_lane(), tid = wid * 64 + lane, wr = wid >> 2, wc = wid & 3, fr = lane & 15, fq = lane >> 4;
    const int nt = K / BK;
    unsigned voffB[2], vAc[2][2], vAn[2][2]; int Rr[2], Cb[2];
    const size_t kstep = (size_t)(BK * 2);
    const size_t hstep = (size_t)HALF * S.ldb * 2;
#pragma unroll
    for (int i = 0; i < 2; ++i) { int R, C; stage_rc(tid * 16 + i * 8192, R, C); const int Rb = Epi::PERM ? ((R & ~31) + perm32(R & 31)) : R;
        Rr[i] = R; Cb[i] = C * 2; voffB[i] = (unsigned)(Rb * S.ldb + C) * 2u; }
    const unsigned ldsw = (unsigned)wid * 1024u;
    const int aoff = lds_byte(wr * 64 + fr, fq * 8), boff = lds_byte(wc * 32 + fr, fq * 8);
#define PG8_SA(b, h) (((b) * 2 + (h)) * HTB)
#define PG8_SB(b, h) ((4 + (b) * 2 + (h)) * HTB)
#define PG8_STAGE(bufoff, gbase, voff) do { _Pragma("unroll") for (int _i = 0; _i < 2; ++_i) \
        __builtin_amdgcn_global_load_lds((const unsigned*)((const char*)(gbase) + (voff)[_i]), (LAS unsigned*)(lds + (bufoff) + ldsw + _i * 8192), 16, 0, 0); } while (0)
#define PG8_LDA(dst, b, h) do { _Pragma("unroll") for (int m = 0; m < 4; ++m) _Pragma("unroll") for (int k = 0; k < 2; ++k) dst[m][k] = *(const LAS bf16x8*)(lds + PG8_SA(b, h) + aoff + m * 2048 + k * 1024); } while (0)
#define PG8_LDB(dst, b, h) do { _Pragma("unroll") for (int n = 0; n < 2; ++n) _Pragma("unroll") for (int k = 0; k < 2; ++k) dst[n][k] = *(const LAS bf16x8*)(lds + PG8_SB(b, h) + boff + n * 2048 + k * 1024); } while (0)
#define PG8_MMA(ai, bj, At, Bt) do { __builtin_amdgcn_s_setprio(1); _Pragma("unroll") for (int m = 0; m < 4; ++m) _Pragma("unroll") for (int n = 0; n < 2; ++n) _Pragma("unroll") for (int k = 0; k < 2; ++k) \
        acc[ai][bj][m][n] = __builtin_amdgcn_mfma_f32_16x16x32_bf16(Bt[n][k], At[m][k], acc[ai][bj][m][n], 0, 0, 0); __builtin_amdgcn_s_setprio(0); } while (0)
#define PG8_WAIT_V(n) asm volatile("s_waitcnt vmcnt(" #n ")" ::: "memory")
#define PG8_WAIT_L(n) asm volatile("s_waitcnt lgkmcnt(" #n ")" ::: "memory")
#define PG8_BAR __builtin_amdgcn_s_barrier()
#define PG8_SCHED __builtin_amdgcn_sched_barrier(0)
#define PG8_VOFF(dst, ui_) do { _Pragma("unroll") for (int _h = 0; _h < 2; ++_h) _Pragma("unroll") for (int _i = 0; _i < 2; ++_i) \
        dst[_h][_i] = GATHER ? (S.a_off((ui_), Rr[_i] + _h * HALF) + (unsigned)Cb[_i]) : (unsigned)((Rr[_i] + _h * HALF) * S.lda * 2 + Cb[_i]); } while (0)
    Unit cur, nxt; int ui = 0;
    if (!S.next(0, cur)) return;
    f32x4 acc[2][2][4][2];
#pragma unroll
    for (int a = 0; a < 2; ++a)
#pragma unroll
        for (int b = 0; b < 2; ++b)
#pragma unroll
            for (int m = 0; m < 4; ++m)
#pragma unroll
                for (int n = 0; n < 2; ++n) acc[a][b][m][n] = (f32x4){0.f, 0.f, 0.f, 0.f};
    bf16x8 At[4][2], B0[2][2], B1[2][2];
    const char* cA = S.a_base(cur); const char* cB = S.b_base(cur);
    PG8_VOFF(vAc, 0);
    PG8_STAGE(PG8_SB(0, 0), cB, voffB); PG8_STAGE(PG8_SB(0, 1), cB + hstep, voffB); PG8_STAGE(PG8_SA(0, 0), cA, vAc[0]); PG8_STAGE(PG8_SA(0, 1), cA, vAc[1]);
    if (wr == 1) PG8_BAR;
    PG8_WAIT_V(2); PG8_BAR;
    PG8_STAGE(PG8_SB(1, 0), cB + kstep, voffB); PG8_STAGE(PG8_SA(1, 0), cA + kstep, vAc[0]); PG8_STAGE(PG8_SB(1, 1), cB + hstep + kstep, voffB);
    PG8_WAIT_V(6); PG8_BAR;
    for (;;) {
        const bool has_next = S.next(ui + 1, nxt);
        const char* nA = has_next ? S.a_base(nxt) : cA; const char* nB = has_next ? S.b_base(nxt) : cB;
        if (GATHER) { if (has_next) { PG8_VOFF(vAn, ui + 1); } else {
#pragma unroll
            for (int h = 0; h < 2; ++h)
#pragma unroll
                for (int i = 0; i < 2; ++i) vAn[h][i] = vAc[h][i]; } }
        for (int t = 0; t < nt; t += 2) {
            const bool last = (t == nt - 2);
            const char* a1 = cA + (size_t)(t + 1) * kstep;
            const char* a2 = last ? nA : cA + (size_t)(t + 2) * kstep; const char* b2 = last ? nB : cB + (size_t)(t + 2) * kstep;
            const char* a3 = a2 + kstep; const char* b3 = b2 + kstep;
            unsigned vA2[2][2];
#pragma unroll
            for (int h = 0; h < 2; ++h)
#pragma unroll
                for (int i = 0; i < 2; ++i) vA2[h][i] = (GATHER && last) ? vAn[h][i] : vAc[h][i];
            PG8_LDB(B0, 0, 0); PG8_LDB(B1, 0, 1); PG8_SCHED; PG8_LDA(At, 0, 0); PG8_STAGE(PG8_SA(1, 1), a1, vAc[1]);
            PG8_WAIT_V(8); PG8_WAIT_L(0); PG8_BAR; PG8_MMA(0, 0, At, B0); PG8_MMA(0, 1, At, B1); PG8_BAR; PG8_SCHED;
            PG8_LDA(At, 0, 1); PG8_STAGE(PG8_SB(0, 0), b2, voffB); PG8_STAGE(PG8_SB(0, 1), b2 + hstep, voffB); PG8_STAGE(PG8_SA(0, 0), a2, vA2[0]);
            PG8_WAIT_V(8); PG8_WAIT_L(0); PG8_BAR; PG8_MMA(1, 0, At, B0); PG8_MMA(1, 1, At, B1); PG8_BAR; PG8_SCHED;
            PG8_LDB(B0, 1, 0); PG8_LDB(B1, 1, 1); PG8_SCHED; PG8_LDA(At, 1, 0); PG8_STAGE(PG8_SA(0, 1), a2, vA2[1]);
            PG8_WAIT_V(8); PG8_WAIT_L(0); PG8_BAR; PG8_MMA(0, 0, At, B0); PG8_MMA(0, 1, At, B1); PG8_BAR; PG8_SCHED;
            PG8_LDA(At, 1, 1); PG8_STAGE(PG8_SB(1, 0), b3, voffB); PG8_STAGE(PG8_SB(1, 1), b3 + hstep, voffB); PG8_STAGE(PG8_SA(1, 0), a3, vA2[0]);
            PG8_WAIT_V(8); PG8_WAIT_L(0); PG8_BAR; PG8_MMA(1, 0, At, B0); PG8_MMA(1, 1, At, B1); PG8_BAR; PG8_SCHED;
        }
        if constexpr (ALIGN_EPI) { if (wr == 0) PG8_BAR; }
        E(acc, cur, wr, wc, fr, fq);
        if (!has_next) break;
#pragma unroll
        for (int a = 0; a < 2; ++a)
#pragma unroll
            for (int b = 0; b < 2; ++b)
#pragma unroll
                for (int m = 0; m < 4; ++m)
#pragma unroll
                    for (int n = 0; n < 2; ++n) acc[a][b][m][n] = (f32x4){0.f, 0.f, 0.f, 0.f};
        cur = nxt; cA = nA; cB = nB; ++ui;
        if (GATHER) {
#pragma unroll
            for (int h = 0; h < 2; ++h)
#pragma unroll
                for (int i = 0; i < 2; ++i) vAc[h][i] = vAn[h][i]; }
        if constexpr (ALIGN_EPI) { if (wr == 1) PG8_BAR; }
    }
    PG8_WAIT_V(0);
    if constexpr (!ALIGN_EPI) { if (wr == 0) PG8_BAR; }
    PG8_BAR;
#undef PG8_SA
#undef PG8_SB
#undef PG8_STAGE
#undef PG8_LDA
#undef PG8_LDB
#undef PG8_MMA
#undef PG8_WAIT_V
#undef PG8_WAIT_L
#undef PG8_BAR
#undef PG8_SCHED
#undef PG8_VOFF
}

typedef const f32x4 (&AccT)[2][2][4][2];

struct EpiUV {
    static constexpr bool PERM = true;
    bf16* O; const float* bias; const float* ss; float* vstat;
    __device__ __forceinline__ void operator()(AccT acc, const Unit& u, int wr, int wc, int fr, int fq) const {
        const int col0 = u.pn * BM + wc * 32 + 8 * fq; const bool isv = u.pn >= 12;
        f32x4 bv[2][2]; f32x4 sv[2][4]; float rr[2][4];
#pragma unroll
        for (int ai = 0; ai < 2; ++ai)
#pragma unroll
            for (int m = 0; m < 4; ++m) sv[ai][m] = *(const f32x4*)(ss + (size_t)(u.r0 + ai * HALF + wr * 64 + m * 16 + fr) * 16 + 4 * fq);
#pragma unroll
        for (int bj = 0; bj < 2; ++bj)
#pragma unroll
            for (int n = 0; n < 2; ++n) bv[bj][n] = *(const f32x4*)(bias + col0 + bj * HALF + 4 * n);
#pragma unroll
        for (int ai = 0; ai < 2; ++ai)
#pragma unroll
            for (int m = 0; m < 4; ++m) { float q = (sv[ai][m].x + sv[ai][m].y) + (sv[ai][m].z + sv[ai][m].w); q += __shfl_xor(q, 16); q += __shfl_xor(q, 32); rr[ai][m] = __builtin_amdgcn_rsqf(q * (1.0f / D) + EPS); }
        asm volatile("" ::: "memory");
#pragma unroll
        for (int ai = 0; ai < 2; ++ai)
#pragma unroll
            for (int m = 0; m < 4; ++m) {
                const int row = u.r0 + ai * HALF + wr * 64 + m * 16 + fr;
                const float r = rr[ai][m];
                bf16* rowp = O + (size_t)row * GF + col0; f32x2 s1 = (f32x2){0.f, 0.f}, s2 = (f32x2){0.f, 0.f};
#pragma unroll
                for (int bj = 0; bj < 2; ++bj) {
                    const f32x4 v0 = acc[ai][bj][m][0] * r + bv[bj][0], v1 = acc[ai][bj][m][1] * r + bv[bj][1];
                    const f32x2 a = gelu_tanh2((f32x2){v0[0], v0[1]}), b = gelu_tanh2((f32x2){v0[2], v0[3]}), c = gelu_tanh2((f32x2){v1[0], v1[1]}), d = gelu_tanh2((f32x2){v1[2], v1[3]});
                    if (isv) { s1 += (a + b) + (c + d); s2 += (a * a + b * b) + (c * c + d * d); }
                    v4u w; w.x = cvt_pk_bf16(a.x, a.y); w.y = cvt_pk_bf16(b.x, b.y); w.z = cvt_pk_bf16(c.x, c.y); w.w = cvt_pk_bf16(d.x, d.y);
                    *(v4u*)(rowp + bj * HALF) = w; }
                if (isv) { float t1 = s1.x + s1.y, t2 = s2.x + s2.y; t1 += __shfl_xor(t1, 16); t1 += __shfl_xor(t1, 32); t2 += __shfl_xor(t2, 16); t2 += __shfl_xor(t2, 32);
                    if (fq == 0) *(f32x2*)(vstat + ((size_t)row * 48 + (u.pn - 12) * 4 + wc) * 2) = (f32x2){t1, t2}; }
            }
    }
};

template <bool F32IN> struct EpiRes {
    static constexpr bool PERM = false;
    const void* base; bf16* xb; const float* bias; float* ssout;
    __device__ __forceinline__ void operator()(AccT acc, const Unit& u, int wr, int wc, int fr, int fq) const {
        const int col0 = u.pn * BM + wc * 32 + 4 * fq;
        f32x4 bv[2][2];
#pragma unroll
        for (int bj = 0; bj < 2; ++bj)
#pragma unroll
            for (int n = 0; n < 2; ++n) bv[bj][n] = bias ? *(const f32x4*)(bias + col0 + bj * HALF + n * 16) : (f32x4){0.f, 0.f, 0.f, 0.f};
#pragma unroll
        for (int ai = 0; ai < 2; ++ai) {
            f32x4 xv[4][2][2];
#pragma unroll
            for (int m = 0; m < 4; ++m) { const size_t off = (size_t)(u.r0 + ai * HALF + wr * 64 + m * 16 + fr) * D + col0;
#pragma unroll
                for (int bj = 0; bj < 2; ++bj)
#pragma unroll
                    for (int n = 0; n < 2; ++n) {
                        if (F32IN) xv[m][bj][n] = *(const f32x4*)((const float*)base + off + bj * HALF + n * 16);
                        else { const v2u w = *(const v2u*)((const bf16*)base + off + bj * HALF + n * 16); xv[m][bj][n] = (f32x4){bf_lo(w.x), bf_hi(w.x), bf_lo(w.y), bf_hi(w.y)}; } } }
            asm volatile("" ::: "memory");
#pragma unroll
            for (int m = 0; m < 4; ++m) {
                const int row = u.r0 + ai * HALF + wr * 64 + m * 16 + fr; const size_t off = (size_t)row * D + col0; float s2 = 0.f;
#pragma unroll
                for (int bj = 0; bj < 2; ++bj)
#pragma unroll
                    for (int n = 0; n < 2; ++n) {
                        const f32x4 v = xv[m][bj][n] + acc[ai][bj][m][n] + bv[bj][n];
                        s2 += (v[0] * v[0] + v[1] * v[1]) + (v[2] * v[2] + v[3] * v[3]);
                        v2u w; w.x = cvt_pk_bf16(v[0], v[1]); w.y = cvt_pk_bf16(v[2], v[3]); *(v2u*)(xb + off + bj * HALF + n * 16) = w; }
                if (ssout) { s2 += __shfl_xor(s2, 16); s2 += __shfl_xor(s2, 32); if (fq == 0) ssout[(size_t)row * 16 + u.pn * 4 + wc] = s2; }
            }
            asm volatile("" ::: "memory");
        }
    }
};

template <bool MOE> struct EpiHid {
    static constexpr bool PERM = true;
    bf16* O; int ldh; const float* ss; const float* r4; const int* toklist;
    __device__ __forceinline__ void operator()(AccT acc, const Unit& u, int wr, int wc, int fr, int fq) const {
        const int col0 = u.pn * HALF + wc * 32 + 8 * fq;
        float rr[2][4];
        if (MOE) {
            int tk[2][4];
#pragma unroll
            for (int ai = 0; ai < 2; ++ai)
#pragma unroll
                for (int m = 0; m < 4; ++m) { const int tr = ai * HALF + wr * 64 + m * 16 + fr; tk[ai][m] = toklist[u.e * M + (tr < u.cnt ? u.pm * BM + tr : 0)]; }
#pragma unroll
            for (int ai = 0; ai < 2; ++ai)
#pragma unroll
                for (int m = 0; m < 4; ++m) rr[ai][m] = r4[tk[ai][m]];
        } else {
            f32x4 sv[2][4];
#pragma unroll
            for (int ai = 0; ai < 2; ++ai)
#pragma unroll
                for (int m = 0; m < 4; ++m) sv[ai][m] = *(const f32x4*)(ss + (size_t)(u.r0 + ai * HALF + wr * 64 + m * 16 + fr) * 16 + 4 * fq);
#pragma unroll
            for (int ai = 0; ai < 2; ++ai)
#pragma unroll
                for (int m = 0; m < 4; ++m) { float q = (sv[ai][m].x + sv[ai][m].y) + (sv[ai][m].z + sv[ai][m].w); q += __shfl_xor(q, 16); q += __shfl_xor(q, 32); rr[ai][m] = __builtin_amdgcn_rsqf(q * (1.0f / D) + EPS); }
        }
        asm volatile("" ::: "memory");
#pragma unroll
        for (int ai = 0; ai < 2; ++ai)
#pragma unroll
            for (int m = 0; m < 4; ++m) {
                const int tr = ai * HALF + wr * 64 + m * 16 + fr; const int row = u.r0 + tr; const float r = rr[ai][m]; const bool valid = MOE ? (tr < u.cnt) : true;
                const float rn = -LOG2E * r, r2 = r * r;
                const f32x4 ga = acc[ai][0][m][0], gb = acc[ai][0][m][1], ua = acc[ai][1][m][0], ub = acc[ai][1][m][1];
                const f32x2 o0 = ((f32x2){ga[0], ga[1]} * (f32x2){ua[0], ua[1]}) * r2 * sigm2((f32x2){ga[0], ga[1]} * rn), o1 = ((f32x2){ga[2], ga[3]} * (f32x2){ua[2], ua[3]}) * r2 * sigm2((f32x2){ga[2], ga[3]} * rn);
                const f32x2 o2 = ((f32x2){gb[0], gb[1]} * (f32x2){ub[0], ub[1]}) * r2 * sigm2((f32x2){gb[0], gb[1]} * rn), o3 = ((f32x2){gb[2], gb[3]} * (f32x2){ub[2], ub[3]}) * r2 * sigm2((f32x2){gb[2], gb[3]} * rn);
                v4u w; w.x = cvt_pk_bf16(o0.x, o0.y); w.y = cvt_pk_bf16(o1.x, o1.y); w.z = cvt_pk_bf16(o2.x, o2.y); w.w = cvt_pk_bf16(o3.x, o3.y);
                if (valid) *(v4u*)(O + (size_t)row * ldh + col0) = w;
            }
    }
};

struct EpiNull {
    static constexpr bool PERM = true;
    __device__ __forceinline__ void operator()(AccT acc, const Unit& u, int wr, int wc, int fr, int fq) const {
#pragma unroll
        for (int ai = 0; ai < 2; ++ai)
#pragma unroll
            for (int bj = 0; bj < 2; ++bj)
#pragma unroll
                for (int m = 0; m < 4; ++m)
#pragma unroll
                    for (int n = 0; n < 2; ++n) asm volatile("" :: "v"(acc[ai][bj][m][n]));
    }
};

template <bool MOE> struct EpiBf {
    static constexpr bool PERM = true;
    bf16* O; int ldc; const float* slotw;
    __device__ __forceinline__ void operator()(AccT acc, const Unit& u, int wr, int wc, int fr, int fq) const {
        const int col0 = u.pn * BM + wc * 32 + 8 * fq;
        float scv[2][4];
#pragma unroll
        for (int ai = 0; ai < 2; ++ai)
#pragma unroll
            for (int m = 0; m < 4; ++m) { const int tr = ai * HALF + wr * 64 + m * 16 + fr; scv[ai][m] = MOE ? slotw[u.e * M + (tr < u.cnt ? u.pm * BM + tr : 0)] : 1.f; }
        asm volatile("" ::: "memory");
#pragma unroll
        for (int ai = 0; ai < 2; ++ai)
#pragma unroll
            for (int m = 0; m < 4; ++m) {
                const int tr = ai * HALF + wr * 64 + m * 16 + fr; const int row = u.r0 + tr; const float sc = scv[ai][m]; const bool valid = MOE ? (tr < u.cnt) : true;
                bf16* rowp = O + (size_t)row * ldc + col0;
#pragma unroll
                for (int bj = 0; bj < 2; ++bj) { const f32x4 v0 = acc[ai][bj][m][0] * sc, v1 = acc[ai][bj][m][1] * sc;
                    v4u w; w.x = cvt_pk_bf16(v0[0], v0[1]); w.y = cvt_pk_bf16(v0[2], v0[3]); w.z = cvt_pk_bf16(v1[0], v1[1]); w.w = cvt_pk_bf16(v1[2], v1[3]);
                    if (valid) *(v4u*)(rowp + bj * HALF) = w; }
            }
    }
};

struct EpiBfTail {
    static constexpr bool PERM = true;
    bf16* O; const float* slotw; int tail_row0;
    __device__ __forceinline__ void operator()(AccT acc, const Unit& u, int wr, int wc, int fr, int fq) const {
        const int col0 = u.pn * BM + wc * 32 + 8 * fq;
        float scv[2][4];
#pragma unroll
        for (int ai = 0; ai < 2; ++ai)
#pragma unroll
            for (int m = 0; m < 4; ++m) { const int tr = ai * HALF + wr * 64 + m * 16 + fr; scv[ai][m] = slotw[u.e * M + (tr < u.cnt ? u.pm * BM + tr : 0)]; }
        asm volatile("" ::: "memory");
#pragma unroll
        for (int ai = 0; ai < 2; ++ai)
#pragma unroll
            for (int m = 0; m < 4; ++m) {
                const int tr = ai * HALF + wr * 64 + m * 16 + fr; const int row = u.ks * 2048 + (u.r0 + tr - tail_row0); const float sc = scv[ai][m]; const bool valid = tr < u.cnt;
                bf16* rowp = O + (size_t)row * D + col0;
#pragma unroll
                for (int bj = 0; bj < 2; ++bj) { const f32x4 v0 = acc[ai][bj][m][0] * sc, v1 = acc[ai][bj][m][1] * sc;
                    v4u w; w.x = cvt_pk_bf16(v0[0], v0[1]); w.y = cvt_pk_bf16(v0[2], v0[3]); w.z = cvt_pk_bf16(v1[0], v1[1]); w.w = cvt_pk_bf16(v1[2], v1[3]);
                    if (valid) *(v4u*)(rowp + bj * HALF) = w; }
            }
    }
};

struct EpiPle {
    static constexpr bool PERM = false;
    const bf16* xin; const bf16* proj; const float* ss; bf16* xout; float* ssout;
    __device__ __forceinline__ void operator()(AccT acc, const Unit& u, int wr, int wc, int fr, int fq) const {
        const int col0 = u.pn * BM + wc * 32 + 4 * fq;
#pragma unroll
        for (int ai = 0; ai < 2; ++ai)
#pragma unroll
        for (int mh = 0; mh < 2; ++mh) {
            v2u xv[2][2][2], pv[2][2][2]; f32x4 sv[2];
#pragma unroll
            for (int mm = 0; mm < 2; ++mm) { const int row = u.r0 + ai * HALF + wr * 64 + (2 * mh + mm) * 16 + fr; const size_t off = (size_t)row * D + col0;
                sv[mm] = *(const f32x4*)(ss + (size_t)row * 16 + 4 * fq);
#pragma unroll
                for (int bj = 0; bj < 2; ++bj)
#pragma unroll
                    for (int n = 0; n < 2; ++n) { xv[mm][bj][n] = *(const v2u*)(xin + off + bj * HALF + n * 16); pv[mm][bj][n] = *(const v2u*)(proj + off + bj * HALF + n * 16); } }
            asm volatile("" ::: "memory");
#pragma unroll
            for (int mm = 0; mm < 2; ++mm) {
                const int m = 2 * mh + mm;
                const int row = u.r0 + ai * HALF + wr * 64 + m * 16 + fr; const size_t off = (size_t)row * D + col0; float s2 = 0.f;
                float sq = (sv[mm].x + sv[mm].y) + (sv[mm].z + sv[mm].w); sq += __shfl_xor(sq, 16); sq += __shfl_xor(sq, 32);
                const float rn = -LOG2E * __builtin_amdgcn_rsqf(sq * (1.0f / D) + EPS);
#pragma unroll
                for (int bj = 0; bj < 2; ++bj)
#pragma unroll
                    for (int n = 0; n < 2; ++n) {
                        const size_t o = off + bj * HALF + n * 16;
                        const v2u pw = pv[mm][bj][n], xw = xv[mm][bj][n]; const f32x4 a = acc[ai][bj][m][n] * rn;
                        const f32x2 g01 = sigm2((f32x2){a[0], a[1]}), g23 = sigm2((f32x2){a[2], a[3]});
                        f32x4 v; v[0] = bf_lo(xw.x) + bf_lo(pw.x) * g01.x; v[1] = bf_hi(xw.x) + bf_hi(pw.x) * g01.y; v[2] = bf_lo(xw.y) + bf_lo(pw.y) * g23.x; v[3] = bf_hi(xw.y) + bf_hi(pw.y) * g23.y;
                        s2 += (v[0] * v[0] + v[1] * v[1]) + (v[2] * v[2] + v[3] * v[3]);
                        v2u w; w.x = cvt_pk_bf16(v[0], v[1]); w.y = cvt_pk_bf16(v[2], v[3]); *(v2u*)(xout + o) = w; }
                if (ssout) { s2 += __shfl_xor(s2, 16); s2 += __shfl_xor(s2, 32); if (fq == 0) ssout[(size_t)row * 16 + u.pn * 4 + wc] = s2; }
            }
            asm volatile("" ::: "memory");
        }
    }
};

struct EpiQKV {
    static constexpr bool PERM = false;
    bf16* Q; bf16* Kb; bf16* Vb; const float* bq; const float* bkv; const float* ss; const f32x2* rope;
    __device__ __forceinline__ void operator()(AccT acc, const Unit& u, int wr, int wc, int fr, int fq) const {
        const int dlo = 16 * (wc & 1) + 4 * fq;
        const int kind = u.pn < 4 ? 0 : (u.pn == 4 ? 1 : 2);
        f32x4 bv[2][2];
#pragma unroll
        for (int bj = 0; bj < 2; ++bj) {
            const int hcol = 64 * (2 * bj + (wc >> 1)) + dlo;
            const float* bp = kind == 0 ? bq + u.pn * BM + hcol : bkv + (kind - 1) * BM + hcol;
            bv[bj][0] = *(const f32x4*)bp; bv[bj][1] = *(const f32x4*)(bp + 32); }
#pragma unroll
        for (int ai = 0; ai < 2; ++ai) {
            f32x4 sv[4], c01[4], c23[4];
#pragma unroll
            for (int m = 0; m < 4; ++m) { const int row = u.r0 + ai * HALF + wr * 64 + m * 16 + fr; sv[m] = *(const f32x4*)(ss + (size_t)row * 16 + 4 * fq);
                const f32x2* rp = rope + (size_t)(row & (SEQ - 1)) * 32 + dlo; c01[m] = *(const f32x4*)rp; c23[m] = *(const f32x4*)(rp + 2); }
            asm volatile("" ::: "memory");
#pragma unroll
            for (int m = 0; m < 4; ++m) {
                const int row = u.r0 + ai * HALF + wr * 64 + m * 16 + fr;
                float q = (sv[m].x + sv[m].y) + (sv[m].z + sv[m].w); q += __shfl_xor(q, 16); q += __shfl_xor(q, 32); const float r = __builtin_amdgcn_rsqf(q * (1.0f / D) + EPS);
                const f32x4 cs01 = c01[m], cs23 = c23[m];
                const float cc[4] = {cs01[0], cs01[2], cs23[0], cs23[2]}, sn[4] = {cs01[1], cs01[3], cs23[1], cs23[3]};
#pragma unroll
                for (int bj = 0; bj < 2; ++bj) {
                    const int hcol = 64 * (2 * bj + (wc >> 1)) + dlo;
                    f32x4 lo = acc[ai][bj][m][0] * r + bv[bj][0], hi = acc[ai][bj][m][1] * r + bv[bj][1];
                    if (kind < 2) {
#pragma unroll
                        for (int j = 0; j < 4; ++j) { const float a = lo[j], b = hi[j]; lo[j] = a * cc[j] - b * sn[j]; hi[j] = b * cc[j] + a * sn[j]; }
                    }
                    if (kind == 0) { lo = lo * QSCALE; hi = hi * QSCALE; }
                    v2u wl, wh; wl.x = cvt_pk_bf16(lo[0], lo[1]); wl.y = cvt_pk_bf16(lo[2], lo[3]); wh.x = cvt_pk_bf16(hi[0], hi[1]); wh.y = cvt_pk_bf16(hi[2], hi[3]);
                    bf16* dst = kind == 0 ? Q + (size_t)row * D + u.pn * BM + hcol : (kind == 1 ? Kb : Vb) + (size_t)row * 256 + hcol;
                    *(v2u*)dst = wl; *(v2u*)(dst + 32) = wh; }
            }
            asm volatile("" ::: "memory");
        }
    }
};
}

struct Args { const float* in[31]; float* out; unsigned char* ws; int ph_lo, ph_hi, li, pad; };

struct Frame {
    LAS unsigned char* lds; volatile LAS unsigned* MISC; unsigned* ctl; unsigned char* ws;
    int tid, lane, wave, G, bid;
};

__device__ __forceinline__ int dest_row(int mode, int off, int n) {
    if (mode == 1) return ((n >> 7) << 8) + (n & 127) + off;
    if (mode == 2) return ((n & ~48) | ((n & 16) << 1) | ((n & 32) >> 1)) + off;
    return n + off;
}
__device__ __forceinline__ void p0_transpose_item(const float* W, int K, int N, const float* gain, bf16* WT, int mode, int off, int item, int lane, LAS unsigned char* scr) {
    const int nblk = N / 64, kb = item / nblk, nb = item % nblk, k0 = 128 * kb, n0 = 64 * nb;
    const float* src = W + (size_t)k0 * N + n0 + lane;
    float v[96], w[32];
#pragma unroll
    for (int i = 0; i < 96; ++i) v[i] = src[(size_t)i * N];
    int g0 = 0x3f800000, g1 = 0x3f800000;
    if (gain) { g0 = __float_as_int(gain[k0 + lane]); g1 = __float_as_int(gain[k0 + 64 + lane]); }
    LAS unsigned char* myrow = scr + lane * 272;
#define P0_G(i) __int_as_float(__builtin_amdgcn_readlane((i) < 64 ? g0 : g1, (i) & 63))
#define P0_CVT(arr, base, c) do { v4u o; o.x = cvt_pk_bf16(arr[8 * (c) - (base)] * P0_G(8 * (c)), arr[8 * (c) + 1 - (base)] * P0_G(8 * (c) + 1)); o.y = cvt_pk_bf16(arr[8 * (c) + 2 - (base)] * P0_G(8 * (c) + 2), arr[8 * (c) + 3 - (base)] * P0_G(8 * (c) + 3)); \
        o.z = cvt_pk_bf16(arr[8 * (c) + 4 - (base)] * P0_G(8 * (c) + 4), arr[8 * (c) + 5 - (base)] * P0_G(8 * (c) + 5)); o.w = cvt_pk_bf16(arr[8 * (c) + 6 - (base)] * P0_G(8 * (c) + 6), arr[8 * (c) + 7 - (base)] * P0_G(8 * (c) + 7)); *(LAS v4u*)(myrow + 16 * (c)) = o; } while (0)
#pragma unroll
    for (int c = 0; c < 4; ++c) P0_CVT(v, 0, c);
    asm volatile("" ::: "memory");
#pragma unroll
    for (int i = 0; i < 32; ++i) w[i] = src[(size_t)(96 + i) * N];
    asm volatile("" ::: "memory");
#pragma unroll
    for (int c = 4; c < 12; ++c) P0_CVT(v, 0, c);
#pragma unroll
    for (int c = 12; c < 16; ++c) P0_CVT(w, 96, c);
#undef P0_CVT
#undef P0_G
    LDS_WAIT(); asm volatile("" ::: "memory");
    const int c16 = lane & 15, rq = lane >> 4;
#pragma unroll
    for (int j = 0; j < 16; ++j) { const int n = 4 * j + rq; const v4u o = *(const LAS v4u*)(scr + n * 272 + 16 * c16);
        *(v4u*)(WT + (size_t)dest_row(mode, off, n0 + n) * K + k0 + 8 * c16) = o; }
    LDS_WAIT(); asm volatile("" ::: "memory");
}

#define IN_(k) ((const float*)args.in[k])

__global__ void __launch_bounds__(NWAVES * 64, 2) fwd_kernel(Args args) {
    extern __shared__ __attribute__((aligned(16))) unsigned char lds_raw[];
    Frame F;
    F.lds = (LAS unsigned char*)lds_raw;
    F.MISC = (volatile LAS unsigned*)(F.lds + MISC_OFF);
    F.tid = threadIdx.x; F.lane = F.tid & 63; F.wave = __builtin_amdgcn_readfirstlane(F.tid >> 6);
    F.G = gridDim.x; F.bid = blockIdx.x;
    F.ws = args.ws; F.ctl = (unsigned*)(args.ws + WS_CTL);
    unsigned char* ws = args.ws;
    const int tid = F.tid, wave = F.wave, G = F.G, bid = F.bid;
    const int gw = bid * NWAVES + wave, NGW = G * NWAVES;

    for (int u = tid; u < 128; u += NWAVES * 64) ((LAS unsigned*)(F.lds + MISC_OFF))[u] = 0u;
    __syncthreads();
    constexpr bool ONE = (MK_N_LAUNCHES == 1);
    XcdBarrier bar; bar.bar = F.ctl + CW_BAR; bar.x = 0; bar.st = nullptr;
    if (ONE) bar = xcd_barrier_post(F.ctl + CW_BAR, F.MISC + 8);
#define GRID_BAR() do { if (ONE) xcd_barrier(bar); } while (0)
    const int lo = args.ph_lo, hi = args.ph_hi;
#define IN(k) (lo <= (k) && (k) < hi)
#if defined(PROBE_LO)
    unsigned long long probe_t0 = 0ull, probe_dt = 0ull;
#define PROBE_START(k) do { if ((k) == PROBE_LO) probe_t0 = __builtin_amdgcn_s_memrealtime(); } while (0)
#define PROBE_END(k) do { if ((k) == PROBE_HI) probe_dt = __builtin_amdgcn_s_memrealtime() - probe_t0; } while (0)
#else
#define PROBE_START(k) do {} while (0)
#define PROBE_END(k) do {} while (0)
#endif

    bf16* const Win_t = (bf16*)(ws + WS_WIN); bf16* const Wout_t = (bf16*)(ws + WS_WOUT); bf16* const Wgu_t = (bf16*)(ws + WS_WGU); bf16* const Wd_t = (bf16*)(ws + WS_WD);
    bf16* const Wpg0_t = (bf16*)(ws + WS_WPG0); bf16* const Wpp0_t = (bf16*)(ws + WS_WPP0); bf16* const Wpg1_t = (bf16*)(ws + WS_WPG1); bf16* const Wpp1_t = (bf16*)(ws + WS_WPP1);
    bf16* const Wqkv_t = (bf16*)(ws + WS_WQKV); bf16* const Wo_t = (bf16*)(ws + WS_WO); bf16* const MWgu_t = (bf16*)(ws + WS_MWGU); bf16* const MWd_t = (bf16*)(ws + WS_MWD);
    bf16* const XB0 = (bf16*)(ws + WS_XB0); bf16* const XB1 = (bf16*)(ws + WS_XB1); bf16* const PB = (bf16*)(ws + WS_PB);
    bf16* const UV = (bf16*)(ws + WS_UV); bf16* const HID = (bf16*)(ws + WS_HID); bf16* const PROJ = (bf16*)(ws + WS_PROJ);
    bf16* const Qb = (bf16*)(ws + WS_Q); bf16* const Kb = (bf16*)(ws + WS_K); bf16* const Vb = (bf16*)(ws + WS_V);
    bf16* const HIDM = (bf16*)(ws + WS_HIDM); bf16* const YS = (bf16*)(ws + WS_YS); bf16* const YSP = (bf16*)(ws + WS_YSP);
    float* const SS0 = (float*)(ws + WS_SS); float* const SS1 = SS0 + M * 16; float* const SS2 = SS1 + M * 16; float* const SS3 = SS2 + M * 16; float* const SS5 = SS3 + M * 16;
    float* const R4 = (float*)(ws + WS_R4); unsigned* const TOKSLOT = (unsigned*)(ws + WS_TOKSLOT); int* const TOKLIST = (int*)(ws + WS_TOKLIST); float* const SLOTW = (float*)(ws + WS_SLOTW);
    float* const WR = (float*)(ws + WS_WR); float* const VSTAT = (float*)(ws + WS_VSTAT); f32x2* const ROPE = (f32x2*)(ws + WS_ROPE);
    float* const X = args.out;
    unsigned* const GCNT = F.ctl + CW_CNT;

    if (IN(0)) {
        PROBE_START(0);
        const int lane = opaque_lane();
        LAS unsigned char* scr = F.lds + wave * 17408;
        constexpr int I_WIN = (D / 128) * (GF / 64), I_WOUT = (GH / 128) * (D / 64), I_FG = (D / 128) * (FFD / 64), I_FD = (FFD / 128) * (D / 64), I_PG = (D / 128) * (D / 64), I_PP = (PLE / 128) * (D / 64),
                      I_WQ = (D / 128) * (D / 64), I_WKV = (D / 128) * (512 / 64), I_WO = I_WQ, I_MG = (D / 128) * (FFE / 64), I_MD = (FFE / 128) * (D / 64);
        constexpr int NITEMS = I_WIN + I_WOUT + 2 * I_FG + I_FD + 2 * I_PG + 2 * I_PP + I_WQ + I_WKV + I_WO + NE * (2 * I_MG + I_MD);
        for (int it = gw; it < NITEMS; it += NGW) {
            int r = it;
            if (r < I_WIN) { p0_transpose_item(IN_(4), D, GF, IN_(2), Win_t, 0, 0, r, lane, scr); continue; } r -= I_WIN;
            if (r < I_WOUT) { p0_transpose_item(IN_(10), GH, D, nullptr, Wout_t, 0, 0, r, lane, scr); continue; } r -= I_WOUT;
            if (r < I_FG) { p0_transpose_item(IN_(20), D, FFD, IN_(3), Wgu_t, 1, 0, r, lane, scr); continue; } r -= I_FG;
            if (r < I_FG) { p0_transpose_item(IN_(21), D, FFD, IN_(3), Wgu_t, 1, 128, r, lane, scr); continue; } r -= I_FG;
            if (r < I_FD) { p0_transpose_item(IN_(22), FFD, D, nullptr, Wd_t, 0, 0, r, lane, scr); continue; } r -= I_FD;
            if (r < I_PG) { p0_transpose_item(IN_(29), D, D, IN_(28), Wpg0_t, 0, 0, r, lane, scr); continue; } r -= I_PG;
            if (r < I_PG) { p0_transpose_item(IN_(29) + D * D, D, D, IN_(28) + D, Wpg1_t, 0, 0, r, lane, scr); continue; } r -= I_PG;
            if (r < I_PP) { p0_transpose_item(IN_(27), PLE, D, nullptr, Wpp0_t, 0, 0, r, lane, scr); continue; } r -= I_PP;
            if (r < I_PP) { p0_transpose_item(IN_(27) + PLE * D, PLE, D, nullptr, Wpp1_t, 0, 0, r, lane, scr); continue; } r -= I_PP;
            if (r < I_WQ) { p0_transpose_item(IN_(15), D, D, IN_(2) + D, Wqkv_t, 2, 0, r, lane, scr); continue; } r -= I_WQ;
            if (r < I_WKV) { p0_transpose_item(IN_(13), D, 512, IN_(12), Wqkv_t, 2, 1024, r, lane, scr); continue; } r -= I_WKV;
            if (r < I_WO) { p0_transpose_item(IN_(18), D, D, nullptr, Wo_t, 0, 0, r, lane, scr); continue; } r -= I_WO;
            { constexpr int PER_E = 2 * I_MG + I_MD; const int e = r / PER_E; int q = r % PER_E;
              if (q < I_MG) { p0_transpose_item(IN_(24) + (size_t)e * D * FFE, D, FFE, IN_(3) + D, MWgu_t + (size_t)e * 7168 * D, 1, 0, q, lane, scr); continue; } q -= I_MG;
              if (q < I_MG) { p0_transpose_item(IN_(25) + (size_t)e * D * FFE, D, FFE, IN_(3) + D, MWgu_t + (size_t)e * 7168 * D, 1, 128, q, lane, scr); continue; } q -= I_MG;
              p0_transpose_item(IN_(26) + (size_t)e * FFE * D, FFE, D, nullptr, MWd_t + (size_t)e * D * FFE, 0, 0, q, lane, scr); }
        }
        for (int m = 4 * gw; m < M; m += 4 * NGW) {
            const f32x4* xr = (const f32x4*)(IN_(0) + (size_t)m * D) + lane; f32x4 v[16]; float sq[4] = {0.f, 0.f, 0.f, 0.f};
#pragma unroll
            for (int j = 0; j < 16; ++j) v[j] = xr[64 * j];
#pragma unroll
            for (int j = 0; j < 16; ++j) sq[j >> 2] += (v[j].x * v[j].x + v[j].y * v[j].y) + (v[j].z * v[j].z + v[j].w * v[j].w);
#pragma unroll
            for (int q = 0; q < 4; ++q) sq[q] = wave_sum(sq[q]);
            v2u* o8 = (v2u*)(XB0 + (size_t)m * D) + lane;
#pragma unroll
            for (int j = 0; j < 16; ++j) { v2u w; w.x = cvt_pk_bf16(v[j].x, v[j].y); w.y = cvt_pk_bf16(v[j].z, v[j].w); o8[64 * j] = w; }
            SS0[(size_t)m * 16 + lane] = lane == 0 ? sq[0] : (lane == 16 ? sq[1] : (lane == 32 ? sq[2] : (lane == 48 ? sq[3] : 0.f)));
        }
        for (int i = bid * (NWAVES * 64) + tid; i < 2 * M * PLE / 8; i += 4 * G * NWAVES * 64) {
            f32x4 a[4], b[4];
#pragma unroll
            for (int q = 0; q < 4; ++q) { const int ii = i + q * G * NWAVES * 64; if (ii < 2 * M * PLE / 8) { a[q] = ((const f32x4*)IN_(1))[2 * ii]; b[q] = ((const f32x4*)IN_(1))[2 * ii + 1]; } }
#pragma unroll
            for (int q = 0; q < 4; ++q) { const int ii = i + q * G * NWAVES * 64; if (ii < 2 * M * PLE / 8) {
                v4u w; w.x = cvt_pk_bf16(a[q].x, a[q].y); w.y = cvt_pk_bf16(a[q].z, a[q].w); w.z = cvt_pk_bf16(b[q].x, b[q].y); w.w = cvt_pk_bf16(b[q].z, b[q].w);
                ((v4u*)PB)[ii] = w; } }
        }
        for (int i = bid * (NWAVES * 64) + tid; i < SEQ * 32; i += G * NWAVES * 64) {
            const int pos = i >> 5, fi = i & 31;
            const float freq = exp2f(-(float)fi * (13.287712379549449f / 32.0f));
            const float ang = (float)pos * freq;
            const double rev = (double)ang * 0.15915494309189535; const double fr_ = rev - __builtin_rint(rev);
            const float xr = (float)fr_;
            ROPE[i] = (f32x2){__builtin_amdgcn_cosf(xr), __builtin_amdgcn_sinf(xr)};
        }
        for (int i = bid * (NWAVES * 64) + tid; i < NE * D; i += G * NWAVES * 64) { const int e = i >> 10, k = i & 1023; WR[i] = IN_(3)[D + k] * IN_(23)[k * NE + e]; }
        GRID_BAR();
        PROBE_END(0);
    }

    if (IN(1)) {
        PROBE_START(1);
        pg8::StaticOrder S; S.init(M, GF, D, D, G, bid, XB0, Win_t);
        pg8::EpiUV E{UV, IN_(5), SS0, VSTAT};
        pg8::gemm_phase<pg8::EpiUV, pg8::StaticOrder, true, false>(F.lds, D, S, E);
        GRID_BAR();
        PROBE_END(1);
    }

    if (IN(2)) {
        PROBE_START(2);
        const int lane = opaque_lane();
        constexpr int WSTR = 136;
        LAS bf16* WSL = (LAS bf16*)(F.lds);
        LAS bf16* VT = (LAS bf16*)(F.lds + 128 * WSTR * 2);
        LAS f32x2* STAT = (LAS f32x2*)(F.lds + 128 * WSTR * 2 + 192 * WSTR * 2);
        const float* lng = IN_(6); const float* lnb = IN_(7); const float* wsrc = IN_(8); const float* bsrc = IN_(9);
        for (int id = bid; id < 2048; id += G) {
            const int hf = id & 1, g = (id >> 1) & 7, c = id >> 4; const int row0 = 128 * c, ch0 = GD * g + 192 * hf;
            if (tid < 128) {
                const f32x4* vp = (const f32x4*)(VSTAT + (size_t)(row0 + tid) * 96); float s1 = 0.f, s2 = 0.f;
#pragma unroll 4
                for (int j = 0; j < 24; ++j) { const f32x4 q = vp[j]; s1 += q.x + q.z; s2 += q.y + q.w; }
                const float mean = s1 * (1.0f / GH); float var = s2 * (1.0f / GH) - mean * mean; var = var < 0.f ? 0.f : var;
                STAT[tid] = (f32x2){mean, __builtin_amdgcn_rsqf(var + EPS)};
            }
            for (int idx = tid; idx < 2048; idx += NWAVES * 64) {
                const int t = idx >> 4, s0 = (idx & 15) * 8; const f32x4* wp = (const f32x4*)(wsrc + ((size_t)g * 128 + t) * 128 + s0);
                const f32x4 a = wp[0], b = wp[1]; float w8[8] = {a.x, a.y, a.z, a.w, b.x, b.y, b.z, b.w};
#pragma unroll
                for (int j = 0; j < 8; ++j) w8[j] = (s0 + j <= t) ? w8[j] : 0.f;
                v4u o; o.x = cvt_pk_bf16(w8[0], w8[1]); o.y = cvt_pk_bf16(w8[2], w8[3]); o.z = cvt_pk_bf16(w8[4], w8[5]); o.w = cvt_pk_bf16(w8[6], w8[7]);
                *(LAS v4u*)(WSL + t * WSTR + s0) = o;
            }
            __syncthreads();
            for (int idx = tid; idx < 128 * 24; idx += NWAVES * 64) {
                const int s = idx & 127, cg = idx >> 7; const int ch = ch0 + 8 * cg;
                const v4u raw = *(const v4u*)(UV + (size_t)(row0 + s) * GF + GH + ch);
                const f32x2 st = STAT[s];
                const f32x4 g0 = *(const f32x4*)(lng + ch), g1 = *(const f32x4*)(lng + ch + 4), b0 = *(const f32x4*)(lnb + ch), b1 = *(const f32x4*)(lnb + ch + 4);
                float v8[8] = {bf_lo(raw.x), bf_hi(raw.x), bf_lo(raw.y), bf_hi(raw.y), bf_lo(raw.z), bf_hi(raw.z), bf_lo(raw.w), bf_hi(raw.w)};
                const float gg[8] = {g0.x, g0.y, g0.z, g0.w, g1.x, g1.y, g1.z, g1.w}, bb[8] = {b0.x, b0.y, b0.z, b0.w, b1.x, b1.y, b1.z, b1.w};
#pragma unroll
                for (int j = 0; j < 8; j += 2) {
                    const float y0 = (v8[j] - st.x) * st.y * gg[j] + bb[j], y1 = (v8[j + 1] - st.x) * st.y * gg[j + 1] + bb[j + 1];
                    const unsigned w = cvt_pk_bf16(y0, y1);
                    VT[(8 * cg + j) * WSTR + s] = (bf16)(w & 0xffffu); VT[(8 * cg + j + 1) * WSTR + s] = (bf16)(w >> 16); }
            }
            __syncthreads();
            {
                const int tl = lane & 15, kg = lane >> 4; const int t = 16 * wave + tl; const int nks = (wave + 2) >> 1;
                f32x4 acc[12];
#pragma unroll
                for (int cb = 0; cb < 12; ++cb) acc[cb] = (f32x4){0.f, 0.f, 0.f, 0.f};
                for (int ks = 0; ks < nks; ++ks) {
                    const bf16x8 wf = *(const LAS bf16x8*)(WSL + t * WSTR + 32 * ks + 8 * kg);
#pragma unroll
                    for (int cb = 0; cb < 12; ++cb) { const bf16x8 vf = *(const LAS bf16x8*)(VT + (16 * cb + tl) * WSTR + 32 * ks + 8 * kg);
                        acc[cb] = __builtin_amdgcn_mfma_f32_16x16x32_bf16(vf, wf, acc[cb], 0, 0, 0); }
                }
                const float bsv = bsrc[g * 128 + t];
                bf16* up = UV + (size_t)(row0 + t) * GF + ch0 + 4 * kg;
#pragma unroll
                for (int cb = 0; cb < 12; ++cb) { const v2u uw = *(const v2u*)(up + 16 * cb);
                    const float o0 = bf_lo(uw.x) * (acc[cb][0] + bsv), o1 = bf_hi(uw.x) * (acc[cb][1] + bsv), o2 = bf_lo(uw.y) * (acc[cb][2] + bsv), o3 = bf_hi(uw.y) * (acc[cb][3] + bsv);
                    v2u w; w.x = cvt_pk_bf16(o0, o1); w.y = cvt_pk_bf16(o2, o3); *(v2u*)(up + 16 * cb) = w; }
            }
            __syncthreads();
        }
        GRID_BAR();
        PROBE_END(2);
    }

    if (IN(3)) {
        PROBE_START(3);
        pg8::StaticOrder S; S.init(M, D, GH, GF, G, bid, UV, Wout_t);
        pg8::EpiRes<true> E{IN_(0), XB0, IN_(11), SS1};
        pg8::gemm_phase<pg8::EpiRes<true>, pg8::StaticOrder, false, false>(F.lds, GH, S, E);
        GRID_BAR();
        PROBE_END(3);
    }

    if (IN(4)) {
        PROBE_START(4);
        pg8::StaticOrder S; S.init(M, 2 * FFD, D, D, G, bid, XB0, Wgu_t);
        pg8::EpiHid<false> E{HID, FFD, SS1, nullptr, nullptr};
#if defined(PROBE_DUMMY4)
        { pg8::EpiNull EN; pg8::gemm_phase<pg8::EpiNull, pg8::StaticOrder, true, false>(F.lds, D, S, EN); }
#else
        pg8::gemm_phase<pg8::EpiHid<false>, pg8::StaticOrder, true, false>(F.lds, D, S, E);
#endif
        GRID_BAR();
        PROBE_END(4);
#if defined(PROBE_DUMMY4)
        pg8::gemm_phase<pg8::EpiHid<false>, pg8::StaticOrder, true, false>(F.lds, D, S, E);
        GRID_BAR();
#endif
    }

    if (IN(5)) {
        PROBE_START(5);
        { pg8::StaticOrder S; S.init(M, D, FFD, FFD, G, bid, HID, Wd_t);
          pg8::EpiRes<false> E{XB0, XB0, nullptr, SS2};
          pg8::gemm_phase<pg8::EpiRes<false>, pg8::StaticOrder, false, false>(F.lds, FFD, S, E); }
        { pg8::StaticOrder S; S.init(M, D, PLE, PLE, G, bid, PB, Wpp0_t);
          pg8::EpiBf<false> E{PROJ, D, nullptr};
          pg8::gemm_phase<pg8::EpiBf<false>, pg8::StaticOrder, false, false>(F.lds, PLE, S, E); }
        GRID_BAR();
        PROBE_END(5);
    }

    if (IN(6)) {
        PROBE_START(6);
        pg8::StaticOrder S; S.init(M, D, D, D, G, bid, XB0, Wpg0_t);
        pg8::EpiPle E{XB0, PROJ, SS2, XB1, SS3};
        pg8::gemm_phase<pg8::EpiPle, pg8::StaticOrder, false, false>(F.lds, D, S, E);
        GRID_BAR();
        PROBE_END(6);
    }

    if (IN(7)) {
        PROBE_START(7);
        pg8::StaticOrder S; S.init(M, NQKV, D, D, G, bid, XB1, Wqkv_t);
        pg8::EpiQKV E{Qb, Kb, Vb, IN_(16), IN_(14), SS3, ROPE};
        pg8::gemm_phase<pg8::EpiQKV, pg8::StaticOrder, true, false>(F.lds, D, S, E);
        GRID_BAR();
        PROBE_END(7);
    }

    if (IN(8)) {
        PROBE_START(8);
        const int lane = opaque_lane();
        constexpr int KSTR = 72, VSTR = 264;
        LAS bf16* KL = (LAS bf16*)(F.lds);
        LAS bf16* VT = (LAS bf16*)(F.lds + 256 * KSTR * 2);
        const float* sinks = IN_(17);
        for (int id = bid; id < 512; id += G) {
            const int qb = id & 31, g = (id >> 5) & 3, b = id >> 7;
            const long tok0 = (long)b * SEQ + 128 * qb - 128;
            for (int idx = tid; idx < 2048; idx += NWAVES * 64) {
                const int kj = idx >> 3, c = idx & 7; const bool valid = (qb > 0) || (kj >= 128);
                v4u val = (v4u){0u, 0u, 0u, 0u};
                if (valid) val = *(const v4u*)(Kb + (size_t)(tok0 + kj) * 256 + 64 * g + 8 * c);
                *(LAS v4u*)(KL + kj * KSTR + 8 * c) = val;
            }
            for (int idx = tid; idx < 2048; idx += NWAVES * 64) {
                const int kj = idx & 255, c = idx >> 8; const bool valid = (qb > 0) || (kj >= 128);
                v4u raw = (v4u){0u, 0u, 0u, 0u};
                if (valid) raw = *(const v4u*)(Vb + (size_t)(tok0 + kj) * 256 + 64 * g + 8 * c);
                LAS bf16* vp = VT + (8 * c) * VSTR + kj;
                vp[0 * VSTR] = (bf16)(raw.x & 0xffffu); vp[1 * VSTR] = (bf16)(raw.x >> 16); vp[2 * VSTR] = (bf16)(raw.y & 0xffffu); vp[3 * VSTR] = (bf16)(raw.y >> 16);
                vp[4 * VSTR] = (bf16)(raw.z & 0xffffu); vp[5 * VSTR] = (bf16)(raw.z >> 16); vp[6 * VSTR] = (bf16)(raw.w & 0xffffu); vp[7 * VSTR] = (bf16)(raw.w >> 16);
            }
            __syncthreads();
            const int ql = lane & 15, kg = lane >> 4, i = wave;
            for (int it = 0; it < 4; ++it) {
                const int head = 4 * g + it; const size_t qrow = (size_t)b * SEQ + 128 * qb + 16 * i + ql;
                bf16* qp = Qb + qrow * D + 64 * head;
                const bf16x8 qf0 = *(const bf16x8*)(qp + 8 * kg), qf1 = *(const bf16x8*)(qp + 32 + 8 * kg);
                f32x4 sc[9];
#pragma unroll
                for (int jb = 0; jb < 9; ++jb) {
                    const LAS bf16* kp = KL + (16 * (i + jb) + ql) * KSTR + 8 * kg;
                    const bf16x8 a0 = *(const LAS bf16x8*)kp, a1 = *(const LAS bf16x8*)(kp + 32);
                    sc[jb] = __builtin_amdgcn_mfma_f32_16x16x32_bf16(a0, qf0, (f32x4){0.f, 0.f, 0.f, 0.f}, 0, 0, 0);
                    sc[jb] = __builtin_amdgcn_mfma_f32_16x16x32_bf16(a1, qf1, sc[jb], 0, 0, 0);
                }
                const int qi = 16 * i + ql; const float sink = sinks[head] * LOG2E; float mx = sink;
#pragma unroll
                for (int jb = 0; jb < 9; ++jb)
#pragma unroll
                    for (int r = 0; r < 4; ++r) { const int kj = 16 * (i + jb) + 4 * kg + r; const bool valid = (kj > qi) && (kj <= qi + 128) && ((qb > 0) || (kj >= 128));
                        sc[jb][r] = valid ? sc[jb][r] : -INFINITY; mx = fmaxf(mx, sc[jb][r]); }
                mx = fmaxf(mx, __shfl_xor(mx, 16)); mx = fmaxf(mx, __shfl_xor(mx, 32));
                float sum = 0.f;
#pragma unroll
                for (int jb = 0; jb < 9; ++jb)
#pragma unroll
                    for (int r = 0; r < 4; ++r) { const float p = fast_exp2(sc[jb][r] - mx); sc[jb][r] = p; sum += p; }
                sum += __shfl_xor(sum, 16); sum += __shfl_xor(sum, 32);
                const float inv = fast_rcp(sum + fast_exp2(sink - mx));
                f32x4 o[4];
#pragma unroll
                for (int db = 0; db < 4; ++db) o[db] = (f32x4){0.f, 0.f, 0.f, 0.f};
#pragma unroll
                for (int pp = 0; pp < 5; ++pp) {
                    v4u pw; pw.x = cvt_pk_bf16(sc[2 * pp][0], sc[2 * pp][1]); pw.y = cvt_pk_bf16(sc[2 * pp][2], sc[2 * pp][3]);
                    if (pp < 4) { pw.z = cvt_pk_bf16(sc[2 * pp + 1 < 9 ? 2 * pp + 1 : 8][0], sc[2 * pp + 1 < 9 ? 2 * pp + 1 : 8][1]); pw.w = cvt_pk_bf16(sc[2 * pp + 1 < 9 ? 2 * pp + 1 : 8][2], sc[2 * pp + 1 < 9 ? 2 * pp + 1 : 8][3]); }
                    else { pw.z = 0u; pw.w = 0u; }
                    const bf16x8 pf = __builtin_bit_cast(bf16x8, pw);
#pragma unroll
                    for (int db = 0; db < 4; ++db) {
                        const LAS bf16* vp = VT + (16 * db + ql) * VSTR + 16 * (i + 2 * pp) + 4 * kg;
                        v4u vw; const v2u l2 = *(const LAS v2u*)vp; vw.x = l2.x; vw.y = l2.y;
                        if (pp < 4) { const v2u h2 = *(const LAS v2u*)(vp + 16); vw.z = h2.x; vw.w = h2.y; } else { vw.z = 0u; vw.w = 0u; }
                        o[db] = __builtin_amdgcn_mfma_f32_16x16x32_bf16(__builtin_bit_cast(bf16x8, vw), pf, o[db], 0, 0, 0);
                    }
                }
#pragma unroll
                for (int db = 0; db < 4; ++db) { v2u w; w.x = cvt_pk_bf16(o[db][0] * inv, o[db][1] * inv); w.y = cvt_pk_bf16(o[db][2] * inv, o[db][3] * inv);
                    *(v2u*)(qp + 16 * db + 4 * kg) = w; }
            }
            __syncthreads();
        }
        GRID_BAR();
        PROBE_END(8);
    }

    if (IN(9)) {
        PROBE_START(9);
        pg8::StaticOrder S; S.init(M, D, D, D, G, bid, Qb, Wo_t);
        pg8::EpiRes<false> E{XB1, XB1, IN_(19), nullptr};
        pg8::gemm_phase<pg8::EpiRes<false>, pg8::StaticOrder, false, false>(F.lds, D, S, E);
        GRID_BAR();
        PROBE_END(9);
    }

    if (IN(10)) {
        PROBE_START(10);
        const int lane = opaque_lane();
        LAS float* WRL = (LAS float*)(F.lds);
        LAS int* lcnt = (LAS int*)(F.lds + 32768);
        LAS unsigned* rec = (LAS unsigned*)(F.lds + 32768 + 64);
        for (int i = tid; i < NE * D / 4; i += NWAVES * 64) ((LAS f32x4*)WRL)[i] = ((const f32x4*)WR)[i];
        for (int chunk = bid; chunk < M / 64; chunk += G) {
            if (tid < 8) lcnt[tid] = 0;
            __syncthreads();
            v4u xw[8][2];
#pragma unroll
            for (int k = 0; k < 8; ++k) { const v4u* xr = (const v4u*)(XB1 + (size_t)(chunk * 64 + wave * 8 + k) * D) + lane; xw[k][0] = xr[0]; xw[k][1] = xr[64]; }
            asm volatile("" ::: "memory");
#pragma unroll
            for (int k = 0; k < 8; ++k) {
                const int tl = wave * 8 + k, tok = chunk * 64 + tl;
                f32x4 v[4]; float s = 0.f;
#pragma unroll
                for (int j = 0; j < 2; ++j) { const v4u w = xw[k][j]; v[2 * j] = (f32x4){bf_lo(w.x), bf_hi(w.x), bf_lo(w.y), bf_hi(w.y)}; v[2 * j + 1] = (f32x4){bf_lo(w.z), bf_hi(w.z), bf_lo(w.w), bf_hi(w.w)}; }
#pragma unroll
                for (int j = 0; j < 4; ++j) s += (v[j].x * v[j].x + v[j].y * v[j].y) + (v[j].z * v[j].z + v[j].w * v[j].w);
                float dot[8];
#pragma unroll
                for (int e = 0; e < 8; ++e) { float d = 0.f;
#pragma unroll
                    for (int j = 0; j < 4; ++j) { const f32x4 w = ((const LAS f32x4*)(WRL + e * D))[2 * lane + 128 * (j >> 1) + (j & 1)]; d += (v[j].x * w.x + v[j].y * w.y) + (v[j].z * w.z + v[j].w * w.w); }
                    dot[e] = d; }
                s = wave_sum(s);
#pragma unroll
                for (int e = 0; e < 8; ++e) dot[e] = wave_sum(dot[e]);
                const float r = __builtin_amdgcn_rsqf(s * (1.0f / D) + EPS);
                int e0 = 0; float v0 = dot[0] * r;
#pragma unroll
                for (int e = 1; e < 8; ++e) { const float l = dot[e] * r; if (l > v0) { v0 = l; e0 = e; } }
                int e1 = -1; float v1 = -INFINITY;
#pragma unroll
                for (int e = 0; e < 8; ++e) { const float l = dot[e] * r; if (e != e0 && l > v1) { v1 = l; e1 = e; } }
                const float w1 = fast_rcp(1.0f + fast_exp2((v0 - v1) * LOG2E)), w0 = 1.0f - w1;
                if (lane == 0) {
                    const int p0 = __hip_atomic_fetch_add(&lcnt[e0], 1, __ATOMIC_RELAXED, __HIP_MEMORY_SCOPE_WORKGROUP);
                    const int p1 = __hip_atomic_fetch_add(&lcnt[e1], 1, __ATOMIC_RELAXED, __HIP_MEMORY_SCOPE_WORKGROUP);
                    LAS unsigned* rp = rec + tl * 6; rp[0] = (unsigned)e0; rp[1] = (unsigned)e1; rp[2] = (unsigned)p0; rp[3] = (unsigned)p1; rp[4] = __float_as_uint(w0); rp[5] = __float_as_uint(w1);
                    R4[tok] = r;
                }
            }
            __syncthreads();
            if (tid < 8) lcnt[8 + tid] = (int)__hip_atomic_fetch_add(GCNT + 64 * tid, (unsigned)lcnt[tid], __ATOMIC_RELAXED, __HIP_MEMORY_SCOPE_AGENT);
            __syncthreads();
            if (tid < 64) {
                const int tok = chunk * 64 + tid; const LAS unsigned* rp = rec + tid * 6;
                const int e0 = (int)rp[0], e1 = (int)rp[1]; const int q0 = lcnt[8 + e0] + (int)rp[2], q1 = lcnt[8 + e1] + (int)rp[3];
                TOKLIST[e0 * M + q0] = tok; TOKLIST[e1 * M + q1] = tok; SLOTW[e0 * M + q0] = __uint_as_float(rp[4]); SLOTW[e1 * M + q1] = __uint_as_float(rp[5]);
                TOKSLOT[2 * tok] = ((unsigned)e0 << 16) | (unsigned)q0; TOKSLOT[2 * tok + 1] = ((unsigned)e1 << 16) | (unsigned)q1;
            }
            __syncthreads();
        }
        GRID_BAR();
        PROBE_END(10);
    }

    LAS int* const etab = (LAS int*)(F.lds + MISC_OFF) + 32;
    if (IN(11) || IN(12) || IN(13)) {
        if (tid == 0) { int ts = 0, off = 0;
            for (int e = 0; e < 8; ++e) { const int cn = (int)__hip_atomic_load(GCNT + 64 * e, __ATOMIC_RELAXED, __HIP_MEMORY_SCOPE_AGENT); etab[e] = ts; etab[9 + e] = off; etab[18 + e] = cn; ts += (cn + 255) >> 8; off += cn; }
            etab[8] = ts; etab[17] = off;
            int tr0 = 1 << 30;
            for (int e = 0; e < 8; ++e) if (128 >= etab[e] && 128 < etab[e + 1]) tr0 = etab[9 + e] + 256 * (128 - etab[e]);
            etab[26] = tr0; }
        __syncthreads();
    }

    if (IN(11)) {
        PROBE_START(11);
        LAS unsigned* toktab = (LAS unsigned*)(F.lds + TOKTAB_OFF);
        pg8::MoeOrder S{etab, toktab, FFE / 128, G, bid, etab[8] * (FFE / 128), D, D, (const char*)XB1, (const char*)MWgu_t, (size_t)D * 2, (size_t)2 * FFE * D * 2, (size_t)256 * D * 2, 0, 1};
        { pg8::Unit u; for (int ui = 0; ui < 16 && S.next(ui, u); ++ui) { if (tid < 256) { const int tok = TOKLIST[u.e * M + (tid < u.cnt ? u.pm * 256 + tid : 0)]; toktab[ui * 256 + tid] = (unsigned)tok * (unsigned)(D * 2); } } }
        __syncthreads();
        pg8::EpiHid<true> E{HIDM, FFE, nullptr, R4, TOKLIST};
#if defined(PROBE_DUMMY)
        { pg8::EpiNull EN; pg8::gemm_phase<pg8::EpiNull, pg8::MoeOrder, true, true>(F.lds, D, S, EN); }
#else
        pg8::gemm_phase<pg8::EpiHid<true>, pg8::MoeOrder, true, true>(F.lds, D, S, E);
#endif
        GRID_BAR();
        PROBE_END(11);
#if defined(PROBE_DUMMY)
        pg8::gemm_phase<pg8::EpiHid<true>, pg8::MoeOrder, true, true>(F.lds, D, S, E);
        GRID_BAR();
#endif
    }

    if (IN(12)) {
        PROBE_START(12);
        const int TM = etab[8], FULL = TM < 128 ? TM : 128, T = TM - FULL;
        { pg8::MoeOrder S{etab, nullptr, D / 256, G, bid, FULL * (D / 256), FFE, FFE, (const char*)HIDM, (const char*)MWd_t, (size_t)FFE * 2, (size_t)D * FFE * 2, (size_t)256 * FFE * 2, 0, 1};
          pg8::EpiBf<true> E{YS, D, SLOTW};
          pg8::gemm_phase<pg8::EpiBf<true>, pg8::MoeOrder, true, false>(F.lds, FFE, S, E); }
        if (T > 0) {
          pg8::MoeOrder S{etab, nullptr, D / 256, G, bid, T * (D / 256) * 7, FFE, FFE, (const char*)HIDM, (const char*)MWd_t, (size_t)FFE * 2, (size_t)D * FFE * 2, (size_t)256 * FFE * 2, FULL, 7};
          pg8::EpiBfTail E{YSP, SLOTW, etab[26]};
          pg8::gemm_phase<pg8::EpiBfTail, pg8::MoeOrder, false, false>(F.lds, 512, S, E); }
        GRID_BAR();
        PROBE_END(12);
    }

    if (IN(13)) {
        PROBE_START(13);
        const int lane = opaque_lane();
        const int tail0 = etab[26];
        for (int m0 = 2 * gw; m0 < M; m0 += 2 * NGW) {
            const uint4 sl = *(const uint4*)(TOKSLOT + 2 * m0);
            const unsigned sw[4] = {sl.x, sl.y, sl.z, sl.w};
            size_t rr[4];
#pragma unroll
            for (int k = 0; k < 4; ++k) rr[k] = (size_t)(etab[9 + (sw[k] >> 16)] + (int)(sw[k] & 0xffffu));
            f32x4 v[2][4]; v2u yw[4][4]; bool tl[4];
#pragma unroll
            for (int q = 0; q < 2; ++q) { const v2u* xr = (const v2u*)(XB1 + (size_t)(m0 + q) * D) + lane;
#pragma unroll
                for (int j = 0; j < 4; ++j) { const v2u xw = xr[64 * j]; v[q][j] = (f32x4){bf_lo(xw.x), bf_hi(xw.x), bf_lo(xw.y), bf_hi(xw.y)}; } }
#pragma unroll
            for (int k = 0; k < 4; ++k) { tl[k] = (long)rr[k] >= (long)tail0; const v2u* y = (const v2u*)(YS + (tl[k] ? 0 : rr[k]) * D) + lane;
#pragma unroll
                for (int j = 0; j < 4; ++j) yw[k][j] = y[64 * j]; }
#pragma unroll
            for (int k = 0; k < 4; ++k) {
                if (!tl[k]) {
#pragma unroll
                    for (int j = 0; j < 4; ++j) { const v2u a = yw[k][j]; v[k >> 1][j].x += bf_lo(a.x); v[k >> 1][j].y += bf_hi(a.x); v[k >> 1][j].z += bf_lo(a.y); v[k >> 1][j].w += bf_hi(a.y); }
                } else { for (int ks = 0; ks < 7; ++ks) { const v2u* y = (const v2u*)(YSP + ((size_t)ks * 2048 + (rr[k] - tail0)) * D) + lane;
#pragma unroll
                    for (int j = 0; j < 4; ++j) { const v2u a = y[64 * j]; v[k >> 1][j].x += bf_lo(a.x); v[k >> 1][j].y += bf_hi(a.x); v[k >> 1][j].z += bf_lo(a.y); v[k >> 1][j].w += bf_hi(a.y); } } }
            }
#pragma unroll
            for (int q = 0; q < 2; ++q) { v2u* o8 = (v2u*)(XB0 + (size_t)(m0 + q) * D) + lane; float s = 0.f;
#pragma unroll
                for (int j = 0; j < 4; ++j) { s += (v[q][j].x * v[q][j].x + v[q][j].y * v[q][j].y) + (v[q][j].z * v[q][j].z + v[q][j].w * v[q][j].w);
                    v2u w; w.x = cvt_pk_bf16(v[q][j].x, v[q][j].y); w.y = cvt_pk_bf16(v[q][j].z, v[q][j].w); o8[64 * j] = w; }
                s = wave_sum(s);
                if (lane < 16) SS5[(size_t)(m0 + q) * 16 + lane] = lane == 0 ? s : 0.f; }
        }
        VM_WAIT(); __syncthreads();
        { pg8::StaticOrder S; S.init(M, D, PLE, PLE, G, bid, PB + (size_t)M * PLE, Wpp1_t);
          pg8::EpiBf<false> E{PROJ, D, nullptr};
          pg8::gemm_phase<pg8::EpiBf<false>, pg8::StaticOrder, false, false>(F.lds, PLE, S, E); }
        GRID_BAR();
        PROBE_END(13);
    }

    if (IN(14)) {
        PROBE_START(14);
        pg8::StaticOrder S; S.init(M, D, D, D, G, bid, XB0, Wpg1_t);
        pg8::EpiPle E{XB0, PROJ, SS5, XB1, nullptr};
        pg8::gemm_phase<pg8::EpiPle, pg8::StaticOrder, false, false>(F.lds, D, S, E);
        GRID_BAR();
        PROBE_END(14);
    }

    if (IN(15)) {
        PROBE_START(15);
        const int lane = opaque_lane();
        const f32x4* gp = (const f32x4*)IN_(30) + lane;
        const f32x4 g0 = gp[0], g1 = gp[64], g2 = gp[128], g3 = gp[192];
        for (int m0 = 4 * gw; m0 < M; m0 += 4 * NGW) {
            v2u xw[4][4];
#pragma unroll
            for (int q = 0; q < 4; ++q) { const v2u* xr = (const v2u*)(XB1 + (size_t)(m0 + q) * D) + lane;
#pragma unroll
                for (int j = 0; j < 4; ++j) xw[q][j] = xr[64 * j]; }
#pragma unroll
            for (int q = 0; q < 4; ++q) {
                f32x4* orow = (f32x4*)(X + (size_t)(m0 + q) * D) + lane; f32x4 v[4]; float s = 0.f;
#pragma unroll
                for (int j = 0; j < 4; ++j) { const v2u w = xw[q][j]; v[j] = (f32x4){bf_lo(w.x), bf_hi(w.x), bf_lo(w.y), bf_hi(w.y)}; s += (v[j].x * v[j].x + v[j].y * v[j].y) + (v[j].z * v[j].z + v[j].w * v[j].w); }
                s = wave_sum(s); const float r = __builtin_amdgcn_rsqf(s * (1.0f / D) + EPS);
                orow[0] = v[0] * r * g0; orow[64] = v[1] * r * g1; orow[128] = v[2] * r * g2; orow[192] = v[3] * r * g3;
            }
        }
    }
#if defined(PROBE_LO)
    if (bid == 0) { const unsigned long long te = __builtin_amdgcn_s_memrealtime(); while (__builtin_amdgcn_s_memrealtime() - te < 8ull * probe_dt) __builtin_amdgcn_s_sleep(8); }
#endif
#undef IN
#undef GRID_BAR
}

constexpr int N_PHASES = 16;
extern "C" void kernel_launch(void* const* d_in, const int* in_sizes, int n_in, void* d_out, int out_size, void* d_ws, size_t ws_size, hipStream_t stream) {
    static int grid = 0;
    if (grid == 0) {
        if (n_in != 31 || out_size != M * D || ws_size < WS_END) { fprintf(stderr, "kernel_launch: unexpected shapes (n_in %d, out %d, ws %zu < %zu)\n", n_in, out_size, ws_size, (size_t)WS_END); grid = -1; return; }
        int dev = 0, cus = 0;
        if (hipGetDevice(&dev) != hipSuccess || hipDeviceGetAttribute(&cus, hipDeviceAttributeMultiprocessorCount, dev) != hipSuccess) { grid = -1; return; }
        if (hipFuncSetAttribute((const void*)fwd_kernel, hipFuncAttributeMaxDynamicSharedMemorySize, LDS_BYTES) != hipSuccess) { fprintf(stderr, "kernel_launch: hipFuncSetAttribute failed\n"); grid = -1; return; }
        int per_cu = 0;
        if (hipOccupancyMaxActiveBlocksPerMultiprocessor(&per_cu, (const void*)fwd_kernel, NWAVES * 64, LDS_BYTES) != hipSuccess || per_cu < 1) fprintf(stderr, "kernel_launch: occupancy query reports %d\n", per_cu);
        (void)hipGetLastError();
        grid = cus;
    }
    if (grid < 0) return;
    (void)in_sizes;
    if (hipMemsetAsync((char*)d_ws + WS_CTL, 0, CTL_ZERO_BYTES, stream) != hipSuccess) return;
    Args a{};
    for (int i = 0; i < 31; ++i) a.in[i] = (const float*)d_in[i];
    a.out = (float*)d_out; a.ws = (unsigned char*)d_ws;
    if (MK_N_LAUNCHES == 1) {
        a.ph_lo = 0; a.ph_hi = N_PHASES; a.li = 0;
        hipLaunchKernelGGL(fwd_kernel, dim3(grid), dim3(NWAVES * 64), LDS_BYTES, stream, a);
    } else {
        for (int li = 0; li < N_PHASES; ++li) { a.ph_lo = li; a.ph_hi = li + 1; a.li = li;
            hipLaunchKernelGGL(fwd_kernel, dim3(grid), dim3(NWAVES * 64), LDS_BYTES, stream, a); }
    }
}
```

```cpp
#include <hip/hip_runtime.h>
#include <cstdio>
#include <cstdint>

#ifndef MK_N_LAUNCHES
#define MK_N_LAUNCHES 1
#endif

#define GAS __attribute__((address_space(1)))
#define LAS __attribute__((address_space(3)))
typedef unsigned short bf16;
typedef unsigned v4u __attribute__((ext_vector_type(4)));
typedef unsigned v2u __attribute__((ext_vector_type(2)));
typedef float f32x4 __attribute__((ext_vector_type(4)));
typedef float f32x2 __attribute__((ext_vector_type(2)));
typedef short bf16x8 __attribute__((ext_vector_type(8)));
typedef short s16x4 __attribute__((ext_vector_type(4)));

constexpr int M = 16384, D = 1024, SEQ = 4096;
constexpr int GF = 6144, GH = 3072, GD = 384;
constexpr int FFD = 2816, NE = 8, FFE = 3584, PLE = 256;
constexpr int NQKV = 1536;
constexpr float EPS = 1e-6f;
constexpr float LOG2E = 1.4426950408889634f;
constexpr float QSCALE = 0.125f * LOG2E;

constexpr size_t MiB = 1u << 20;
constexpr size_t WS_CTL = 0, CTL_ZERO_BYTES = 1 * MiB;
constexpr size_t WS_SS = 1 * MiB;
constexpr size_t WS_R4 = 6 * MiB;
constexpr size_t WS_TOKSLOT = WS_R4 + 64 * 1024;
constexpr size_t WS_TOKLIST = WS_TOKSLOT + 128 * 1024;
constexpr size_t WS_SLOTW = WS_TOKLIST + 512 * 1024;
constexpr size_t WS_WR = WS_SLOTW + 512 * 1024;
constexpr size_t WS_VSTAT = 8 * MiB;
constexpr size_t WS_ROPE = 14 * MiB;
constexpr size_t WS_PB = 15 * MiB;
constexpr size_t WS_XB1 = 31 * MiB;
constexpr size_t WS_WPG1 = 63 * MiB;
constexpr size_t WS_WPP1 = 65 * MiB;
constexpr size_t WS_MWGU = 66 * MiB;
constexpr size_t WS_MWD = 178 * MiB;
constexpr size_t WS_B = 234 * MiB;
constexpr size_t WS_WIN = WS_B;
constexpr size_t WS_WOUT = WS_B + 12 * MiB;
constexpr size_t WS_WGU = WS_B + 18 * MiB;
constexpr size_t WS_WD = WS_B + 29 * MiB;
constexpr size_t WS_WPG0 = WS_B + 35 * MiB;
constexpr size_t WS_WPP0 = WS_B + 37 * MiB;
constexpr size_t WS_WQKV = WS_B + 38 * MiB;
constexpr size_t WS_WO = WS_B + 41 * MiB;
constexpr size_t WS_XB0 = WS_B + 43 * MiB;
constexpr size_t WS_UV = WS_B + 75 * MiB;
constexpr size_t WS_HID = WS_UV;
constexpr size_t WS_PROJ = WS_UV + 96 * MiB;
constexpr size_t WS_Q = WS_UV;
constexpr size_t WS_K = WS_UV + 32 * MiB;
constexpr size_t WS_V = WS_UV + 40 * MiB;
constexpr size_t WS_HIDM = WS_B;
constexpr size_t WS_YS = WS_MWGU;
constexpr size_t WS_YSP = WS_B + 226 * MiB;
constexpr size_t WS_END = WS_B + 267 * MiB;
static_assert(WS_HIDM + (size_t)(32768 + 256) * FFE * 2 <= WS_END, "hidm");
static_assert(WS_WR + 32768 <= WS_VSTAT, "misc");

constexpr int CW_TMO = 0, CW_BAR = 4096, CW_CNT = 8192;

constexpr int RING_BYTES = 131072;
constexpr int TOKTAB_OFF = RING_BYTES;
constexpr int MISC_OFF = RING_BYTES + 16384;
constexpr int LDS_BYTES = MISC_OFF + 512;
constexpr int NWAVES = 8;

#define RLX_AGENT __ATOMIC_RELAXED, __HIP_MEMORY_SCOPE_AGENT
#define LDS_WAIT() asm volatile("s_waitcnt lgkmcnt(0)" ::: "memory")
#define VM_WAIT() asm volatile("s_waitcnt vmcnt(0)" ::: "memory")
__device__ __forceinline__ unsigned cvt_pk_bf16(float lo, float hi) { unsigned r; asm volatile("v_cvt_pk_bf16_f32 %0, %1, %2" : "=v"(r) : "v"(lo), "v"(hi)); return r; }
__device__ __forceinline__ float bf_lo(unsigned w) { return __uint_as_float(w << 16); }
__device__ __forceinline__ float bf_hi(unsigned w) { return __uint_as_float(w & 0xffff0000u); }
__device__ __forceinline__ float fast_rcp(float x) { return __builtin_amdgcn_rcpf(x); }
__device__ __forceinline__ float fast_exp2(float x) { return __builtin_amdgcn_exp2f(x); }
__device__ __forceinline__ float sigmoid_f(float x) { return fast_rcp(1.0f + fast_exp2(-x * LOG2E)); }
__device__ __forceinline__ float gelu_tanh(float x) { const float u = 0.7978845608028654f * (x + 0.044715f * x * x * x); return x * fast_rcp(1.0f + fast_exp2(-2.0f * LOG2E * u)); }
__device__ __forceinline__ f32x2 gelu_tanh2(f32x2 x) {
    const f32x2 t = x * x; const f32x2 p = t * (-0.10294324f) + (-2.3022082f); const f32x2 z = x * p;
    f32x2 e; e.x = fast_exp2(z.x); e.y = fast_exp2(z.y); const f32x2 d = e + 1.0f;
    f32x2 r; r.x = fast_rcp(d.x); r.y = fast_rcp(d.y); return x * r;
}
__device__ __forceinline__ f32x2 sigm2(f32x2 y  ) { f32x2 e; e.x = fast_exp2(y.x); e.y = fast_exp2(y.y); const f32x2 d = e + 1.0f; f32x2 r; r.x = fast_rcp(d.x); r.y = fast_rcp(d.y); return r; }
__device__ __forceinline__ int opaque_lane() { int l; asm volatile("v_mbcnt_lo_u32_b32 %0, -1, 0\n\tv_mbcnt_hi_u32_b32 %0, -1, %0" : "=v"(l)); return l; }
__device__ __forceinline__ float wave_sum(float v) {
#pragma unroll
    for (int o = 1; o < 64; o <<= 1) v += __shfl_xor(v, o);
    return v;
}
__device__ __forceinline__ float row_rscale(const float* ss, int row, int fq) {
    const f32x4 v = *(const f32x4*)(ss + (size_t)row * 16 + 4 * fq);
    float s = (v.x + v.y) + (v.z + v.w);
    s += __shfl_xor(s, 16); s += __shfl_xor(s, 32);
    return __builtin_amdgcn_rsqf(s * (1.0f / D) + EPS);
}

#define XB_TMO      128
#define XB_XCNT(j)  (256  + 64 * (j))
#define XB_XSUB(j)  (1280 + 64 * (j))
#define XB_XGEN(j)  (2304 + 64 * (j))
#define XB_TOP      3328
#define XB_TOPGEN   3392
#define XCD_BAR_WORDS 3456
#define XB_SPIN_CAP (1u << 18)
__device__ __forceinline__ unsigned xb_ld(unsigned* p)              { return __hip_atomic_load(p, __ATOMIC_RELAXED, __HIP_MEMORY_SCOPE_AGENT); }
__device__ __forceinline__ unsigned xb_add(unsigned* p, unsigned v) { return __hip_atomic_fetch_add(p, v, __ATOMIC_RELAXED, __HIP_MEMORY_SCOPE_AGENT); }
__device__ __forceinline__ unsigned xb_xcc_id() { return (unsigned)__builtin_amdgcn_s_getreg((3 << 11) | 20) & 0xFu; }
#define XB_SPIN(cond, bar) do { unsigned _sp = 0; while (cond) { __builtin_amdgcn_s_sleep(1); \
    if ((++_sp & 255u) == 0u) { if (xb_ld(&(bar)[XB_TMO])) break; if (_sp > XB_SPIN_CAP) { atomicAdd(&(bar)[XB_TMO], 1u); break; } } } } while (0)
struct XcdBarrier { unsigned* bar; unsigned x; volatile LAS unsigned* st; };
__device__ __forceinline__ XcdBarrier xcd_barrier_post(unsigned* bar, volatile LAS unsigned* st, bool leader  ) {
    XcdBarrier b; b.bar = bar; b.x = xb_xcc_id(); b.st = st;
    if (leader) (void)xb_add(&bar[XB_XCNT(b.x)], 1u);
    return b;
}
__device__ __forceinline__ void xcd_barrier_complete(unsigned* bar, unsigned x, unsigned& nloc, unsigned& nx) {
    const unsigned G = gridDim.x * gridDim.y * gridDim.z;
    unsigned sum, cnt, mine, sp = 0u;
    for (;;) {
        sum = 0u; cnt = 0u; mine = 0u;
#pragma unroll
        for (unsigned j = 0; j < 16; ++j) { const unsigned c = xb_ld(&bar[XB_XCNT(j)]); sum += c; cnt += (c > 0u) ? 1u : 0u; mine = (j == x) ? c : mine; }
        if (sum == G) break;
        __builtin_amdgcn_s_sleep(1);
        if ((++sp & 255u) == 0u) { if (xb_ld(&bar[XB_TMO])) break; if (sp > XB_SPIN_CAP) { atomicAdd(&bar[XB_TMO], 1u); break; } }
    }
    nloc = mine > 0u ? mine : 1u; nx = cnt > 0u ? cnt : 1u;
}
__device__ __forceinline__ void xcd_barrier(const XcdBarrier& b, bool leader  ) {
    asm volatile("s_waitcnt vmcnt(0)" ::: "memory");
    __syncthreads();
    if (leader) {
        unsigned* bar = b.bar;
        __builtin_amdgcn_s_waitcnt(0);
        unsigned nloc = b.st[0], nx = b.st[1];
        if (nloc == 0u) { xcd_barrier_complete(bar, b.x, nloc, nx); b.st[0] = nloc; b.st[1] = nx; }
        const unsigned old = xb_add(&bar[XB_XSUB(b.x)], 1u);
        const unsigned gen = old / nloc;
        if (old + 1u == (gen + 1u) * nloc) {
            __builtin_amdgcn_fence(__ATOMIC_RELEASE, "agent");
            asm volatile("s_waitcnt vmcnt(0)" ::: "memory");
            const unsigned og = xb_add(&bar[XB_TOP], 1u);
            const unsigned tg = og / nx;
            if (og + 1u == (tg + 1u) * nx) xb_add(&bar[XB_TOPGEN], 1u);
            else XB_SPIN(xb_ld(&bar[XB_TOPGEN]) == tg, bar);
            __builtin_amdgcn_fence(__ATOMIC_ACQUIRE, "agent");
            xb_add(&bar[XB_XGEN(b.x)], 1u);
            asm volatile("s_waitcnt vmcnt(0)" ::: "memory");
        } else {
            XB_SPIN(xb_ld(&bar[XB_XGEN(b.x)]) == gen, bar);
            __builtin_amdgcn_fence(__ATOMIC_ACQUIRE, "agent");
            asm volatile("s_waitcnt vmcnt(0)" ::: "memory");
        }
    }
    __syncthreads();
}

namespace pg8 {
constexpr int BM = 256, BK = 64, HALF = 128, HTB = HALF * BK * 2, STAGE_BYTES = 8 * HTB, NXCD = 8, WGM = 8;
__host__ __device__ __forceinline__ int lds_byte(int r, int c) { const int st = (r >> 4) * 2 + (c >> 5), rr = r & 15, cc = c & 31, ob = rr * 64 + cc * 2; return st * 1024 + (ob ^ (((ob >> 9) & 1) << 5)); }
__host__ __device__ __forceinline__ void stage_rc(int b, int& R, int& C) { const int st = b / 1024, sb = b % 1024, swz = sb ^ (((sb >> 9) & 1) << 5); R = (st >> 1) * 16 + swz / 64; C = (st & 1) * 32 + (swz % 64) / 2; }
__host__ __device__ __forceinline__ int perm32(int rho) { const int n = rho >> 4, i = rho & 15; return 8 * (i >> 2) + 4 * n + (i & 3); }

struct Unit { int pm, pn, e, r0, cnt, ks; };

struct StaticOrder {
    int nM, nN, nwg, G, c, lda, ldb; const char* A; const char* Bt; size_t tstepA, tstepB;
    __device__ __forceinline__ void init(int M_, int N_, int K_, int lda_, int G_, int c_, const bf16* A_, const bf16* Bt_) { nM = M_ / BM; nN = N_ / BM; nwg = nM * nN; G = G_; c = c_; lda = lda_; ldb = K_; A = (const char*)A_; Bt = (const char*)Bt_; tstepA = (size_t)BM * lda_ * 2; tstepB = (size_t)BM * K_ * 2; }
    __device__ __forceinline__ bool next(int i, Unit& u) const {
        const long L = (long)i * G + c; if (L >= nwg) return false;
        int wgid = (int)L; { const int q = nwg / NXCD, r = nwg % NXCD, xcd = wgid % NXCD, off = wgid / NXCD; wgid = (xcd < r ? xcd * (q + 1) : r * (q + 1) + (xcd - r) * q) + off; }
        const int nig = WGM * nN, gid = wgid / nig, fm = gid * WGM, gsz = (nM - fm) < WGM ? (nM - fm) : WGM;
        u.pm = fm + ((wgid % nig) % gsz); u.pn = (wgid % nig) / gsz; u.e = 0; u.r0 = u.pm * BM; u.cnt = BM; u.ks = 0; return true;
    }
    __device__ __forceinline__ const char* a_base(const Unit& u) const { return A + (size_t)u.pm * tstepA; }
    __device__ __forceinline__ const char* b_base(const Unit& u) const { return Bt + (size_t)u.pn * tstepB; }
    __device__ __forceinline__ unsigned a_off(int, int) const { return 0u; }
};

struct MoeOrder {
    const LAS int* tab; const LAS unsigned* toktab; int NT, G, c, total, lda, ldb; const char* A; const char* Bt; size_t a_row_bytes, b_exp_bytes, b_tile_bytes;
    int mt0, nks;
    __device__ __forceinline__ bool next(int i, Unit& u) const {
        const long L = (long)i * G + c; if (L >= total) return false;
        const int ks = (int)(L % nks); const long L2 = L / nks;
        const int mtg = mt0 + (int)(L2 / NT), pn = (int)(L2 % NT);
        int e = 0;
#pragma unroll
        for (int j = 1; j < 8; ++j) e += (mtg >= __builtin_amdgcn_readfirstlane(tab[j])) ? 1 : 0;
        const int ts = __builtin_amdgcn_readfirstlane(tab[e]), off = __builtin_amdgcn_readfirstlane(tab[9 + e]), cn = __builtin_amdgcn_readfirstlane(tab[18 + e]);
        u.e = e; u.pm = mtg - ts; u.pn = pn; u.r0 = off + BM * u.pm; const int rem = cn - BM * u.pm; u.cnt = rem < BM ? rem : BM; u.ks = ks; return true;
    }
    __device__ __forceinline__ const char* a_base(const Unit& u) const { return toktab ? A : A + (size_t)u.r0 * a_row_bytes + (size_t)u.ks * 1024; }
    __device__ __forceinline__ const char* b_base(const Unit& u) const { return Bt + (size_t)u.e * b_exp_bytes + (size_t)u.pn * b_tile_bytes + (size_t)u.ks * 1024; }
    __device__ __forceinline__ unsigned a_off(int ui, int R) const { return toktab[(ui & 15) * 256 + R]; }
};

template <class Epi, class Sched, bool ALIGN_EPI, bool GATHER>
__device__ __forceinline__ void gemm_phase(LAS unsigned char* lds, const int K, const Sched& S, const Epi& E, const int wid  ) {
    const int lane = opaque_lane(), tid = wid * 64 + lane, wr = wid >> 2, wc = wid & 3, fr = lane & 15, fq = lane >> 4;
    const int nt = K / BK;
    unsigned voffB[2], vAc[2][2], vAn[2][2]; int Rr[2], Cb[2];
    const size_t kstep = (size_t)(BK * 2);
    const size_t hstep = (size_t)HALF * S.ldb * 2;
#pragma unroll
    for (int i = 0; i < 2; ++i) { int R, C; stage_rc(tid * 16 + i * 8192, R, C); const int Rb = Epi::PERM ? ((R & ~31) + perm32(R & 31)) : R;
        Rr[i] = R; Cb[i] = C * 2; voffB[i] = (unsigned)(Rb * S.ldb + C) * 2u; }
    const unsigned ldsw = (unsigned)wid * 1024u;
    const int aoff = lds_byte(wr * 64 + fr, fq * 8), boff = lds_byte(wc * 32 + fr, fq * 8);
#define PG8_SA(b, h) (((b) * 2 + (h)) * HTB)
#define PG8_SB(b, h) ((4 + (b) * 2 + (h)) * HTB)
#define PG8_STAGE(bufoff, gbase, voff) do { _Pragma("unroll") for (int _i = 0; _i < 2; ++_i) \
        __builtin_amdgcn_global_load_lds((const unsigned*)((const char*)(gbase) + (voff)[_i]), (LAS unsigned*)(lds + (bufoff) + ldsw + _i * 8192), 16, 0, 0); } while (0)
#define PG8_LDA(dst, b, h) do { _Pragma("unroll") for (int m = 0; m < 4; ++m) _Pragma("unroll") for (int k = 0; k < 2; ++k) dst[m][k] = *(const LAS bf16x8*)(lds + PG8_SA(b, h) + aoff + m * 2048 + k * 1024); } while (0)
#define PG8_LDB(dst, b, h) do { _Pragma("unroll") for (int n = 0; n < 2; ++n) _Pragma("unroll") for (int k = 0; k < 2; ++k) dst[n][k] = *(const LAS bf16x8*)(lds + PG8_SB(b, h) + boff + n * 2048 + k * 1024); } while (0)
#define PG8_MMA(ai, bj, At, Bt) do { __builtin_amdgcn_s_setprio(1); _Pragma("unroll") for (int m = 0; m < 4; ++m) _Pragma("unroll") for (int n = 0; n < 2; ++n) _Pragma("unroll") for (int k = 0; k < 2; ++k) \
        acc[ai][bj][m][n] = __builtin_amdgcn_mfma_f32_16x16x32_bf16(Bt[n][k], At[m][k], acc[ai][bj][m][n], 0, 0, 0); __builtin_amdgcn_s_setprio(0); } while (0)
#define PG8_WAIT_V(n) asm volatile("s_waitcnt vmcnt(" #n ")" ::: "memory")
#define PG8_WAIT_L(n) asm volatile("s_waitcnt lgkmcnt(" #n ")" ::: "memory")
#define PG8_BAR __builtin_amdgcn_s_barrier()
#define PG8_SCHED __builtin_amdgcn_sched_barrier(0)
#define PG8_VOFF(dst, ui_) do { _Pragma("unroll") for (int _h = 0; _h < 2; ++_h) _Pragma("unroll") for (int _i = 0; _i < 2; ++_i) \
        dst[_h][_i] = GATHER ? (S.a_off((ui_), Rr[_i] + _h * HALF) + (unsigned)Cb[_i]) : (unsigned)((Rr[_i] + _h * HALF) * S.lda * 2 + Cb[_i]); } while (0)
    Unit cur, nxt; int ui = 0;
    if (!S.next(0, cur)) return;
    f32x4 acc[2][2][4][2];
#pragma unroll
    for (int a = 0; a < 2; ++a)
#pragma unroll
        for (int b = 0; b < 2; ++b)
#pragma unroll
            for (int m = 0; m < 4; ++m)
#pragma unroll
                for (int n = 0; n < 2; ++n) acc[a][b][m][n] = (f32x4){0.f, 0.f, 0.f, 0.f};
    bf16x8 At[4][2], B0[2][2], B1[2][2];
    const char* cA = S.a_base(cur); const char* cB = S.b_base(cur);
    PG8_VOFF(vAc, 0);
    PG8_STAGE(PG8_SB(0, 0), cB, voffB); PG8_STAGE(PG8_SB(0, 1), cB + hstep, voffB); PG8_STAGE(PG8_SA(0, 0), cA, vAc[0]); PG8_STAGE(PG8_SA(0, 1), cA, vAc[1]);
    if (wr == 1) PG8_BAR;
    PG8_WAIT_V(2); PG8_BAR;
    PG8_STAGE(PG8_SB(1, 0), cB + kstep, voffB); PG8_STAGE(PG8_SA(1, 0), cA + kstep, vAc[0]); PG8_STAGE(PG8_SB(1, 1), cB + hstep + kstep, voffB);
    PG8_WAIT_V(6); PG8_BAR;
    for (;;) {
        const bool has_next = S.next(ui + 1, nxt);
        const char* nA = has_next ? S.a_base(nxt) : cA; const char* nB = has_next ? S.b_base(nxt) : cB;
        if (GATHER) { if (has_next) { PG8_VOFF(vAn, ui + 1); } else {
#pragma unroll
            for (int h = 0; h < 2; ++h)
#pragma unroll
                for (int i = 0; i < 2; ++i) vAn[h][i] = vAc[h][i]; } }
        for (int t = 0; t < nt; t += 2) {
            const bool last = (t == nt - 2);
            const char* a1 = cA + (size_t)(t + 1) * kstep;
            const char* a2 = last ? nA : cA + (size_t)(t + 2) * kstep; const char* b2 = last ? nB : cB + (size_t)(t + 2) * kstep;
            const char* a3 = a2 + kstep; const char* b3 = b2 + kstep;
            unsigned vA2[2][2];
#pragma unroll
            for (int h = 0; h < 2; ++h)
#pragma unroll
                for (int i = 0; i < 2; ++i) vA2[h][i] = (GATHER && last) ? vAn[h][i] : vAc[h][i];
            PG8_LDB(B0, 0, 0); PG8_LDB(B1, 0, 1); PG8_SCHED; PG8_LDA(At, 0, 0); PG8_STAGE(PG8_SA(1, 1), a1, vAc[1]);
            PG8_WAIT_V(8); PG8_WAIT_L(0); PG8_BAR; PG8_MMA(0, 0, At, B0); PG8_MMA(0, 1, At, B1); PG8_BAR; PG8_SCHED;
            PG8_LDA(At, 0, 1); PG8_STAGE(PG8_SB(0, 0), b2, voffB); PG8_STAGE(PG8_SB(0, 1), b2 + hstep, voffB); PG8_STAGE(PG8_SA(0, 0), a2, vA2[0]);
            PG8_WAIT_V(8); PG8_WAIT_L(0); PG8_BAR; PG8_MMA(1, 0, At, B0); PG8_MMA(1, 1, At, B1); PG8_BAR; PG8_SCHED;
            PG8_LDB(B0, 1, 0); PG8_LDB(B1, 1, 1); PG8_SCHED; PG8_LDA(At, 1, 0); PG8_STAGE(PG8_SA(0, 1), a2, vA2[1]);
            PG8_WAIT_V(8); PG8_WAIT_L(0); PG8_BAR; PG8_MMA(0, 0, At, B0); PG8_MMA(0, 1, At, B1); PG8_BAR; PG8_SCHED;
            PG8_LDA(At, 1, 1); PG8_STAGE(PG8_SB(1, 0), b3, voffB); PG8_STAGE(PG8_SB(1, 1), b3 + hstep, voffB); PG8_STAGE(PG8_SA(1, 0), a3, vA2[0]);
            PG8_WAIT_V(8); PG8_WAIT_L(0); PG8_BAR; PG8_MMA(1, 0, At, B0); PG8_MMA(1, 1, At, B1); PG8_BAR; PG8_SCHED;
        }
        if constexpr (ALIGN_EPI) { if (wr == 0) PG8_BAR; }
        E(acc, cur, wr, wc, fr, fq);
        if (!has_next) break;
#pragma unroll
        for (int a = 0; a < 2; ++a)
#pragma unroll
            for (int b = 0; b < 2; ++b)
#pragma unroll
                for (int m = 0; m < 4; ++m)
#pragma unroll
                    for (int n = 0; n < 2; ++n) acc[a][b][m][n] = (f32x4){0.f, 0.f, 0.f, 0.f};
        cur = nxt; cA = nA; cB = nB; ++ui;
        if (GATHER) {
#pragma unroll
            for (int h = 0; h < 2; ++h)
#pragma unroll
                for (int i = 0; i < 2; ++i) vAc[h][i] = vAn[h][i]; }
        if constexpr (ALIGN_EPI) { if (wr == 1) PG8_BAR; }
    }
    PG8_WAIT_V(0);
    if constexpr (!ALIGN_EPI) { if (wr == 0) PG8_BAR; }
    PG8_BAR;
#undef PG8_SA
#undef PG8_SB
#undef PG8_STAGE
#undef PG8_LDA
#undef PG8_LDB
#undef PG8_MMA
#undef PG8_WAIT_V
#undef PG8_WAIT_L
#undef PG8_BAR
#undef PG8_SCHED
#undef PG8_VOFF
}

typedef const f32x4 (&AccT)[2][2][4][2];

struct EpiUV {
    static constexpr bool PERM = true;
    bf16* O; const float* bias; const float* ss; float* vstat;
    __device__ __forceinline__ void operator()(AccT acc, const Unit& u, int wr, int wc, int fr, int fq) const {
        const int col0 = u.pn * BM + wc * 32 + 8 * fq; const bool isv = u.pn >= 12;
        f32x4 bv[2][2]; f32x4 sv[2][4]; float rr[2][4];
#pragma unroll
        for (int ai = 0; ai < 2; ++ai)
#pragma unroll
            for (int m = 0; m < 4; ++m) sv[ai][m] = *(const f32x4*)(ss + (size_t)(u.r0 + ai * HALF + wr * 64 + m * 16 + fr) * 16 + 4 * fq);
#pragma unroll
        for (int bj = 0; bj < 2; ++bj)
#pragma unroll
            for (int n = 0; n < 2; ++n) bv[bj][n] = *(const f32x4*)(bias + col0 + bj * HALF + 4 * n);
#pragma unroll
        for (int ai = 0; ai < 2; ++ai)
#pragma unroll
            for (int m = 0; m < 4; ++m) { float q = (sv[ai][m].x + sv[ai][m].y) + (sv[ai][m].z + sv[ai][m].w); q += __shfl_xor(q, 16); q += __shfl_xor(q, 32); rr[ai][m] = __builtin_amdgcn_rsqf(q * (1.0f / D) + EPS); }
        asm volatile("" ::: "memory");
#pragma unroll
        for (int ai = 0; ai < 2; ++ai)
#pragma unroll
            for (int m = 0; m < 4; ++m) {
                const int row = u.r0 + ai * HALF + wr * 64 + m * 16 + fr;
                const float r = rr[ai][m];
                bf16* rowp = O + (size_t)row * GF + col0; f32x2 s1 = (f32x2){0.f, 0.f}, s2 = (f32x2){0.f, 0.f};
#pragma unroll
                for (int bj = 0; bj < 2; ++bj) {
                    const f32x4 v0 = acc[ai][bj][m][0] * r + bv[bj][0], v1 = acc[ai][bj][m][1] * r + bv[bj][1];
                    const f32x2 a = gelu_tanh2((f32x2){v0[0], v0[1]}), b = gelu_tanh2((f32x2){v0[2], v0[3]}), c = gelu_tanh2((f32x2){v1[0], v1[1]}), d = gelu_tanh2((f32x2){v1[2], v1[3]});
                    if (isv) { s1 += (a + b) + (c + d); s2 += (a * a + b * b) + (c * c + d * d); }
                    v4u w; w.x = cvt_pk_bf16(a.x, a.y); w.y = cvt_pk_bf16(b.x, b.y); w.z = cvt_pk_bf16(c.x, c.y); w.w = cvt_pk_bf16(d.x, d.y);
                    *(v4u*)(rowp + bj * HALF) = w; }
                if (isv) { float t1 = s1.x + s1.y, t2 = s2.x + s2.y; t1 += __shfl_xor(t1, 16); t1 += __shfl_xor(t1, 32); t2 += __shfl_xor(t2, 16); t2 += __shfl_xor(t2, 32);
                    if (fq == 0) *(f32x2*)(vstat + ((size_t)row * 48 + (u.pn - 12) * 4 + wc) * 2) = (f32x2){t1, t2}; }
            }
    }
};

template <bool F32IN> struct EpiRes {
    static constexpr bool PERM = false;
    const void* base; bf16* xb; const float* bias; float* ssout;
    __device__ __forceinline__ void operator()(AccT acc, const Unit& u, int wr, int wc, int fr, int fq) const {
        const int col0 = u.pn * BM + wc * 32 + 4 * fq;
        f32x4 bv[2][2];
#pragma unroll
        for (int bj = 0; bj < 2; ++bj)
#pragma unroll
            for (int n = 0; n < 2; ++n) bv[bj][n] = bias ? *(const f32x4*)(bias + col0 + bj * HALF + n * 16) : (f32x4){0.f, 0.f, 0.f, 0.f};
#pragma unroll
        for (int ai = 0; ai < 2; ++ai) {
            f32x4 xv[4][2][2];
#pragma unroll
            for (int m = 0; m < 4; ++m) { const size_t off = (size_t)(u.r0 + ai * HALF + wr * 64 + m * 16 + fr) * D + col0;
#pragma unroll
                for (int bj = 0; bj < 2; ++bj)
#pragma unroll
                    for (int n = 0; n < 2; ++n) {
                        if (F32IN) xv[m][bj][n] = *(const f32x4*)((const float*)base + off + bj * HALF + n * 16);
                        else { const v2u w = *(const v2u*)((const bf16*)base + off + bj * HALF + n * 16); xv[m][bj][n] = (f32x4){bf_lo(w.x), bf_hi(w.x), bf_lo(w.y), bf_hi(w.y)}; } } }
            asm volatile("" ::: "memory");
#pragma unroll
            for (int m = 0; m < 4; ++m) {
                const int row = u.r0 + ai * HALF + wr * 64 + m * 16 + fr; const size_t off = (size_t)row * D + col0; float s2 = 0.f;
#pragma unroll
                for (int bj = 0; bj < 2; ++bj)
#pragma unroll
                    for (int n = 0; n < 2; ++n) {
                        const f32x4 v = xv[m][bj][n] + acc[ai][bj][m][n] + bv[bj][n];
                        s2 += (v[0] * v[0] + v[1] * v[1]) + (v[2] * v[2] + v[3] * v[3]);
                        v2u w; w.x = cvt_pk_bf16(v[0], v[1]); w.y = cvt_pk_bf16(v[2], v[3]); *(v2u*)(xb + off + bj * HALF + n * 16) = w; }
                if (ssout) { s2 += __shfl_xor(s2, 16); s2 += __shfl_xor(s2, 32); if (fq == 0) ssout[(size_t)row * 16 + u.pn * 4 + wc] = s2; }
            }
            asm volatile("" ::: "memory");
        }
    }
};

template <bool MOE> struct EpiHid {
    static constexpr bool PERM = true;
    bf16* O; int ldh; const float* ss; const float* r4; const int* toklist;
    __device__ __forceinline__ void operator()(AccT acc, const Unit& u, int wr, int wc, int fr, int fq) const {
        const int col0 = u.pn * HALF + wc * 32 + 8 * fq;
        float rr[2][4];
        if (MOE) {
            int tk[2][4];
#pragma unroll
            for (int ai = 0; ai < 2; ++ai)
#pragma unroll
                for (int m = 0; m < 4; ++m) { const int tr = ai * HALF + wr * 64 + m * 16 + fr; tk[ai][m] = toklist[u.e * M + (tr < u.cnt ? u.pm * BM + tr : 0)]; }
#pragma unroll
            for (int ai = 0; ai < 2; ++ai)
#pragma unroll
                for (int m = 0; m < 4; ++m) rr[ai][m] = r4[tk[ai][m]];
        } else {
            f32x4 sv[2][4];
#pragma unroll
            for (int ai = 0; ai < 2; ++ai)
#pragma unroll
                for (int m = 0; m < 4; ++m) sv[ai][m] = *(const f32x4*)(ss + (size_t)(u.r0 + ai * HALF + wr * 64 + m * 16 + fr) * 16 + 4 * fq);
#pragma unroll
            for (int ai = 0; ai < 2; ++ai)
#pragma unroll
                for (int m = 0; m < 4; ++m) { float q = (sv[ai][m].x + sv[ai][m].y) + (sv[ai][m].z + sv[ai][m].w); q += __shfl_xor(q, 16); q += __shfl_xor(q, 32); rr[ai][m] = __builtin_amdgcn_rsqf(q * (1.0f / D) + EPS); }
        }
        asm volatile("" ::: "memory");
#pragma unroll
        for (int ai = 0; ai < 2; ++ai)
#pragma unroll
            for (int m = 0; m < 4; ++m) {
                const int tr = ai * HALF + wr * 64 + m * 16 + fr; const int row = u.r0 + tr; const float r = rr[ai][m]; const bool valid = MOE ? (tr < u.cnt) : true;
                const float rn = -LOG2E * r, r2 = r * r;
                const f32x4 ga = acc[ai][0][m][0], gb = acc[ai][0][m][1], ua = acc[ai][1][m][0], ub = acc[ai][1][m][1];
                const f32x2 o0 = ((f32x2){ga[0], ga[1]} * (f32x2){ua[0], ua[1]}) * r2 * sigm2((f32x2){ga[0], ga[1]} * rn), o1 = ((f32x2){ga[2], ga[3]} * (f32x2){ua[2], ua[3]}) * r2 * sigm2((f32x2){ga[2], ga[3]} * rn);
                const f32x2 o2 = ((f32x2){gb[0], gb[1]} * (f32x2){ub[0], ub[1]}) * r2 * sigm2((f32x2){gb[0], gb[1]} * rn), o3 = ((f32x2){gb[2], gb[3]} * (f32x2){ub[2], ub[3]}) * r2 * sigm2((f32x2){gb[2], gb[3]} * rn);
                v4u w; w.x = cvt_pk_bf16(o0.x, o0.y); w.y = cvt_pk_bf16(o1.x, o1.y); w.z = cvt_pk_bf16(o2.x, o2.y); w.w = cvt_pk_bf16(o3.x, o3.y);
                if (valid) *(v4u*)(O + (size_t)row * ldh + col0) = w;
            }
    }
};

struct EpiNull {
    static constexpr bool PERM = true;
    __device__ __forceinline__ void operator()(AccT acc, const Unit& u, int wr, int wc, int fr, int fq) const {
#pragma unroll
        for (int ai = 0; ai < 2; ++ai)
#pragma unroll
            for (int bj = 0; bj < 2; ++bj)
#pragma unroll
                for (int m = 0; m < 4; ++m)
#pragma unroll
                    for (int n = 0; n < 2; ++n) asm volatile("" :: "v"(acc[ai][bj][m][n]));
    }
};

template <bool MOE> struct EpiBf {
    static constexpr bool PERM = true;
    bf16* O; int ldc; const float* slotw;
    __device__ __forceinline__ void operator()(AccT acc, const Unit& u, int wr, int wc, int fr, int fq) const {
        const int col0 = u.pn * BM + wc * 32 + 8 * fq;
        float scv[2][4];
#pragma unroll
        for (int ai = 0; ai < 2; ++ai)
#pragma unroll
            for (int m = 0; m < 4; ++m) { const int tr = ai * HALF + wr * 64 + m * 16 + fr; scv[ai][m] = MOE ? slotw[u.e * M + (tr < u.cnt ? u.pm * BM + tr : 0)] : 1.f; }
        asm volatile("" ::: "memory");
#pragma unroll
        for (int ai = 0; ai < 2; ++ai)
#pragma unroll
            for (int m = 0; m < 4; ++m) {
                const int tr = ai * HALF + wr * 64 + m * 16 + fr; const int row = u.r0 + tr; const float sc = scv[ai][m]; const bool valid = MOE ? (tr < u.cnt) : true;
                bf16* rowp = O + (size_t)row * ldc + col0;
#pragma unroll
                for (int bj = 0; bj < 2; ++bj) { const f32x4 v0 = acc[ai][bj][m][0] * sc, v1 = acc[ai][bj][m][1] * sc;
                    v4u w; w.x = cvt_pk_bf16(v0[0], v0[1]); w.y = cvt_pk_bf16(v0[2], v0[3]); w.z = cvt_pk_bf16(v1[0], v1[1]); w.w = cvt_pk_bf16(v1[2], v1[3]);
                    if (valid) *(v4u*)(rowp + bj * HALF) = w; }
            }
    }
};

struct EpiBfTail {
    static constexpr bool PERM = true;
    bf16* O; const float* slotw; int tail_row0;
    __device__ __forceinline__ void operator()(AccT acc, const Unit& u, int wr, int wc, int fr, int fq) const {
        const int col0 = u.pn * BM + wc * 32 + 8 * fq;
        float scv[2][4];
#pragma unroll
        for (int ai = 0; ai < 2; ++ai)
#pragma unroll
            for (int m = 0; m < 4; ++m) { const int tr = ai * HALF + wr * 64 + m * 16 + fr; scv[ai][m] = slotw[u.e * M + (tr < u.cnt ? u.pm * BM + tr : 0)]; }
        asm volatile("" ::: "memory");
#pragma unroll
        for (int ai = 0; ai < 2; ++ai)
#pragma unroll
            for (int m = 0; m < 4; ++m) {
                const int tr = ai * HALF + wr * 64 + m * 16 + fr; const int row = u.ks * 2048 + (u.r0 + tr - tail_row0); const float sc = scv[ai][m]; const bool valid = tr < u.cnt;
                bf16* rowp = O + (size_t)row * D + col0;
#pragma unroll
                for (int bj = 0; bj < 2; ++bj) { const f32x4 v0 = acc[ai][bj][m][0] * sc, v1 = acc[ai][bj][m][1] * sc;
                    v4u w; w.x = cvt_pk_bf16(v0[0], v0[1]); w.y = cvt_pk_bf16(v0[2], v0[3]); w.z = cvt_pk_bf16(v1[0], v1[1]); w.w = cvt_pk_bf16(v1[2], v1[3]);
                    if (valid) *(v4u*)(rowp + bj * HALF) = w; }
            }
    }
};

struct EpiPle {
    static constexpr bool PERM = false;
    const bf16* xin; const bf16* proj; const float* ss; bf16* xout; float* ssout;
    __device__ __forceinline__ void operator()(AccT acc, const Unit& u, int wr, int wc, int fr, int fq) const {
        const int col0 = u.pn * BM + wc * 32 + 4 * fq;
#pragma unroll
        for (int ai = 0; ai < 2; ++ai)
#pragma unroll
        for (int mh = 0; mh < 2; ++mh) {
            v2u xv[2][2][2], pv[2][2][2]; f32x4 sv[2];
#pragma unroll
            for (int mm = 0; mm < 2; ++mm) { const int row = u.r0 + ai * HALF + wr * 64 + (2 * mh + mm) * 16 + fr; const size_t off = (size_t)row * D + col0;
                sv[mm] = *(const f32x4*)(ss + (size_t)row * 16 + 4 * fq);
#pragma unroll
                for (int bj = 0; bj < 2; ++bj)
#pragma unroll
                    for (int n = 0; n < 2; ++n) { xv[mm][bj][n] = *(const v2u*)(xin + off + bj * HALF + n * 16); pv[mm][bj][n] = *(const v2u*)(proj + off + bj * HALF + n * 16); } }
            asm volatile("" ::: "memory");
#pragma unroll
            for (int mm = 0; mm < 2; ++mm) {
                const int m = 2 * mh + mm;
                const int row = u.r0 + ai * HALF + wr * 64 + m * 16 + fr; const size_t off = (size_t)row * D + col0; float s2 = 0.f;
                float sq = (sv[mm].x + sv[mm].y) + (sv[mm].z + sv[mm].w); sq += __shfl_xor(sq, 16); sq += __shfl_xor(sq, 32);
                const float rn = -LOG2E * __builtin_amdgcn_rsqf(sq * (1.0f / D) + EPS);
#pragma unroll
                for (int bj = 0; bj < 2; ++bj)
#pragma unroll
                    for (int n = 0; n < 2; ++n) {
                        const size_t o = off + bj * HALF + n * 16;
                        const v2u pw = pv[mm][bj][n], xw = xv[mm][bj][n]; const f32x4 a = acc[ai][bj][m][n] * rn;
                        const f32x2 g01 = sigm2((f32x2){a[0], a[1]}), g23 = sigm2((f32x2){a[2], a[3]});
                        f32x4 v; v[0] = bf_lo(xw.x) + bf_lo(pw.x) * g01.x; v[1] = bf_hi(xw.x) + bf_hi(pw.x) * g01.y; v[2] = bf_lo(xw.y) + bf_lo(pw.y) * g23.x; v[3] = bf_hi(xw.y) + bf_hi(pw.y) * g23.y;
                        s2 += (v[0] * v[0] + v[1] * v[1]) + (v[2] * v[2] + v[3] * v[3]);
                        v2u w; w.x = cvt_pk_bf16(v[0], v[1]); w.y = cvt_pk_bf16(v[2], v[3]); *(v2u*)(xout + o) = w; }
                if (ssout) { s2 += __shfl_xor(s2, 16); s2 += __shfl_xor(s2, 32); if (fq == 0) ssout[(size_t)row * 16 + u.pn * 4 + wc] = s2; }
            }
            asm volatile("" ::: "memory");
        }
    }
};

struct EpiQKV {
    static constexpr bool PERM = false;
    bf16* Q; bf16* Kb; bf16* Vb; const float* bq; const float* bkv; const float* ss; const f32x2* rope;
    __device__ __forceinline__ void operator()(AccT acc, const Unit& u, int wr, int wc, int fr, int fq) const {
        const int dlo = 16 * (wc & 1) + 4 * fq;
        const int kind = u.pn < 4 ? 0 : (u.pn == 4 ? 1 : 2);
        f32x4 bv[2][2];
#pragma unroll
        for (int bj = 0; bj < 2; ++bj) {
            const int hcol = 64 * (2 * bj + (wc >> 1)) + dlo;
            const float* bp = kind == 0 ? bq + u.pn * BM + hcol : bkv + (kind - 1) * BM + hcol;
            bv[bj][0] = *(const f32x4*)bp; bv[bj][1] = *(const f32x4*)(bp + 32); }
#pragma unroll
        for (int ai = 0; ai < 2; ++ai) {
            f32x4 sv[4], c01[4], c23[4];
#pragma unroll
            for (int m = 0; m < 4; ++m) { const int row = u.r0 + ai * HALF + wr * 64 + m * 16 + fr; sv[m] = *(const f32x4*)(ss + (size_t)row * 16 + 4 * fq);
                const f32x2* rp = rope + (size_t)(row & (SEQ - 1)) * 32 + dlo; c01[m] = *(const f32x4*)rp; c23[m] = *(const f32x4*)(rp + 2); }
            asm volatile("" ::: "memory");
#pragma unroll
            for (int m = 0; m < 4; ++m) {
                const int row = u.r0 + ai * HALF + wr * 64 + m * 16 + fr;
                float q = (sv[m].x + sv[m].y) + (sv[m].z + sv[m].w); q += __shfl_xor(q, 16); q += __shfl_xor(q, 32); const float r = __builtin_amdgcn_rsqf(q * (1.0f / D) + EPS);
                const f32x4 cs01 = c01[m], cs23 = c23[m];
                const float cc[4] = {cs01[0], cs01[2], cs23[0], cs23[2]}, sn[4] = {cs01[1], cs01[3], cs23[1], cs23[3]};
#pragma unroll
                for (int bj = 0; bj < 2; ++bj) {
                    const int hcol = 64 * (2 * bj + (wc >> 1)) + dlo;
                    f32x4 lo = acc[ai][bj][m][0] * r + bv[bj][0], hi = acc[ai][bj][m][1] * r + bv[bj][1];
                    if (kind < 2) {
#pragma unroll
                        for (int j = 0; j < 4; ++j) { const float a = lo[j], b = hi[j]; lo[j] = a * cc[j] - b * sn[j]; hi[j] = b * cc[j] + a * sn[j]; }
                    }
                    if (kind == 0) { lo = lo * QSCALE; hi = hi * QSCALE; }
                    v2u wl, wh; wl.x = cvt_pk_bf16(lo[0], lo[1]); wl.y = cvt_pk_bf16(lo[2], lo[3]); wh.x = cvt_pk_bf16(hi[0], hi[1]); wh.y = cvt_pk_bf16(hi[2], hi[3]);
                    bf16* dst = kind == 0 ? Q + (size_t)row * D + u.pn * BM + hcol : (kind == 1 ? Kb : Vb) + (size_t)row * 256 + hcol;
                    *(v2u*)dst = wl; *(v2u*)(dst + 32) = wh; }
            }
            asm volatile("" ::: "memory");
        }
    }
};
}

struct Args { const float* in[31]; float* out; unsigned char* ws; int ph_lo, ph_hi, li, pad; };

struct Frame {
    LAS unsigned char* lds; volatile LAS unsigned* MISC; unsigned* ctl; unsigned char* ws;
    int wave, G, bid;
};

__device__ __forceinline__ int dest_row(int mode, int off, int n) {
    if (mode == 1) return ((n >> 7) << 8) + (n & 127) + off;
    if (mode == 2) return ((n & ~48) | ((n & 16) << 1) | ((n & 32) >> 1)) + off;
    return n + off;
}
__device__ __forceinline__ void p0_transpose_item(const float* W, int K, int N, const float* gain, bf16* WT, int mode, int off, int item, int lane, LAS unsigned char* scr) {
    const int nblk = N / 64, kb = item / nblk, nb = item % nblk, k0 = 128 * kb, n0 = 64 * nb;
    const float* src = W + (size_t)k0 * N + n0 + lane;
    float v[96], w[32];
#pragma unroll
    for (int i = 0; i < 96; ++i) v[i] = src[(size_t)i * N];
    int g0 = 0x3f800000, g1 = 0x3f800000;
    if (gain) { g0 = __float_as_int(gain[k0 + lane]); g1 = __float_as_int(gain[k0 + 64 + lane]); }
    LAS unsigned char* myrow = scr + lane * 272;
#define P0_G(i) __int_as_float(__builtin_amdgcn_readlane((i) < 64 ? g0 : g1, (i) & 63))
#define P0_CVT(arr, base, c) do { v4u o; o.x = cvt_pk_bf16(arr[8 * (c) - (base)] * P0_G(8 * (c)), arr[8 * (c) + 1 - (base)] * P0_G(8 * (c) + 1)); o.y = cvt_pk_bf16(arr[8 * (c) + 2 - (base)] * P0_G(8 * (c) + 2), arr[8 * (c) + 3 - (base)] * P0_G(8 * (c) + 3)); \
        o.z = cvt_pk_bf16(arr[8 * (c) + 4 - (base)] * P0_G(8 * (c) + 4), arr[8 * (c) + 5 - (base)] * P0_G(8 * (c) + 5)); o.w = cvt_pk_bf16(arr[8 * (c) + 6 - (base)] * P0_G(8 * (c) + 6), arr[8 * (c) + 7 - (base)] * P0_G(8 * (c) + 7)); *(LAS v4u*)(myrow + 16 * (c)) = o; } while (0)
#pragma unroll
    for (int c = 0; c < 4; ++c) P0_CVT(v, 0, c);
    asm volatile("" ::: "memory");
#pragma unroll
    for (int i = 0; i < 32; ++i) w[i] = src[(size_t)(96 + i) * N];
    asm volatile("" ::: "memory");
#pragma unroll
    for (int c = 4; c < 12; ++c) P0_CVT(v, 0, c);
#pragma unroll
    for (int c = 12; c < 16; ++c) P0_CVT(w, 96, c);
#undef P0_CVT
#undef P0_G
    LDS_WAIT(); asm volatile("" ::: "memory");
    const int c16 = lane & 15, rq = lane >> 4;
#pragma unroll
    for (int j = 0; j < 16; ++j) { const int n = 4 * j + rq; const v4u o = *(const LAS v4u*)(scr + n * 272 + 16 * c16);
        *(v4u*)(WT + (size_t)dest_row(mode, off, n0 + n) * K + k0 + 8 * c16) = o; }
    LDS_WAIT(); asm volatile("" ::: "memory");
}

#define IN_(k) ((const float*)args.in[k])

__global__ void __launch_bounds__(NWAVES * 64, 2) fwd_kernel(Args args) {
    extern __shared__ __attribute__((aligned(16))) unsigned char lds_raw[];
    Frame F;
    F.lds = (LAS unsigned char*)lds_raw;
    F.MISC = (volatile LAS unsigned*)(F.lds + MISC_OFF);
    F.wave = __builtin_amdgcn_readfirstlane(threadIdx.x >> 6);
    F.G = gridDim.x; F.bid = blockIdx.x;
    F.ws = args.ws; F.ctl = (unsigned*)(args.ws + WS_CTL);
    unsigned char* ws = args.ws;
    const int wave = F.wave, G = F.G, bid = F.bid;
    const int gw = bid * NWAVES + wave, NGW = G * NWAVES;
#define PH_IDS const int lane = opaque_lane(); const int tid = wave * 64 + lane; (void)tid; (void)lane

    { PH_IDS; for (int u = tid; u < 128; u += NWAVES * 64) ((LAS unsigned*)(F.lds + MISC_OFF))[u] = 0u; }
    __syncthreads();
    constexpr bool ONE = (MK_N_LAUNCHES == 1);
    XcdBarrier bar; bar.bar = F.ctl + CW_BAR; bar.x = 0; bar.st = nullptr;
    if (ONE) bar = xcd_barrier_post(F.ctl + CW_BAR, F.MISC + 8, wave == 0 && opaque_lane() == 0);
#define GRID_BAR() do { if (ONE) xcd_barrier(bar, wave == 0 && opaque_lane() == 0); } while (0)
    const int lo = args.ph_lo, hi = args.ph_hi;
#define IN(k) (lo <= (k) && (k) < hi)
#if defined(PROBE_LO)
    unsigned long long probe_t0 = 0ull, probe_dt = 0ull;
#define PROBE_START(k) do { if ((k) == PROBE_LO) probe_t0 = __builtin_amdgcn_s_memrealtime(); } while (0)
#define PROBE_END(k) do { if ((k) == PROBE_HI) probe_dt = __builtin_amdgcn_s_memrealtime() - probe_t0; } while (0)
#else
#define PROBE_START(k) do {} while (0)
#define PROBE_END(k) do {} while (0)
#endif

    bf16* const Win_t = (bf16*)(ws + WS_WIN); bf16* const Wout_t = (bf16*)(ws + WS_WOUT); bf16* const Wgu_t = (bf16*)(ws + WS_WGU); bf16* const Wd_t = (bf16*)(ws + WS_WD);
    bf16* const Wpg0_t = (bf16*)(ws + WS_WPG0); bf16* const Wpp0_t = (bf16*)(ws + WS_WPP0); bf16* const Wpg1_t = (bf16*)(ws + WS_WPG1); bf16* const Wpp1_t = (bf16*)(ws + WS_WPP1);
    bf16* const Wqkv_t = (bf16*)(ws + WS_WQKV); bf16* const Wo_t = (bf16*)(ws + WS_WO); bf16* const MWgu_t = (bf16*)(ws + WS_MWGU); bf16* const MWd_t = (bf16*)(ws + WS_MWD);
    bf16* const XB0 = (bf16*)(ws + WS_XB0); bf16* const XB1 = (bf16*)(ws + WS_XB1); bf16* const PB = (bf16*)(ws + WS_PB);
    bf16* const UV = (bf16*)(ws + WS_UV); bf16* const HID = (bf16*)(ws + WS_HID); bf16* const PROJ = (bf16*)(ws + WS_PROJ);
    bf16* const Qb = (bf16*)(ws + WS_Q); bf16* const Kb = (bf16*)(ws + WS_K); bf16* const Vb = (bf16*)(ws + WS_V);
    bf16* const HIDM = (bf16*)(ws + WS_HIDM); bf16* const YS = (bf16*)(ws + WS_YS); bf16* const YSP = (bf16*)(ws + WS_YSP);
    float* const SS0 = (float*)(ws + WS_SS); float* const SS1 = SS0 + M * 16; float* const SS2 = SS1 + M * 16; float* const SS3 = SS2 + M * 16; float* const SS5 = SS3 + M * 16;
    float* const R4 = (float*)(ws + WS_R4); unsigned* const TOKSLOT = (unsigned*)(ws + WS_TOKSLOT); int* const TOKLIST = (int*)(ws + WS_TOKLIST); float* const SLOTW = (float*)(ws + WS_SLOTW);
    float* const WR = (float*)(ws + WS_WR); float* const VSTAT = (float*)(ws + WS_VSTAT); f32x2* const ROPE = (f32x2*)(ws + WS_ROPE);
    float* const X = args.out;
    unsigned* const GCNT = F.ctl + CW_CNT;

    if (IN(0)) {
        PROBE_START(0);
        PH_IDS;
        LAS unsigned char* scr = F.lds + wave * 17408;
        constexpr int I_WIN = (D / 128) * (GF / 64), I_WOUT = (GH / 128) * (D / 64), I_FG = (D / 128) * (FFD / 64), I_FD = (FFD / 128) * (D / 64), I_PG = (D / 128) * (D / 64), I_PP = (PLE / 128) * (D / 64),
                      I_WQ = (D / 128) * (D / 64), I_WKV = (D / 128) * (512 / 64), I_WO = I_WQ, I_MG = (D / 128) * (FFE / 64), I_MD = (FFE / 128) * (D / 64);
        constexpr int NITEMS = I_WIN + I_WOUT + 2 * I_FG + I_FD + 2 * I_PG + 2 * I_PP + I_WQ + I_WKV + I_WO + NE * (2 * I_MG + I_MD);
        for (int it = gw; it < NITEMS; it += NGW) {
            int r = it;
            if (r < I_WIN) { p0_transpose_item(IN_(4), D, GF, IN_(2), Win_t, 0, 0, r, lane, scr); continue; } r -= I_WIN;
            if (r < I_WOUT) { p0_transpose_item(IN_(10), GH, D, nullptr, Wout_t, 0, 0, r, lane, scr); continue; } r -= I_WOUT;
            if (r < I_FG) { p0_transpose_item(IN_(20), D, FFD, IN_(3), Wgu_t, 1, 0, r, lane, scr); continue; } r -= I_FG;
            if (r < I_FG) { p0_transpose_item(IN_(21), D, FFD, IN_(3), Wgu_t, 1, 128, r, lane, scr); continue; } r -= I_FG;
            if (r < I_FD) { p0_transpose_item(IN_(22), FFD, D, nullptr, Wd_t, 0, 0, r, lane, scr); continue; } r -= I_FD;
            if (r < I_PG) { p0_transpose_item(IN_(29), D, D, IN_(28), Wpg0_t, 0, 0, r, lane, scr); continue; } r -= I_PG;
            if (r < I_PG) { p0_transpose_item(IN_(29) + D * D, D, D, IN_(28) + D, Wpg1_t, 0, 0, r, lane, scr); continue; } r -= I_PG;
            if (r < I_PP) { p0_transpose_item(IN_(27), PLE, D, nullptr, Wpp0_t, 0, 0, r, lane, scr); continue; } r -= I_PP;
            if (r < I_PP) { p0_transpose_item(IN_(27) + PLE * D, PLE, D, nullptr, Wpp1_t, 0, 0, r, lane, scr); continue; } r -= I_PP;
            if (r < I_WQ) { p0_transpose_item(IN_(15), D, D, IN_(2) + D, Wqkv_t, 2, 0, r, lane, scr); continue; } r -= I_WQ;
            if (r < I_WKV) { p0_transpose_item(IN_(13), D, 512, IN_(12), Wqkv_t, 2, 1024, r, lane, scr); continue; } r -= I_WKV;
            if (r < I_WO) { p0_transpose_item(IN_(18), D, D, nullptr, Wo_t, 0, 0, r, lane, scr); continue; } r -= I_WO;
            { constexpr int PER_E = 2 * I_MG + I_MD; const int e = r / PER_E; int q = r % PER_E;
              if (q < I_MG) { p0_transpose_item(IN_(24) + (size_t)e * D * FFE, D, FFE, IN_(3) + D, MWgu_t + (size_t)e * 7168 * D, 1, 0, q, lane, scr); continue; } q -= I_MG;
              if (q < I_MG) { p0_transpose_item(IN_(25) + (size_t)e * D * FFE, D, FFE, IN_(3) + D, MWgu_t + (size_t)e * 7168 * D, 1, 128, q, lane, scr); continue; } q -= I_MG;
              p0_transpose_item(IN_(26) + (size_t)e * FFE * D, FFE, D, nullptr, MWd_t + (size_t)e * D * FFE, 0, 0, q, lane, scr); }
        }
        for (int m = 4 * gw; m < M; m += 4 * NGW) {
            const f32x4* xr = (const f32x4*)(IN_(0) + (size_t)m * D) + lane; f32x4 v[16]; float sq[4] = {0.f, 0.f, 0.f, 0.f};
#pragma unroll
            for (int j = 0; j < 16; ++j) v[j] = xr[64 * j];
#pragma unroll
            for (int j = 0; j < 16; ++j) sq[j >> 2] += (v[j].x * v[j].x + v[j].y * v[j].y) + (v[j].z * v[j].z + v[j].w * v[j].w);
#pragma unroll
            for (int q = 0; q < 4; ++q) sq[q] = wave_sum(sq[q]);
            v2u* o8 = (v2u*)(XB0 + (size_t)m * D) + lane;
#pragma unroll
            for (int j = 0; j < 16; ++j) { v2u w; w.x = cvt_pk_bf16(v[j].x, v[j].y); w.y = cvt_pk_bf16(v[j].z, v[j].w); o8[64 * j] = w; }
            SS0[(size_t)m * 16 + lane] = lane == 0 ? sq[0] : (lane == 16 ? sq[1] : (lane == 32 ? sq[2] : (lane == 48 ? sq[3] : 0.f)));
        }
        for (int i = bid * (NWAVES * 64) + tid; i < 2 * M * PLE / 8; i += 4 * G * NWAVES * 64) {
            f32x4 a[4], b[4];
#pragma unroll
            for (int q = 0; q < 4; ++q) { const int ii = i + q * G * NWAVES * 64; if (ii < 2 * M * PLE / 8) { a[q] = ((const f32x4*)IN_(1))[2 * ii]; b[q] = ((const f32x4*)IN_(1))[2 * ii + 1]; } }
#pragma unroll
            for (int q = 0; q < 4; ++q) { const int ii = i + q * G * NWAVES * 64; if (ii < 2 * M * PLE / 8) {
                v4u w; w.x = cvt_pk_bf16(a[q].x, a[q].y); w.y = cvt_pk_bf16(a[q].z, a[q].w); w.z = cvt_pk_bf16(b[q].x, b[q].y); w.w = cvt_pk_bf16(b[q].z, b[q].w);
                ((v4u*)PB)[ii] = w; } }
        }
        for (int i = bid * (NWAVES * 64) + tid; i < SEQ * 32; i += G * NWAVES * 64) {
            const int pos = i >> 5, fi = i & 31;
            const float freq = exp2f(-(float)fi * (13.287712379549449f / 32.0f));
            const float ang = (float)pos * freq;
            const double rev = (double)ang * 0.15915494309189535; const double fr_ = rev - __builtin_rint(rev);
            const float xr = (float)fr_;
            ROPE[i] = (f32x2){__builtin_amdgcn_cosf(xr), __builtin_amdgcn_sinf(xr)};
        }
        for (int i = bid * (NWAVES * 64) + tid; i < NE * D; i += G * NWAVES * 64) { const int e = i >> 10, k = i & 1023; WR[i] = IN_(3)[D + k] * IN_(23)[k * NE + e]; }
        GRID_BAR();
        PROBE_END(0);
    }

    if (IN(1)) {
        PROBE_START(1);
        pg8::StaticOrder S; S.init(M, GF, D, D, G, bid, XB0, Win_t);
        pg8::EpiUV E{UV, IN_(5), SS0, VSTAT};
        pg8::gemm_phase<pg8::EpiUV, pg8::StaticOrder, true, false>(F.lds, D, S, E, wave);
        GRID_BAR();
        PROBE_END(1);
    }

    if (IN(2)) {
        PROBE_START(2);
        PH_IDS;
        constexpr int WSTR = 136;
        constexpr int VPITCH = 400;
        LAS bf16* WSL = (LAS bf16*)(F.lds);
        LAS unsigned char* VL = F.lds + 34816;
        LAS f32x2* STAT = (LAS f32x2*)(F.lds + 34816 + 51200);
        LAS float* C1 = (LAS float*)(F.lds + 34816 + 51200 + 1024);
        LAS float* C2 = C1 + 128; LAS float* GBL = C2 + 128;
        const float* lng = IN_(6); const float* lnb = IN_(7); const float* wsrc = IN_(8); const float* bsrc = IN_(9);
        typedef short v4i16_t __attribute__((ext_vector_type(4)));
        for (int cu = bid; cu < 256; cu += G) {
            const int c = cu >> 1, gq = (cu & 1) * 4; const int row0 = 128 * c;
            if (tid < 128) {
                const f32x4* vp = (const f32x4*)(VSTAT + (size_t)(row0 + tid) * 96); float s1 = 0.f, s2 = 0.f;
#pragma unroll 8
                for (int j = 0; j < 24; ++j) { const f32x4 q = vp[j]; s1 += q.x + q.z; s2 += q.y + q.w; }
                const float mean = s1 * (1.0f / GH); float var = s2 * (1.0f / GH) - mean * mean; var = var < 0.f ? 0.f : var;
                STAT[tid] = (f32x2){mean, __builtin_amdgcn_rsqf(var + EPS)};
            }
            const int tl = lane & 15, kg = lane >> 4; const int t = 16 * wave + tl; const int nks = (wave + 2) >> 1;
            const bf16* vbase = UV + (size_t)row0 * GF + GH; bf16* ubase = UV + (size_t)(row0 + t) * GF + 4 * kg;
            v4u vq[6]; v2u ucur[12];
#define P2_LOADV(chn) do { _Pragma("unroll") for (int j_ = 0; j_ < 6; ++j_) { const int idx_ = tid + 512 * j_; vq[j_] = *(const v4u*)(vbase + (size_t)(idx_ / 24) * GF + (chn) + 8 * (idx_ % 24)); } } while (0)
#define P2_LOADU(dst, chn) do { _Pragma("unroll") for (int cb_ = 0; cb_ < 12; ++cb_) dst[cb_] = *(const v2u*)(ubase + (chn) + 16 * cb_); } while (0)
            P2_LOADV(GD * gq);
            __syncthreads();
            for (int gi = 0; gi < 4; ++gi) {
                const int g = gq + gi;
                for (int idx = tid; idx < 2048; idx += NWAVES * 64) {
                    const int tt = idx >> 4, s0 = (idx & 15) * 8; const f32x4* wp = (const f32x4*)(wsrc + ((size_t)g * 128 + tt) * 128 + s0);
                    const f32x4 wa = wp[0], wb = wp[1]; const float w8[8] = {wa.x, wa.y, wa.z, wa.w, wb.x, wb.y, wb.z, wb.w};
                    float p1 = 0.f, p2 = 0.f; v4u o; unsigned pk[4];
#pragma unroll
                    for (int j = 0; j < 8; j += 2) {
                        const f32x2 st0 = STAT[s0 + j], st1 = STAT[s0 + j + 1];
                        const float m0 = (s0 + j <= tt) ? w8[j] : 0.f, m1 = (s0 + j + 1 <= tt) ? w8[j + 1] : 0.f;
                        const unsigned w = cvt_pk_bf16(m0 * st0.y, m1 * st1.y); pk[j >> 1] = w;
                        p1 += bf_lo(w) * st0.x + bf_hi(w) * st1.x; p2 += m0 + m1; }
                    o.x = pk[0]; o.y = pk[1]; o.z = pk[2]; o.w = pk[3];
                    *(LAS v4u*)(WSL + tt * WSTR + s0) = o;
#pragma unroll
                    for (int sh = 1; sh < 16; sh <<= 1) { p1 += __shfl_xor(p1, sh); p2 += __shfl_xor(p2, sh); }
                    if ((idx & 15) == 0) { C1[tt] = p1; C2[tt] = p2; }
                }
                for (int i = tid; i < GD; i += NWAVES * 64) { GBL[i] = lng[GD * g + i]; GBL[GD + i] = lnb[GD * g + i]; }
#pragma unroll
                for (int hf = 0; hf < 2; ++hf) {
                    const int chn = GD * g + 192 * hf;
                    P2_LOADU(ucur, chn);
#pragma unroll
                    for (int j = 0; j < 6; ++j) { const int idx = tid + 512 * j; *(LAS v4u*)(VL + (idx / 24) * VPITCH + 16 * (idx % 24)) = vq[j]; }
                    __syncthreads();
                    const bool more = !(gi == 3 && hf == 1); const int chn2 = hf == 0 ? chn + 192 : GD * (g + 1);
                    if (more) { P2_LOADV(chn2); }
                    f32x4 acc[12];
#pragma unroll
                    for (int cb = 0; cb < 12; ++cb) acc[cb] = (f32x4){0.f, 0.f, 0.f, 0.f};
                    for (int ks = 0; ks < nks; ++ks) {
                        const bf16x8 wf = *(const LAS bf16x8*)(WSL + t * WSTR + 32 * ks + 8 * kg);
                        unsigned vb = (unsigned)(uintptr_t)VL + (unsigned)((32 * ks + 8 * kg + (tl >> 2)) * VPITCH + 8 * (tl & 3));
                        asm volatile("" : "+v"(vb));
#pragma unroll
                        for (int h6 = 0; h6 < 2; ++h6) {
                            v4i16_t lo[6], hi[6];
#pragma unroll
                            for (int cq = 0; cq < 6; ++cq) {
                                asm volatile("ds_read_b64_tr_b16 %0, %1 offset:%c2" : "=&v"(lo[cq]) : "v"(vb), "i"(32 * (6 * h6 + cq)) : "memory");
                                asm volatile("ds_read_b64_tr_b16 %0, %1 offset:%c2" : "=&v"(hi[cq]) : "v"(vb), "i"(4 * VPITCH + 32 * (6 * h6 + cq)) : "memory"); }
                            asm volatile("s_waitcnt lgkmcnt(0)" ::: "memory"); __builtin_amdgcn_sched_barrier(0);
#pragma unroll
                            for (int cq = 0; cq < 6; ++cq) {
                                const bf16x8 vf = __builtin_shufflevector(lo[cq], hi[cq], 0, 1, 2, 3, 4, 5, 6, 7);
                                acc[6 * h6 + cq] = __builtin_amdgcn_mfma_f32_16x16x32_bf16(vf, wf, acc[6 * h6 + cq], 0, 0, 0); }
                        }
                    }
                    const float c1 = C1[t], c2 = C2[t], bsv = bsrc[g * 128 + t];
#pragma unroll
                    for (int cb = 0; cb < 12; ++cb) {
                        const int chl = 192 * hf + 16 * cb + 4 * kg; const f32x4 ga = *(const LAS f32x4*)(GBL + chl), be = *(const LAS f32x4*)(GBL + GD + chl);
                        const v2u uw = ucur[cb];
                        const float o0 = bf_lo(uw.x) * (ga[0] * (acc[cb][0] - c1) + be[0] * c2 + bsv), o1 = bf_hi(uw.x) * (ga[1] * (acc[cb][1] - c1) + be[1] * c2 + bsv);
                        const float o2 = bf_lo(uw.y) * (ga[2] * (acc[cb][2] - c1) + be[2] * c2 + bsv), o3 = bf_hi(uw.y) * (ga[3] * (acc[cb][3] - c1) + be[3] * c2 + bsv);
                        v2u w; w.x = cvt_pk_bf16(o0, o1); w.y = cvt_pk_bf16(o2, o3); *(v2u*)(ubase + chn + 16 * cb) = w;
                        if ((cb & 3) == 3) __builtin_amdgcn_sched_barrier(0); }
                    __syncthreads();
                }
            }
#undef P2_LOADV
#undef P2_LOADU
        }
        GRID_BAR();
        PROBE_END(2);
    }

    if (IN(3)) {
        PROBE_START(3);
        pg8::StaticOrder S; S.init(M, D, GH, GF, G, bid, UV, Wout_t);
        pg8::EpiRes<true> E{IN_(0), XB0, IN_(11), SS1};
        pg8::gemm_phase<pg8::EpiRes<true>, pg8::StaticOrder, false, false>(F.lds, GH, S, E, wave);
        GRID_BAR();
        PROBE_END(3);
    }

    if (IN(4)) {
        PROBE_START(4);
        pg8::StaticOrder S; S.init(M, 2 * FFD, D, D, G, bid, XB0, Wgu_t);
        pg8::EpiHid<false> E{HID, FFD, SS1, nullptr, nullptr};
#if defined(PROBE_DUMMY4)
        { pg8::EpiNull EN; pg8::gemm_phase<pg8::EpiNull, pg8::StaticOrder, true, false>(F.lds, D, S, EN, wave); }
#else
        pg8::gemm_phase<pg8::EpiHid<false>, pg8::StaticOrder, true, false>(F.lds, D, S, E, wave);
#endif
        GRID_BAR();
        PROBE_END(4);
#if defined(PROBE_DUMMY4)
        pg8::gemm_phase<pg8::EpiHid<false>, pg8::StaticOrder, true, false>(F.lds, D, S, E, wave);
        GRID_BAR();
#endif
    }

    if (IN(5)) {
        PROBE_START(5);
        { pg8::StaticOrder S; S.init(M, D, FFD, FFD, G, bid, HID, Wd_t);
          pg8::EpiRes<false> E{XB0, XB0, nullptr, SS2};
          pg8::gemm_phase<pg8::EpiRes<false>, pg8::StaticOrder, false, false>(F.lds, FFD, S, E, wave); }
        { pg8::StaticOrder S; S.init(M, D, PLE, PLE, G, bid, PB, Wpp0_t);
          pg8::EpiBf<false> E{PROJ, D, nullptr};
          pg8::gemm_phase<pg8::EpiBf<false>, pg8::StaticOrder, false, false>(F.lds, PLE, S, E, wave); }
        GRID_BAR();
        PROBE_END(5);
    }

    if (IN(6)) {
        PROBE_START(6);
        pg8::StaticOrder S; S.init(M, D, D, D, G, bid, XB0, Wpg0_t);
        pg8::EpiPle E{XB0, PROJ, SS2, XB1, SS3};
        pg8::gemm_phase<pg8::EpiPle, pg8::StaticOrder, false, false>(F.lds, D, S, E, wave);
        GRID_BAR();
        PROBE_END(6);
    }

    if (IN(7)) {
        PROBE_START(7);
        pg8::StaticOrder S; S.init(M, NQKV, D, D, G, bid, XB1, Wqkv_t);
        pg8::EpiQKV E{Qb, Kb, Vb, IN_(16), IN_(14), SS3, ROPE};
        pg8::gemm_phase<pg8::EpiQKV, pg8::StaticOrder, true, false>(F.lds, D, S, E, wave);
        GRID_BAR();
        PROBE_END(7);
    }

    if (IN(8)) {
        PROBE_START(8);
        PH_IDS;
        constexpr int KSTR = 72, VSTR = 264;
        LAS bf16* KL = (LAS bf16*)(F.lds);
        LAS bf16* VT = (LAS bf16*)(F.lds + 256 * KSTR * 2);
        const float* sinks = IN_(17);
        for (int id = bid; id < 512; id += G) {
            const int qb = id & 31, g = (id >> 5) & 3, b = id >> 7;
            const long tok0 = (long)b * SEQ + 128 * qb - 128;
            for (int idx = tid; idx < 2048; idx += NWAVES * 64) {
                const int kj = idx >> 3, c = idx & 7; const bool valid = (qb > 0) || (kj >= 128);
                v4u val = (v4u){0u, 0u, 0u, 0u};
                if (valid) val = *(const v4u*)(Kb + (size_t)(tok0 + kj) * 256 + 64 * g + 8 * c);
                *(LAS v4u*)(KL + kj * KSTR + 8 * c) = val;
            }
            for (int idx = tid; idx < 2048; idx += NWAVES * 64) {
                const int kj = idx & 255, c = idx >> 8; const bool valid = (qb > 0) || (kj >= 128);
                v4u raw = (v4u){0u, 0u, 0u, 0u};
                if (valid) raw = *(const v4u*)(Vb + (size_t)(tok0 + kj) * 256 + 64 * g + 8 * c);
                LAS bf16* vp = VT + (8 * c) * VSTR + kj;
                vp[0 * VSTR] = (bf16)(raw.x & 0xffffu); vp[1 * VSTR] = (bf16)(raw.x >> 16); vp[2 * VSTR] = (bf16)(raw.y & 0xffffu); vp[3 * VSTR] = (bf16)(raw.y >> 16);
                vp[4 * VSTR] = (bf16)(raw.z & 0xffffu); vp[5 * VSTR] = (bf16)(raw.z >> 16); vp[6 * VSTR] = (bf16)(raw.w & 0xffffu); vp[7 * VSTR] = (bf16)(raw.w >> 16);
            }
            __syncthreads();
            const int ql = lane & 15, kg = lane >> 4, i = wave;
            for (int it = 0; it < 4; ++it) {
                const int head = 4 * g + it; const size_t qrow = (size_t)b * SEQ + 128 * qb + 16 * i + ql;
                bf16* qp = Qb + qrow * D + 64 * head;
                const bf16x8 qf0 = *(const bf16x8*)(qp + 8 * kg), qf1 = *(const bf16x8*)(qp + 32 + 8 * kg);
                f32x4 sc[9];
#pragma unroll
                for (int jb = 0; jb < 9; ++jb) {
                    const LAS bf16* kp = KL + (16 * (i + jb) + ql) * KSTR + 8 * kg;
                    const bf16x8 a0 = *(const LAS bf16x8*)kp, a1 = *(const LAS bf16x8*)(kp + 32);
                    sc[jb] = __builtin_amdgcn_mfma_f32_16x16x32_bf16(a0, qf0, (f32x4){0.f, 0.f, 0.f, 0.f}, 0, 0, 0);
                    sc[jb] = __builtin_amdgcn_mfma_f32_16x16x32_bf16(a1, qf1, sc[jb], 0, 0, 0);
                }
                const int qi = 16 * i + ql; const float sink = sinks[head] * LOG2E; float mx = sink;
#pragma unroll
                for (int jb = 0; jb < 9; ++jb)
#pragma unroll
                    for (int r = 0; r < 4; ++r) { const int kj = 16 * (i + jb) + 4 * kg + r; const bool valid = (kj > qi) && (kj <= qi + 128) && ((qb > 0) || (kj >= 128));
                        sc[jb][r] = valid ? sc[jb][r] : -INFINITY; mx = fmaxf(mx, sc[jb][r]); }
                mx = fmaxf(mx, __shfl_xor(mx, 16)); mx = fmaxf(mx, __shfl_xor(mx, 32));
                float sum = 0.f;
#pragma unroll
                for (int jb = 0; jb < 9; ++jb)
#pragma unroll
                    for (int r = 0; r < 4; ++r) { const float p = fast_exp2(sc[jb][r] - mx); sc[jb][r] = p; sum += p; }
                sum += __shfl_xor(sum, 16); sum += __shfl_xor(sum, 32);
                const float inv = fast_rcp(sum + fast_exp2(sink - mx));
                f32x4 o[4];
#pragma unroll
                for (int db = 0; db < 4; ++db) o[db] = (f32x4){0.f, 0.f, 0.f, 0.f};
#pragma unroll
                for (int pp = 0; pp < 5; ++pp) {
                    v4u pw; pw.x = cvt_pk_bf16(sc[2 * pp][0], sc[2 * pp][1]); pw.y = cvt_pk_bf16(sc[2 * pp][2], sc[2 * pp][3]);
                    if (pp < 4) { pw.z = cvt_pk_bf16(sc[2 * pp + 1 < 9 ? 2 * pp + 1 : 8][0], sc[2 * pp + 1 < 9 ? 2 * pp + 1 : 8][1]); pw.w = cvt_pk_bf16(sc[2 * pp + 1 < 9 ? 2 * pp + 1 : 8][2], sc[2 * pp + 1 < 9 ? 2 * pp + 1 : 8][3]); }
                    else { pw.z = 0u; pw.w = 0u; }
                    const bf16x8 pf = __builtin_bit_cast(bf16x8, pw);
#pragma unroll
                    for (int db = 0; db < 4; ++db) {
                        const LAS bf16* vp = VT + (16 * db + ql) * VSTR + 16 * (i + 2 * pp) + 4 * kg;
                        v4u vw; const v2u l2 = *(const LAS v2u*)vp; vw.x = l2.x; vw.y = l2.y;
                        if (pp < 4) { const v2u h2 = *(const LAS v2u*)(vp + 16); vw.z = h2.x; vw.w = h2.y; } else { vw.z = 0u; vw.w = 0u; }
                        o[db] = __builtin_amdgcn_mfma_f32_16x16x32_bf16(__builtin_bit_cast(bf16x8, vw), pf, o[db], 0, 0, 0);
                    }
                }
#pragma unroll
                for (int db = 0; db < 4; ++db) { v2u w; w.x = cvt_pk_bf16(o[db][0] * inv, o[db][1] * inv); w.y = cvt_pk_bf16(o[db][2] * inv, o[db][3] * inv);
                    *(v2u*)(qp + 16 * db + 4 * kg) = w; }
            }
            __syncthreads();
        }
        GRID_BAR();
        PROBE_END(8);
    }

    if (IN(9)) {
        PROBE_START(9);
        pg8::StaticOrder S; S.init(M, D, D, D, G, bid, Qb, Wo_t);
        pg8::EpiRes<false> E{XB1, XB1, IN_(19), nullptr};
        pg8::gemm_phase<pg8::EpiRes<false>, pg8::StaticOrder, false, false>(F.lds, D, S, E, wave);
        GRID_BAR();
        PROBE_END(9);
    }

    if (IN(10)) {
        PROBE_START(10);
        PH_IDS;
        LAS float* WRL = (LAS float*)(F.lds);
        LAS int* lcnt = (LAS int*)(F.lds + 32768);
        LAS unsigned* rec = (LAS unsigned*)(F.lds + 32768 + 64);
        for (int i = tid; i < NE * D / 4; i += NWAVES * 64) ((LAS f32x4*)WRL)[i] = ((const f32x4*)WR)[i];
        for (int chunk = bid; chunk < M / 64; chunk += G) {
            if (tid < 8) lcnt[tid] = 0;
            __syncthreads();
            v4u xw[8][2];
#pragma unroll
            for (int k = 0; k < 8; ++k) { const v4u* xr = (const v4u*)(XB1 + (size_t)(chunk * 64 + wave * 8 + k) * D) + lane; xw[k][0] = xr[0]; xw[k][1] = xr[64]; }
            asm volatile("" ::: "memory");
#pragma unroll
            for (int k = 0; k < 8; ++k) {
                const int tl = wave * 8 + k, tok = chunk * 64 + tl;
                f32x4 v[4]; float s = 0.f;
#pragma unroll
                for (int j = 0; j < 2; ++j) { const v4u w = xw[k][j]; v[2 * j] = (f32x4){bf_lo(w.x), bf_hi(w.x), bf_lo(w.y), bf_hi(w.y)}; v[2 * j + 1] = (f32x4){bf_lo(w.z), bf_hi(w.z), bf_lo(w.w), bf_hi(w.w)}; }
#pragma unroll
                for (int j = 0; j < 4; ++j) s += (v[j].x * v[j].x + v[j].y * v[j].y) + (v[j].z * v[j].z + v[j].w * v[j].w);
                float dot[8];
#pragma unroll
                for (int e = 0; e < 8; ++e) { float d = 0.f;
#pragma unroll
                    for (int j = 0; j < 4; ++j) { const f32x4 w = ((const LAS f32x4*)(WRL + e * D))[2 * lane + 128 * (j >> 1) + (j & 1)]; d += (v[j].x * w.x + v[j].y * w.y) + (v[j].z * w.z + v[j].w * w.w); }
                    dot[e] = d; }
                s = wave_sum(s);
#pragma unroll
                for (int e = 0; e < 8; ++e) dot[e] = wave_sum(dot[e]);
                const float r = __builtin_amdgcn_rsqf(s * (1.0f / D) + EPS);
                int e0 = 0; float v0 = dot[0] * r;
#pragma unroll
                for (int e = 1; e < 8; ++e) { const float l = dot[e] * r; if (l > v0) { v0 = l; e0 = e; } }
                int e1 = -1; float v1 = -INFINITY;
#pragma unroll
                for (int e = 0; e < 8; ++e) { const float l = dot[e] * r; if (e != e0 && l > v1) { v1 = l; e1 = e; } }
                const float w1 = fast_rcp(1.0f + fast_exp2((v0 - v1) * LOG2E)), w0 = 1.0f - w1;
                if (lane == 0) {
                    const int p0 = __hip_atomic_fetch_add(&lcnt[e0], 1, __ATOMIC_RELAXED, __HIP_MEMORY_SCOPE_WORKGROUP);
                    const int p1 = __hip_atomic_fetch_add(&lcnt[e1], 1, __ATOMIC_RELAXED, __HIP_MEMORY_SCOPE_WORKGROUP);
                    LAS unsigned* rp = rec + tl * 6; rp[0] = (unsigned)e0; rp[1] = (unsigned)e1; rp[2] = (unsigned)p0; rp[3] = (unsigned)p1; rp[4] = __float_as_uint(w0); rp[5] = __float_as_uint(w1);
                    R4[tok] = r;
                }
            }
            __syncthreads();
            if (tid < 8) lcnt[8 + tid] = (int)__hip_atomic_fetch_add(GCNT + 64 * tid, (unsigned)lcnt[tid], __ATOMIC_RELAXED, __HIP_MEMORY_SCOPE_AGENT);
            __syncthreads();
            if (tid < 64) {
                const int tok = chunk * 64 + tid; const LAS unsigned* rp = rec + tid * 6;
                const int e0 = (int)rp[0], e1 = (int)rp[1]; const int q0 = lcnt[8 + e0] + (int)rp[2], q1 = lcnt[8 + e1] + (int)rp[3];
                TOKLIST[e0 * M + q0] = tok; TOKLIST[e1 * M + q1] = tok; SLOTW[e0 * M + q0] = __uint_as_float(rp[4]); SLOTW[e1 * M + q1] = __uint_as_float(rp[5]);
                TOKSLOT[2 * tok] = ((unsigned)e0 << 16) | (unsigned)q0; TOKSLOT[2 * tok + 1] = ((unsigned)e1 << 16) | (unsigned)q1;
            }
            __syncthreads();
        }
        GRID_BAR();
        PROBE_END(10);
    }

    LAS int* const etab = (LAS int*)(F.lds + MISC_OFF) + 32;
    if (IN(11) || IN(12) || IN(13)) {
        PH_IDS;
        if (tid == 0) { int ts = 0, off = 0;
            for (int e = 0; e < 8; ++e) { const int cn = (int)__hip_atomic_load(GCNT + 64 * e, __ATOMIC_RELAXED, __HIP_MEMORY_SCOPE_AGENT); etab[e] = ts; etab[9 + e] = off; etab[18 + e] = cn; ts += (cn + 255) >> 8; off += cn; }
            etab[8] = ts; etab[17] = off;
            int tr0 = 1 << 30;
            for (int e = 0; e < 8; ++e) if (128 >= etab[e] && 128 < etab[e + 1]) tr0 = etab[9 + e] + 256 * (128 - etab[e]);
            etab[26] = tr0; }
        __syncthreads();
    }

    if (IN(11)) {
        PROBE_START(11);
        PH_IDS;
        LAS unsigned* toktab = (LAS unsigned*)(F.lds + TOKTAB_OFF);
        pg8::MoeOrder S{etab, toktab, FFE / 128, G, bid, etab[8] * (FFE / 128), D, D, (const char*)XB1, (const char*)MWgu_t, (size_t)D * 2, (size_t)2 * FFE * D * 2, (size_t)256 * D * 2, 0, 1};
        { pg8::Unit u; for (int ui = 0; ui < 16 && S.next(ui, u); ++ui) { if (tid < 256) { const int tok = TOKLIST[u.e * M + (tid < u.cnt ? u.pm * 256 + tid : 0)]; toktab[ui * 256 + tid] = (unsigned)tok * (unsigned)(D * 2); } } }
        __syncthreads();
        pg8::EpiHid<true> E{HIDM, FFE, nullptr, R4, TOKLIST};
#if defined(PROBE_DUMMY)
        { pg8::EpiNull EN; pg8::gemm_phase<pg8::EpiNull, pg8::MoeOrder, true, true>(F.lds, D, S, EN, wave); }
#else
        pg8::gemm_phase<pg8::EpiHid<true>, pg8::MoeOrder, true, true>(F.lds, D, S, E, wave);
#endif
        GRID_BAR();
        PROBE_END(11);
#if defined(PROBE_DUMMY)
        pg8::gemm_phase<pg8::EpiHid<true>, pg8::MoeOrder, true, true>(F.lds, D, S, E, wave);
        GRID_BAR();
#endif
    }

    if (IN(12)) {
        PROBE_START(12);
        PH_IDS;
        const int TM = etab[8], FULL = TM < 128 ? TM : 128, T = TM - FULL;
        { pg8::MoeOrder S{etab, nullptr, D / 256, G, bid, FULL * (D / 256), FFE, FFE, (const char*)HIDM, (const char*)MWd_t, (size_t)FFE * 2, (size_t)D * FFE * 2, (size_t)256 * FFE * 2, 0, 1};
          pg8::EpiBf<true> E{YS, D, SLOTW};
          pg8::gemm_phase<pg8::EpiBf<true>, pg8::MoeOrder, true, false>(F.lds, FFE, S, E, wave); }
        if (T > 0) {
          pg8::MoeOrder S{etab, nullptr, D / 256, G, bid, T * (D / 256) * 7, FFE, FFE, (const char*)HIDM, (const char*)MWd_t, (size_t)FFE * 2, (size_t)D * FFE * 2, (size_t)256 * FFE * 2, FULL, 7};
          pg8::EpiBfTail E{YSP, SLOTW, etab[26]};
          pg8::gemm_phase<pg8::EpiBfTail, pg8::MoeOrder, false, false>(F.lds, 512, S, E, wave); }
        GRID_BAR();
        PROBE_END(12);
    }

    if (IN(13)) {
        PROBE_START(13);
        PH_IDS;
        const int tail0 = etab[26];
        for (int m0 = 2 * gw; m0 < M; m0 += 2 * NGW) {
            const uint4 sl = *(const uint4*)(TOKSLOT + 2 * m0);
            const unsigned sw[4] = {sl.x, sl.y, sl.z, sl.w};
            size_t rr[4];
#pragma unroll
            for (int k = 0; k < 4; ++k) rr[k] = (size_t)(etab[9 + (sw[k] >> 16)] + (int)(sw[k] & 0xffffu));
            f32x4 v[2][4]; v2u yw[4][4]; bool tl[4];
#pragma unroll
            for (int q = 0; q < 2; ++q) { const v2u* xr = (const v2u*)(XB1 + (size_t)(m0 + q) * D) + lane;
#pragma unroll
                for (int j = 0; j < 4; ++j) { const v2u xw = xr[64 * j]; v[q][j] = (f32x4){bf_lo(xw.x), bf_hi(xw.x), bf_lo(xw.y), bf_hi(xw.y)}; } }
#pragma unroll
            for (int k = 0; k < 4; ++k) { tl[k] = (long)rr[k] >= (long)tail0; const v2u* y = (const v2u*)(YS + (tl[k] ? 0 : rr[k]) * D) + lane;
#pragma unroll
                for (int j = 0; j < 4; ++j) yw[k][j] = y[64 * j]; }
#pragma unroll
            for (int k = 0; k < 4; ++k) {
                if (!tl[k]) {
#pragma unroll
                    for (int j = 0; j < 4; ++j) { const v2u a = yw[k][j]; v[k >> 1][j].x += bf_lo(a.x); v[k >> 1][j].y += bf_hi(a.x); v[k >> 1][j].z += bf_lo(a.y); v[k >> 1][j].w += bf_hi(a.y); }
                } else { for (int ks = 0; ks < 7; ++ks) { const v2u* y = (const v2u*)(YSP + ((size_t)ks * 2048 + (rr[k] - tail0)) * D) + lane;
#pragma unroll
                    for (int j = 0; j < 4; ++j) { const v2u a = y[64 * j]; v[k >> 1][j].x += bf_lo(a.x); v[k >> 1][j].y += bf_hi(a.x); v[k >> 1][j].z += bf_lo(a.y); v[k >> 1][j].w += bf_hi(a.y); } } }
            }
#pragma unroll
            for (int q = 0; q < 2; ++q) { v2u* o8 = (v2u*)(XB0 + (size_t)(m0 + q) * D) + lane; float s = 0.f;
#pragma unroll
                for (int j = 0; j < 4; ++j) { s += (v[q][j].x * v[q][j].x + v[q][j].y * v[q][j].y) + (v[q][j].z * v[q][j].z + v[q][j].w * v[q][j].w);
                    v2u w; w.x = cvt_pk_bf16(v[q][j].x, v[q][j].y); w.y = cvt_pk_bf16(v[q][j].z, v[q][j].w); o8[64 * j] = w; }
                s = wave_sum(s);
                if (lane < 16) SS5[(size_t)(m0 + q) * 16 + lane] = lane == 0 ? s : 0.f; }
        }
        VM_WAIT(); __syncthreads();
        { pg8::StaticOrder S; S.init(M, D, PLE, PLE, G, bid, PB + (size_t)M * PLE, Wpp1_t);
          pg8::EpiBf<false> E{PROJ, D, nullptr};
          pg8::gemm_phase<pg8::EpiBf<false>, pg8::StaticOrder, false, false>(F.lds, PLE, S, E, wave); }
        GRID_BAR();
        PROBE_END(13);
    }

    if (IN(14)) {
        PROBE_START(14);
        pg8::StaticOrder S; S.init(M, D, D, D, G, bid, XB0, Wpg1_t);
        pg8::EpiPle E{XB0, PROJ, SS5, XB1, nullptr};
        pg8::gemm_phase<pg8::EpiPle, pg8::StaticOrder, false, false>(F.lds, D, S, E, wave);
        GRID_BAR();
        PROBE_END(14);
    }

    if (IN(15)) {
        PROBE_START(15);
        PH_IDS;
        const f32x4* gp = (const f32x4*)IN_(30) + lane;
        const f32x4 g0 = gp[0], g1 = gp[64], g2 = gp[128], g3 = gp[192];
        for (int m0 = 4 * gw; m0 < M; m0 += 4 * NGW) {
            v2u xw[4][4];
#pragma unroll
            for (int q = 0; q < 4; ++q) { const v2u* xr = (const v2u*)(XB1 + (size_t)(m0 + q) * D) + lane;
#pragma unroll
                for (int j = 0; j < 4; ++j) xw[q][j] = xr[64 * j]; }
#pragma unroll
            for (int q = 0; q < 4; ++q) {
                f32x4* orow = (f32x4*)(X + (size_t)(m0 + q) * D) + lane; f32x4 v[4]; float s = 0.f;
#pragma unroll
                for (int j = 0; j < 4; ++j) { const v2u w = xw[q][j]; v[j] = (f32x4){bf_lo(w.x), bf_hi(w.x), bf_lo(w.y), bf_hi(w.y)}; s += (v[j].x * v[j].x + v[j].y * v[j].y) + (v[j].z * v[j].z + v[j].w * v[j].w); }
                s = wave_sum(s); const float r = __builtin_amdgcn_rsqf(s * (1.0f / D) + EPS);
                orow[0] = v[0] * r * g0; orow[64] = v[1] * r * g1; orow[128] = v[2] * r * g2; orow[192] = v[3] * r * g3;
            }
        }
    }
#if defined(PROBE_LO)
    if (bid == 0) { const unsigned long long te = __builtin_amdgcn_s_memrealtime(); while (__builtin_amdgcn_s_memrealtime() - te < 8ull * probe_dt) __builtin_amdgcn_s_sleep(8); }
#endif
#undef IN
#undef GRID_BAR
}

constexpr int N_PHASES = 16;
extern "C" void kernel_launch(void* const* d_in, const int* in_sizes, int n_in, void* d_out, int out_size, void* d_ws, size_t ws_size, hipStream_t stream) {
    static int grid = 0;
    if (grid == 0) {
        if (n_in != 31 || out_size != M * D || ws_size < WS_END) { fprintf(stderr, "kernel_launch: unexpected shapes (n_in %d, out %d, ws %zu < %zu)\n", n_in, out_size, ws_size, (size_t)WS_END); grid = -1; return; }
        int dev = 0, cus = 0;
        if (hipGetDevice(&dev) != hipSuccess || hipDeviceGetAttribute(&cus, hipDeviceAttributeMultiprocessorCount, dev) != hipSuccess) { grid = -1; return; }
        if (hipFuncSetAttribute((const void*)fwd_kernel, hipFuncAttributeMaxDynamicSharedMemorySize, LDS_BYTES) != hipSuccess) { fprintf(stderr, "kernel_launch: hipFuncSetAttribute failed\n"); grid = -1; return; }
        int per_cu = 0;
        if (hipOccupancyMaxActiveBlocksPerMultiprocessor(&per_cu, (const void*)fwd_kernel, NWAVES * 64, LDS_BYTES) != hipSuccess || per_cu < 1) fprintf(stderr, "kernel_launch: occupancy query reports %d\n", per_cu);
        (void)hipGetLastError();
        grid = cus;
    }
    if (grid < 0) return;
    (void)in_sizes;
    if (hipMemsetAsync((char*)d_ws + WS_CTL, 0, CTL_ZERO_BYTES, stream) != hipSuccess) return;
    Args a{};
    for (int i = 0; i < 31; ++i) a.in[i] = (const float*)d_in[i];
    a.out = (float*)d_out; a.ws = (unsigned char*)d_ws;
    if (MK_N_LAUNCHES == 1) {
        a.ph_lo = 0; a.ph_hi = N_PHASES; a.li = 0;
        hipLaunchKernelGGL(fwd_kernel, dim3(grid), dim3(NWAVES * 64), LDS_BYTES, stream, a);
    } else {
        for (int li = 0; li < N_PHASES; ++li) { a.ph_lo = li; a.ph_hi = li + 1; a.li = li;
            hipLaunchKernelGGL(fwd_kernel, dim3(grid), dim3(NWAVES * 64), LDS_BYTES, stream, a); }
    }
}
```
